# Optimizing an MI355X kernel written in HIP

```python
import jax, jax.numpy as jnp
from jax import lax
import numpy as np

D_MODEL = 1024
BATCH = 8
SEQ = 4096
DEPTH = 4

N_META = 16
EPS = 1e-6
D_FF = 2816
FFN_HALF = 0.5

A_WIDTH = 3 * D_MODEL // 8
A_DK = 64
A_DV = 64
A_HEADS = A_WIDTH // A_DV
A_CHUNK = 64

B_HEAD_DIM = 64
B_WIDTH = 3 * D_MODEL // 8
B_Q_HEADS = B_WIDTH // B_HEAD_DIM
B_KV_HEADS = 2
B_WINDOW = 128
B_BLOCK = 128

C_CHANNELS = D_MODEL - A_WIDTH - B_WIDTH
C_CONV_WIDTH = 31

MIX_WIDTH = A_WIDTH + B_WIDTH + C_CHANNELS
IN_SPLITS = (A_HEADS * A_DK, A_HEADS * A_DK, A_WIDTH, A_WIDTH,
             B_Q_HEADS * B_HEAD_DIM, B_KV_HEADS * B_HEAD_DIM, B_KV_HEADS * B_HEAD_DIM,
             2 * C_CHANNELS)
IN_WIDTH = sum(IN_SPLITS)

kernel_name = 'hymba_style_hgrn2_swa_conformer_macaron'


def rms_norm(x, g):
    xf = x.astype(jnp.float32)
    y = xf * lax.rsqrt(jnp.mean(xf * xf, axis=-1, keepdims=True) + EPS)
    return (y * g.astype(jnp.float32)).astype(x.dtype)


def swiglu(x, w_gate, w_up, w_down):
    return (jax.nn.silu(x @ w_gate) * (x @ w_up)) @ w_down


def pad_front(t, n):
    return jnp.pad(t, ((0, 0), (n, 0), (0, 0)))


def hgrn2_recurrence(q, f_pre, i, g, lb, out_gain):
    Bsz, L, _ = q.shape
    dt = q.dtype
    pad = A_CHUNK - N_META
    total = L + pad
    nc = total // A_CHUNK
    z = f_pre.astype(jnp.float32)
    lb = lb.astype(jnp.float32)
    log_f = jnp.logaddexp(jnp.log(lb), jnp.log1p(-lb) + jax.nn.log_sigmoid(z))
    k = (1.0 - lb) * jax.nn.sigmoid(-z)

    def chunks(t, d):
        return pad_front(t, pad).reshape(Bsz, nc, A_CHUNK, A_HEADS, d).transpose(1, 0, 3, 2, 4)

    qc = chunks(q.astype(jnp.float32), A_DK)
    kc = chunks(k, A_DK)
    gc = chunks(log_f, A_DK)
    vc = chunks(i.astype(jnp.float32), A_DV)
    causal = jnp.tril(jnp.ones((A_CHUNK, A_CHUNK), dtype=bool))

    def step(S, inp):
        qb, kb, vb, gb = inp
        G = jnp.cumsum(gb, axis=2)
        o_inter = jnp.einsum('bhtk,bhkv->bhtv', qb * jnp.exp(G), S)
        diff = G[:, :, :, None, :] - G[:, :, None, :, :]
        decay = jnp.exp(jnp.where(causal[:, :, None], diff, -jnp.inf))
        A = jnp.einsum('bhtsk,bhsk->bhts', decay * qb[:, :, :, None, :], kb)
        o_intra = jnp.einsum('bhts,bhsv->bhtv', A, vb)
        G_last = G[:, :, -1:, :]
        S_new = (jnp.exp(G_last[:, :, 0, :])[..., None] * S
                 + jnp.einsum('bhsk,bhsv->bhkv', kb * jnp.exp(G_last - G), vb))
        return S_new, o_inter + o_intra

    S0 = jnp.zeros((Bsz, A_HEADS, A_DK, A_DV), jnp.float32)
    _, o = lax.scan(step, S0, (qc, kc, vc, gc))
    o = o.transpose(1, 0, 3, 2, 4).reshape(Bsz, total, A_HEADS, A_DV)[:, pad:]
    o = rms_norm(o, out_gain)
    gate = jax.nn.silu(g.astype(jnp.float32)).reshape(Bsz, L, A_HEADS, A_DV)
    return (o * gate).reshape(Bsz, L, A_WIDTH).astype(dt)


def sliding_window_sink_attention(q, k, v, sinks):
    Bsz, L, _ = q.shape
    dt = q.dtype
    G = B_Q_HEADS // B_KV_HEADS
    pad = B_BLOCK - N_META
    total = L + pad
    nb = total // B_BLOCK
    qb = pad_front(q, pad).reshape(Bsz, nb, B_BLOCK, B_KV_HEADS, G, B_HEAD_DIM)
    kb = pad_front(k, pad).reshape(Bsz, nb, B_BLOCK, B_KV_HEADS, B_HEAD_DIM)
    vb = pad_front(v, pad).reshape(Bsz, nb, B_BLOCK, B_KV_HEADS, B_HEAD_DIM)

    def band(t):
        prev = jnp.concatenate([jnp.zeros_like(t[:, :1]), t[:, :-1]], axis=1)
        return jnp.concatenate([prev, t], axis=2)

    k_band, v_band = band(kb), band(vb)
    k_meta = k[:, :N_META].reshape(Bsz, N_META, B_KV_HEADS, B_HEAD_DIM)
    v_meta = v[:, :N_META].reshape(Bsz, N_META, B_KV_HEADS, B_HEAD_DIM)
    scale = B_HEAD_DIM ** -0.5
    s_band = jnp.einsum('bnqhgd,bnkhd->bnhgqk', qb, k_band)
    s_meta = jnp.einsum('bnqhgd,bmhd->bnhgqm', qb, k_meta)
    scores = jnp.concatenate([s_band, s_meta], axis=-1).astype(jnp.float32) * scale

    q_pos = jnp.arange(total).reshape(nb, B_BLOCK)
    k_pos = (jnp.arange(nb)[:, None] - 1) * B_BLOCK + jnp.arange(2 * B_BLOCK)[None, :]
    qp, kp = q_pos[:, :, None], k_pos[:, None, :]
    band_mask = (kp >= pad + N_META) & (kp <= qp) & (qp - kp < B_WINDOW)
    meta_mask = (pad + jnp.arange(N_META))[None, None, :] <= qp
    mask = jnp.concatenate([band_mask, meta_mask], axis=-1)[None, :, None, None]
    scores = jnp.where(mask, scores, -jnp.inf)
    sink = jnp.broadcast_to(sinks.astype(jnp.float32).reshape(1, 1, B_KV_HEADS, G, 1, 1),
                            scores.shape[:-1] + (1,))
    probs = jax.nn.softmax(jnp.concatenate([scores, sink], axis=-1), axis=-1)[..., :-1].astype(dt)
    out = (jnp.einsum('bnhgqk,bnkhd->bnqhgd', probs[..., :2 * B_BLOCK], v_band)
           + jnp.einsum('bnhgqm,bmhd->bnqhgd', probs[..., 2 * B_BLOCK:], v_meta))
    return out.reshape(Bsz, total, B_Q_HEADS * B_HEAD_DIM)[:, pad:]


def conformer_conv(u, dw_w, dw_b, ln_g, ln_b):
    a, b = jnp.split(u, 2, axis=-1)
    h = a * jax.nn.sigmoid(b)
    h = lax.conv_general_dilated(h, dw_w[:, None, :].astype(h.dtype), (1,),
                                 [(C_CONV_WIDTH - 1, 0)],
                                 dimension_numbers=('NWC', 'WIO', 'NWC'),
                                 feature_group_count=C_CHANNELS) + dw_b
    hf = h.astype(jnp.float32)
    mu = jnp.mean(hf, axis=-1, keepdims=True)
    var = jnp.mean(jnp.square(hf - mu), axis=-1, keepdims=True)
    hn = (hf - mu) * lax.rsqrt(var + EPS) * ln_g.astype(jnp.float32) + ln_b.astype(jnp.float32)
    return jax.nn.silu(hn).astype(u.dtype)


def setup_inputs(seed: int = 0) -> dict:
    key = jax.random.key(seed)
    ks = jax.random.split(key, 24)
    f32 = jnp.float32

    def nrm(k, shape, scale):
        return jax.random.normal(k, shape, f32) * scale

    def gain(k, shape):
        return 1.0 + 0.02 * jax.random.normal(k, shape, f32)

    return {
        'x': nrm(ks[0], (BATCH, SEQ, D_MODEL), 1.0),
        'meta_tokens': nrm(ks[1], (N_META, D_MODEL), 1.0),
        'ffn1_norm': gain(ks[2], (DEPTH, D_MODEL)),
        'ffn1_w_gate': nrm(ks[3], (DEPTH, D_MODEL, D_FF), D_MODEL ** -0.5),
        'ffn1_w_up': nrm(ks[4], (DEPTH, D_MODEL, D_FF), D_MODEL ** -0.5),
        'ffn1_w_down': nrm(ks[5], (DEPTH, D_FF, D_MODEL), D_FF ** -0.5),
        'mix_norm': gain(ks[6], (DEPTH, D_MODEL)),
        'w_in': nrm(ks[7], (DEPTH, D_MODEL, IN_WIDTH), D_MODEL ** -0.5),
        'w_out': nrm(ks[8], (DEPTH, MIX_WIDTH, D_MODEL), MIX_WIDTH ** -0.5),
        'hgrn_lb_logits': nrm(ks[9], (DEPTH, A_HEADS * A_DK), 0.5),
        'hgrn_out_norm': gain(ks[10], (DEPTH, A_DV)),
        'attn_sinks': nrm(ks[11], (DEPTH, B_Q_HEADS), 0.5),
        'conv_dw_w': nrm(ks[12], (DEPTH, C_CONV_WIDTH, C_CHANNELS), C_CONV_WIDTH ** -0.5),
        'conv_dw_b': nrm(ks[13], (DEPTH, C_CHANNELS), 0.02),
        'conv_ln_g': gain(ks[14], (DEPTH, C_CHANNELS)),
        'conv_ln_b': nrm(ks[15], (DEPTH, C_CHANNELS), 0.02),
        'ffn2_norm': gain(ks[16], (DEPTH, D_MODEL)),
        'ffn2_w_gate': nrm(ks[17], (DEPTH, D_MODEL, D_FF), D_MODEL ** -0.5),
        'ffn2_w_up': nrm(ks[18], (DEPTH, D_MODEL, D_FF), D_MODEL ** -0.5),
        'ffn2_w_down': nrm(ks[19], (DEPTH, D_FF, D_MODEL), D_FF ** -0.5),
        'final_norm': gain(ks[20], (D_MODEL,)),
    }


def reference(x, meta_tokens, ffn1_norm, ffn1_w_gate, ffn1_w_up, ffn1_w_down,
              mix_norm, w_in, w_out, hgrn_lb_logits, hgrn_out_norm, attn_sinks,
              conv_dw_w, conv_dw_b, conv_ln_g, conv_ln_b,
              ffn2_norm, ffn2_w_gate, ffn2_w_up, ffn2_w_down, final_norm):
    Bsz = x.shape[0]
    meta = jnp.broadcast_to(meta_tokens[None].astype(x.dtype), (Bsz, N_META, D_MODEL))
    h = jnp.concatenate([meta, x], axis=1)
    lbs = jnp.cumsum(jax.nn.softmax(hgrn_lb_logits.astype(jnp.float32), axis=0), axis=0)
    lbs = lbs - lbs[0]
    split_points = np.cumsum(IN_SPLITS)[:-1].tolist()
    for l in range(DEPTH):
        h = h + FFN_HALF * swiglu(rms_norm(h, ffn1_norm[l]), ffn1_w_gate[l], ffn1_w_up[l], ffn1_w_down[l])
        p = rms_norm(h, mix_norm[l]) @ w_in[l]
        a_q, a_f, a_i, a_g, b_q, b_k, b_v, c_u = jnp.split(p, split_points, axis=-1)
        y_a = hgrn2_recurrence(a_q, a_f, a_i, a_g, lbs[l], hgrn_out_norm[l])
        y_b = sliding_window_sink_attention(b_q, b_k, b_v, attn_sinks[l])
        y_c = conformer_conv(c_u, conv_dw_w[l], conv_dw_b[l], conv_ln_g[l], conv_ln_b[l])
        h = h + jnp.concatenate([y_a, y_b, y_c], axis=-1) @ w_out[l]
        h = h + FFN_HALF * swiglu(rms_norm(h, ffn2_norm[l]), ffn2_w_gate[l], ffn2_w_up[l], ffn2_w_down[l])
    return rms_norm(h[:, N_META:], final_norm)
```

```cpp
#include <hip/hip_runtime.h>
#include <hip/hip_cooperative_groups.h>
#include <cstdio>
#include <cstdint>
namespace cg = cooperative_groups;

namespace pg8 {
#define PG8_LAS __attribute__((address_space(3)))
typedef unsigned short bf16_t;
typedef short bf16x8 __attribute__((ext_vector_type(8)));
typedef float f32x4 __attribute__((ext_vector_type(4)));
typedef unsigned u32x4 __attribute__((ext_vector_type(4)));
constexpr int BM = 256, BK = 64, HALF = 128, HTB = HALF * BK * 2  , STAGE_BYTES = 8 * HTB, NXCD = 8, WGM = 8;

__host__ __device__ __forceinline__ int lds_byte(int r, int c) { const int st = (r >> 4) * 2 + (c >> 5), rr = r & 15, cc = c & 31, ob = rr * 64 + cc * 2; return st * 1024 + (ob ^ (((ob >> 9) & 1) << 5)); }
__host__ __device__ __forceinline__ void stage_rc(int b, int& R, int& C) { const int st = b / 1024, sb = b % 1024, swz = sb ^ (((sb >> 9) & 1) << 5); R = (st >> 1) * 16 + swz / 64; C = (st & 1) * 32 + (swz % 64) / 2; }
__host__ __device__ __forceinline__ int perm32(int rho) { const int n = rho >> 4, i = rho & 15; return 8 * (i >> 2) + 4 * n + (i & 3); }

struct Unit { int pm, pn, idx; };
struct Gemm { const bf16_t* A; const bf16_t* Bt; int M, N, K; };

struct StaticOrder {
    int nM, nN, nwg, G, c;
    __host__ __device__ void init(int M, int N, int G_, int c_) { nM = M / BM; nN = N / BM; nwg = nM * nN; G = G_; c = c_; }
    __host__ __device__ bool next(int i, Unit& u) const {
        const long L = (long)i * G + c; if (L >= nwg) return false;
        int wgid = (int)L; { const int q = nwg / NXCD, r = nwg % NXCD, xcd = wgid % NXCD, off = wgid / NXCD; wgid = (xcd < r ? xcd * (q + 1) : r * (q + 1) + (xcd - r) * q) + off; }
        const int nig = WGM * nN, gid = wgid / nig, fm = gid * WGM, gsz = (nM - fm) < WGM ? (nM - fm) : WGM;
        u.pm = fm + ((wgid % nig) % gsz); u.pn = (wgid % nig) / gsz; u.idx = i; return true;
    }
    __device__ __forceinline__ void a_ready(const Unit&) const {}
    __device__ __forceinline__ void done(const Unit&) const {}
};

__device__ __forceinline__ unsigned cvt_pk_bf16(float lo, float hi) { unsigned r; asm volatile("v_cvt_pk_bf16_f32 %0, %1, %2" : "=v"(r) : "v"(lo), "v"(hi)); return r; }
typedef float f32x2 __attribute__((ext_vector_type(2)));
typedef __bf16 bf16x2_t __attribute__((ext_vector_type(2)));
typedef unsigned u32x2 __attribute__((ext_vector_type(2)));
typedef _Float16 f16x8 __attribute__((ext_vector_type(8)));
typedef _Float16 f16x4 __attribute__((ext_vector_type(4)));
typedef _Float16 f16x2 __attribute__((ext_vector_type(2)));
__device__ __forceinline__ unsigned pk_f16(float lo, float hi) { f32x2 v = {lo, hi}; f16x2 h = __builtin_convertvector(v, f16x2); return __builtin_bit_cast(unsigned, h); }
__device__ __forceinline__ unsigned pk_bf16(float lo, float hi) { f32x2 v = {lo, hi}; bf16x2_t b = __builtin_convertvector(v, bf16x2_t); return __builtin_bit_cast(unsigned, b); }
__device__ __forceinline__ float silu_f(float x) { return x * __builtin_amdgcn_rcpf(1.0f + __expf(-x)); }

__device__ __forceinline__ float shx_(float v, int o, int lane) { return __builtin_bit_cast(float, __builtin_amdgcn_ds_bpermute((lane ^ o) << 2, __builtin_bit_cast(int, v))); }
#define PG8_ROW_RINV(rinv, tab, u, wr, fr) do { _Pragma("unroll") for (int ai = 0; ai < 2; ++ai) _Pragma("unroll") for (int m = 0; m < 4; ++m) rinv[ai][m] = (tab)[(u).idx * 256 + ai * HALF + (wr) * 64 + m * 16 + (fr)]; } while (0)
struct EpiSwiGLU {
    static constexpr bool PERM = true, AFTER_DRAIN = false;
    bf16_t* O; int ldo; const PG8_LAS float* tab;
    __device__ __forceinline__ void operator()(const f32x4 (&acc)[2][2][4][2], const Unit& u, int wr, int wc, int fr, int fq) const {
        const int row0 = u.pm * BM + wr * 64 + fr; const int col0 = u.pn * 128 + wc * 32 + 8 * fq;
        float rinv[2][4]; PG8_ROW_RINV(rinv, tab, u, wr, fr);
#pragma unroll
        for (int ai = 0; ai < 2; ++ai)
#pragma unroll
            for (int m = 0; m < 4; ++m) { const float ri = rinv[ai][m];
                float g[8], up[8], e[8];
#pragma unroll
                for (int i = 0; i < 4; ++i) { g[i] = acc[ai][0][m][0][i] * ri; g[4 + i] = acc[ai][0][m][1][i] * ri; up[i] = acc[ai][1][m][0][i] * ri; up[4 + i] = acc[ai][1][m][1][i] * ri; }
#pragma unroll
                for (int i = 0; i < 8; ++i) e[i] = __builtin_amdgcn_exp2f(g[i] * -1.4426950408889634f);
#pragma unroll
                for (int i = 0; i < 8; ++i) e[i] = __builtin_amdgcn_rcpf(1.0f + e[i]);
#pragma unroll
                for (int i = 0; i < 8; ++i) g[i] = (g[i] * up[i]) * e[i];
                u32x4 w; w.x = pk_bf16(g[0], g[1]); w.y = pk_bf16(g[2], g[3]); w.z = pk_bf16(g[4], g[5]); w.w = pk_bf16(g[6], g[7]);
                *(u32x4*)(O + (size_t)(row0 + ai * HALF + m * 16) * ldo + col0) = w; }
    }
};
struct EpiStoreBf16 {
    static constexpr bool PERM = true, AFTER_DRAIN = false;
    bf16_t* O; int ldo; const PG8_LAS float* tab;
    __device__ __forceinline__ void operator()(const f32x4 (&acc)[2][2][4][2], const Unit& u, int wr, int wc, int fr, int fq) const {
        const int row0 = u.pm * BM + wr * 64 + fr; const int col0 = u.pn * BM + wc * 32 + 8 * fq;
        float rinv[2][4]; PG8_ROW_RINV(rinv, tab, u, wr, fr);
#pragma unroll
        for (int ai = 0; ai < 2; ++ai)
#pragma unroll
            for (int m = 0; m < 4; ++m) { bf16_t* rowp = O + (size_t)(row0 + ai * HALF + m * 16) * ldo + col0;
#pragma unroll
                for (int bj = 0; bj < 2; ++bj) { const f32x4 v0 = acc[ai][bj][m][0] * rinv[ai][m], v1 = acc[ai][bj][m][1] * rinv[ai][m];
                    u32x4 w; w.x = pk_bf16(v0[0], v0[1]); w.y = pk_bf16(v0[2], v0[3]); w.z = pk_bf16(v1[0], v1[1]); w.w = pk_bf16(v1[2], v1[3]);
                    *(u32x4*)(rowp + bj * HALF) = w; } }
    }
};
struct EpiResid {
    static constexpr bool PERM = true, AFTER_DRAIN = false;
    const float* in32; unsigned short* hb; float* rowsq; float scale;
    __device__ __forceinline__ void operator()(const f32x4 (&acc)[2][2][4][2], const Unit& u, int wr, int wc, int fr, int fq) const {
        const int lane = fq * 16 + fr;
        const int row0 = u.pm * BM + wr * 64 + fr; const int col0 = u.pn * BM + wc * 32 + 8 * fq;
        if (in32) {
#pragma unroll
            for (int ai = 0; ai < 2; ++ai)
#pragma unroll
              for (int mp = 0; mp < 2; ++mp) { f32x4 b0[2][2], b1[2][2];
#pragma unroll
                for (int mm = 0; mm < 2; ++mm)
#pragma unroll
                    for (int bj = 0; bj < 2; ++bj) { const float* ip = in32 + (size_t)(row0 + ai * HALF + (2 * mp + mm) * 16) * 1024 + col0 + bj * HALF; b0[mm][bj] = *(const f32x4*)ip; b1[mm][bj] = *(const f32x4*)(ip + 4); }
#pragma unroll
                for (int mm = 0; mm < 2; ++mm) { const int m = 2 * mp + mm; const int row = row0 + ai * HALF + m * 16; const size_t off = (size_t)row * 1024 + col0; float ss = 0.f;
#pragma unroll
                    for (int bj = 0; bj < 2; ++bj) { const f32x4 o0 = b0[mm][bj] + acc[ai][bj][m][0] * scale, o1 = b1[mm][bj] + acc[ai][bj][m][1] * scale;
                        ss += ((o0[0] * o0[0] + o0[1] * o0[1]) + (o0[2] * o0[2] + o0[3] * o0[3])) + ((o1[0] * o1[0] + o1[1] * o1[1]) + (o1[2] * o1[2] + o1[3] * o1[3]));
                        u32x4 w; w.x = pk_f16(o0[0], o0[1]); w.y = pk_f16(o0[2], o0[3]); w.z = pk_f16(o1[0], o1[1]); w.w = pk_f16(o1[2], o1[3]);
                        *(u32x4*)(hb + off + bj * HALF) = w; }
                    ss += shx_(ss, 16, lane); ss += shx_(ss, 32, lane);
                    if (fq == 0) rowsq[(size_t)row * 16 + u.pn * 4 + wc] = ss; } }
        } else {
#pragma unroll
            for (int ai = 0; ai < 2; ++ai) { f16x8 hv[4][2];
#pragma unroll
                for (int m = 0; m < 4; ++m)
#pragma unroll
                    for (int bj = 0; bj < 2; ++bj) hv[m][bj] = *(const f16x8*)(hb + (size_t)(row0 + ai * HALF + m * 16) * 1024 + col0 + bj * HALF);
#pragma unroll
                for (int m = 0; m < 4; ++m) { const int row = row0 + ai * HALF + m * 16; const size_t off = (size_t)row * 1024 + col0; float ss = 0.f;
#pragma unroll
                    for (int bj = 0; bj < 2; ++bj) { const f16x8 h = hv[m][bj];
                        const f32x4 o0 = (f32x4){(float)h[0], (float)h[1], (float)h[2], (float)h[3]} + acc[ai][bj][m][0] * scale, o1 = (f32x4){(float)h[4], (float)h[5], (float)h[6], (float)h[7]} + acc[ai][bj][m][1] * scale;
                        ss += ((o0[0] * o0[0] + o0[1] * o0[1]) + (o0[2] * o0[2] + o0[3] * o0[3])) + ((o1[0] * o1[0] + o1[1] * o1[1]) + (o1[2] * o1[2] + o1[3] * o1[3]));
                        u32x4 w; w.x = pk_f16(o0[0], o0[1]); w.y = pk_f16(o0[2], o0[3]); w.z = pk_f16(o1[0], o1[1]); w.w = pk_f16(o1[2], o1[3]);
                        *(u32x4*)(hb + off + bj * HALF) = w; }
                    ss += shx_(ss, 16, lane); ss += shx_(ss, 32, lane);
                    if (fq == 0) rowsq[(size_t)row * 16 + u.pn * 4 + wc] = ss; } }
        }
    }
};

template <class Epi, class Sched, bool ALIGN_EPI = false, bool SP2 = false, bool F16 = false>
__device__ __forceinline__ void gemm_phase(PG8_LAS unsigned char* lds, const Gemm g, const Sched& S, const Epi& E, int tid_in) {
    int tid_l = tid_in; asm volatile("" : "+v"(tid_l));
    const int tid = tid_l, wid = __builtin_amdgcn_readfirstlane(tid >> 6), lane = tid & 63, wr = wid >> 2, wc = wid & 3, fr = lane & 15, fq = lane >> 4;
    const int K = g.K, nt = K / BK;
    unsigned voffA[2], voffB[2];
#pragma unroll
    for (int i = 0; i < 2; ++i) { int R, C; stage_rc(tid * 16 + i * 8192, R, C); const int Rb = Epi::PERM ? ((R & ~31) + perm32(R & 31)) : R;
        voffA[i] = (unsigned)(R * K + C) * 2u; voffB[i] = (unsigned)(Rb * K + C) * 2u; }
    const size_t kstep = (size_t)(BK * 2);
    const size_t hstep = (size_t)HALF * K * 2;
    const size_t tstep = 2 * hstep;
    const unsigned ldsw = (unsigned)wid * 1024u;
    const int aoff = lds_byte(wr * 64 + fr, fq * 8), boff = lds_byte(wc * 32 + fr, fq * 8);
#define PG8_SA(b, h) (((b) * 2 + (h)) * HTB)
#define PG8_SB(b, h) ((4 + (b) * 2 + (h)) * HTB)
#define PG8_STAGE(bufoff, gbase, voff) do { _Pragma("unroll") for (int _i = 0; _i < 2; ++_i) \
        __builtin_amdgcn_global_load_lds((const unsigned*)((const char*)(gbase) + (voff)[_i]), (PG8_LAS unsigned*)(lds + (bufoff) + ldsw + _i * 8192), 16, 0, 0); } while (0)
#define PG8_LDA(dst, b, h) do { _Pragma("unroll") for (int m = 0; m < 4; ++m) _Pragma("unroll") for (int k = 0; k < 2; ++k) dst[m][k] = *(const PG8_LAS bf16x8*)(lds + PG8_SA(b, h) + aoff + m * 2048 + k * 1024); } while (0)
#define PG8_LDB(dst, b, h) do { _Pragma("unroll") for (int n = 0; n < 2; ++n) _Pragma("unroll") for (int k = 0; k < 2; ++k) dst[n][k] = *(const PG8_LAS bf16x8*)(lds + PG8_SB(b, h) + boff + n * 2048 + k * 1024); } while (0)
#define PG8_MMA(ai, bj, At, Bt) do { __builtin_amdgcn_s_setprio(1); _Pragma("unroll") for (int m = 0; m < 4; ++m) _Pragma("unroll") for (int n = 0; n < 2; ++n) _Pragma("unroll") for (int k = 0; k < 2; ++k) \
        acc[ai][bj][m][n] = F16 ? __builtin_amdgcn_mfma_f32_16x16x32_f16(__builtin_bit_cast(f16x8, Bt[n][k]), __builtin_bit_cast(f16x8, At[m][k]), acc[ai][bj][m][n], 0, 0, 0) \
                                : __builtin_amdgcn_mfma_f32_16x16x32_bf16(Bt[n][k], At[m][k], acc[ai][bj][m][n], 0, 0, 0); __builtin_amdgcn_s_setprio(0); } while (0)
#define PG8_WAIT_V(n) asm volatile("s_waitcnt vmcnt(" #n ")" ::: "memory")
#define PG8_WAIT_L(n) asm volatile("s_waitcnt lgkmcnt(" #n ")" ::: "memory")
#define PG8_BAR __builtin_amdgcn_s_barrier()
#define PG8_SCHED __builtin_amdgcn_sched_barrier(0)
    Unit cur, nxt; int ui = 0;
    if (!S.next(0, cur)) return;
    f32x4 acc[2][2][4][2];
#pragma unroll
    for (int a = 0; a < 2; ++a)
#pragma unroll
        for (int b = 0; b < 2; ++b)
#pragma unroll
            for (int m = 0; m < 4; ++m)
#pragma unroll
                for (int n = 0; n < 2; ++n) acc[a][b][m][n] = (f32x4){0.f, 0.f, 0.f, 0.f};
    bf16x8 At[4][2], B0[2][2], B1[2][2];
    const char* cA = (const char*)g.A + (size_t)cur.pm * tstep; const char* cB = (const char*)g.Bt + (size_t)cur.pn * tstep;
    S.a_ready(cur);
    if constexpr (SP2) {
        PG8_STAGE(PG8_SB(0, 0), cB, voffB); PG8_STAGE(PG8_SB(0, 1), cB + hstep, voffB); PG8_STAGE(PG8_SA(0, 0), cA, voffA); PG8_STAGE(PG8_SA(0, 1), cA + hstep, voffA);
        if (wr == 1) PG8_BAR;
        PG8_WAIT_V(2); PG8_BAR;
        PG8_STAGE(PG8_SB(1, 0), cB + kstep, voffB); PG8_STAGE(PG8_SA(1, 0), cA + kstep, voffA); PG8_STAGE(PG8_SB(1, 1), cB + hstep + kstep, voffB);
        PG8_WAIT_V(6); PG8_BAR;
    } else {
        PG8_STAGE(PG8_SB(0, 0), cB, voffB); PG8_STAGE(PG8_SA(0, 0), cA, voffA); PG8_STAGE(PG8_SB(0, 1), cB + hstep, voffB); PG8_STAGE(PG8_SA(0, 1), cA + hstep, voffA);
        if (wr == 1) PG8_BAR;
        PG8_WAIT_V(4); PG8_BAR;
        PG8_STAGE(PG8_SB(1, 0), cB + kstep, voffB); PG8_STAGE(PG8_SA(1, 0), cA + kstep, voffA); PG8_STAGE(PG8_SB(1, 1), cB + hstep + kstep, voffB);
        PG8_WAIT_V(6); PG8_BAR;
    }
    for (;;) {
        const bool has_next = S.next(ui + 1, nxt);
        const char* nA = has_next ? (const char*)g.A + (size_t)nxt.pm * tstep : cA; const char* nB = has_next ? (const char*)g.Bt + (size_t)nxt.pn * tstep : cB;
        for (int t = 0; t < nt; t += 2) {
            const bool last = (t == nt - 2);
            const char* a1 = cA + (size_t)(t + 1) * kstep;
            const char* a2 = last ? nA : cA + (size_t)(t + 2) * kstep; const char* b2 = last ? nB : cB + (size_t)(t + 2) * kstep;
            const char* a3 = a2 + kstep; const char* b3 = b2 + kstep;
            if (last && has_next) S.a_ready(nxt);
            if constexpr (SP2) {
            PG8_LDB(B0, 0, 0); PG8_LDB(B1, 0, 1); PG8_SCHED; PG8_LDA(At, 0, 0); PG8_STAGE(PG8_SA(1, 1), a1 + hstep, voffA);
            PG8_WAIT_V(8); PG8_WAIT_L(0); PG8_BAR; PG8_MMA(0, 0, At, B0); PG8_MMA(0, 1, At, B1); PG8_BAR; PG8_SCHED;
            PG8_LDA(At, 0, 1); PG8_STAGE(PG8_SB(0, 0), b2, voffB); PG8_STAGE(PG8_SB(0, 1), b2 + hstep, voffB); PG8_STAGE(PG8_SA(0, 0), a2, voffA);
            PG8_WAIT_V(8); PG8_WAIT_L(0); PG8_BAR; PG8_MMA(1, 0, At, B0); PG8_MMA(1, 1, At, B1); PG8_BAR; PG8_SCHED;
            PG8_LDB(B0, 1, 0); PG8_LDB(B1, 1, 1); PG8_SCHED; PG8_LDA(At, 1, 0); PG8_STAGE(PG8_SA(0, 1), a2 + hstep, voffA);
            PG8_WAIT_V(8); PG8_WAIT_L(0); PG8_BAR; PG8_MMA(0, 0, At, B0); PG8_MMA(0, 1, At, B1); PG8_BAR; PG8_SCHED;
            PG8_LDA(At, 1, 1); PG8_STAGE(PG8_SB(1, 0), b3, voffB); PG8_STAGE(PG8_SB(1, 1), b3 + hstep, voffB); PG8_STAGE(PG8_SA(1, 0), a3, voffA);
            PG8_WAIT_V(8); PG8_WAIT_L(0); PG8_BAR; PG8_MMA(1, 0, At, B0); PG8_MMA(1, 1, At, B1); PG8_BAR; PG8_SCHED;
            } else {
            PG8_LDB(B0, 0, 0); PG8_SCHED; PG8_LDA(At, 0, 0); PG8_STAGE(PG8_SA(1, 1), a1 + hstep, voffA);
            PG8_WAIT_L(8); PG8_BAR; PG8_WAIT_L(0); PG8_MMA(0, 0, At, B0); PG8_BAR; PG8_SCHED;
            PG8_LDB(B1, 0, 1); PG8_STAGE(PG8_SB(0, 0), b2, voffB);
            PG8_BAR; PG8_WAIT_L(0); PG8_MMA(0, 1, At, B1); PG8_BAR;
            PG8_LDA(At, 0, 1); PG8_STAGE(PG8_SA(0, 0), a2, voffA);
            PG8_BAR; PG8_WAIT_L(0); PG8_MMA(1, 0, At, B0); PG8_BAR; PG8_SCHED;
            PG8_STAGE(PG8_SB(0, 1), b2 + hstep, voffB);
            PG8_WAIT_V(6); PG8_BAR; PG8_MMA(1, 1, At, B1); PG8_BAR;
            PG8_LDB(B0, 1, 0); PG8_SCHED; PG8_LDA(At, 1, 0); PG8_STAGE(PG8_SA(0, 1), a2 + hstep, voffA);
            PG8_WAIT_L(8); PG8_BAR; PG8_WAIT_L(0); PG8_MMA(0, 0, At, B0); PG8_BAR; PG8_SCHED;
            PG8_LDB(B1, 1, 1); PG8_STAGE(PG8_SB(1, 0), b3, voffB);
            PG8_BAR; PG8_WAIT_L(0); PG8_MMA(0, 1, At, B1); PG8_BAR;
            PG8_LDA(At, 1, 1); PG8_STAGE(PG8_SA(1, 0), a3, voffA);
            PG8_BAR; PG8_WAIT_L(0); PG8_MMA(1, 0, At, B0); PG8_BAR; PG8_SCHED;
            PG8_STAGE(PG8_SB(1, 1), b3 + hstep, voffB);
            PG8_WAIT_V(6); PG8_BAR; PG8_MMA(1, 1, At, B1); PG8_BAR;
            }
        }
        if constexpr (ALIGN_EPI) { if (wr == 0) PG8_BAR; }
        if constexpr (!Epi::AFTER_DRAIN) { E(acc, cur, wr, wc, fr, fq); S.done(cur); }
        if (!has_next) break;
#pragma unroll
        for (int a = 0; a < 2; ++a)
#pragma unroll
            for (int b = 0; b < 2; ++b)
#pragma unroll
                for (int m = 0; m < 4; ++m)
#pragma unroll
                    for (int n = 0; n < 2; ++n) acc[a][b][m][n] = (f32x4){0.f, 0.f, 0.f, 0.f};
        cur = nxt; cA = nA; cB = nB; ++ui;
        if constexpr (ALIGN_EPI) { if (wr == 1) PG8_BAR; }
    }
    PG8_WAIT_V(0);
    if constexpr (!ALIGN_EPI) { if (wr == 0) PG8_BAR; }
    PG8_BAR;
    if constexpr (Epi::AFTER_DRAIN) { E.fused(acc, cur, wr, wc, fr, fq, lds, wid, lane); S.done(cur); }
#undef PG8_SA
#undef PG8_SB
#undef PG8_STAGE
#undef PG8_LDA
#undef PG8_LDB
#undef PG8_MMA
#undef PG8_WAIT_V
#undef PG8_WAIT_L
#undef PG8_BAR
#undef PG8_SCHED
}
}

#define LAS __attribute__((address_space(3)))
typedef unsigned short bf16;
typedef unsigned v4u __attribute__((ext_vector_type(4)));
typedef unsigned v2u __attribute__((ext_vector_type(2)));
typedef float f32x4 __attribute__((ext_vector_type(4)));
typedef short bf16x8 __attribute__((ext_vector_type(8)));

constexpr int NWAVES = 8, NTHREADS = 512;
constexpr int D = 1024, FF = 2816, NB = 8, SEQ = 4096, NMETA = 16, DEPTH = 4;
constexpr int MMAIN = NB * SEQ;
constexpr int METAROW = MMAIN;
constexpr int MR = MMAIN + 256;
constexpr int INW = 2688, LDP = 2816;
constexpr int P_AQ = 0, P_AF = 384, P_AI = 768, P_AG = 1152, P_BQ = 1536, P_BK = 1920, P_BV = 2048, P_CU = 2176;
constexpr float EPS = 1e-6f;
constexpr int HG_NC = 65;
constexpr int HG_UNITS = NB * 6 * HG_NC;
constexpr int AT_UNITS = NB * 6 * 128 + 6;
constexpr int CV_UNITS = NB * 128 + 1;

constexpr size_t MiB = 1u << 20;
constexpr size_t WS_CTL = 0, CTL_ZERO_BYTES = 1 * MiB;
constexpr size_t WS_HM = 1 * MiB;
constexpr size_t WS_W = 2 * MiB;
constexpr size_t WL_GU1 = 0, WL_D1 = 11 * MiB, WL_IN = WL_D1 + 5632 * 1024, WL_OUT = 22 * MiB, WL_GU2 = 24 * MiB, WL_D2 = 35 * MiB, WL_STRIDE = 40 * MiB + 512 * 1024;
constexpr size_t WS_XN = 164 * MiB;
constexpr size_t WS_ACT = 229 * MiB;
constexpr size_t WS_DS = 407 * MiB;
constexpr size_t WS_ST = 456 * MiB;
constexpr size_t WS_DEC = 481 * MiB;
constexpr size_t WS_RSQ = 482 * MiB;
constexpr size_t WS_END = 484 * MiB;
static_assert(WS_W + 4 * WL_STRIDE <= WS_XN && WS_XN + (size_t)MR * D * 2 <= WS_ACT && WS_ACT + (size_t)MR * LDP * 2 <= WS_DS && WS_DS + (size_t)HG_UNITS * 4096 * 4 <= WS_ST && WS_ST + (size_t)HG_UNITS * 4096 * 2 <= WS_DEC && WS_DEC + (size_t)HG_UNITS * 64 * 4 <= WS_RSQ && WS_RSQ + (size_t)MMAIN * 64 <= WS_END, "ws map");
static_assert(WL_IN + (size_t)LDP * 1024 * 2 <= WL_OUT && WL_D2 + (size_t)1024 * FF * 2 <= WL_STRIDE, "weight map");

constexpr int TLD = 72;
constexpr int TILE_BYTES = 64 * TLD * 2;
constexpr int WAVE_LDS = 2 * TILE_BYTES + 512;
constexpr int LDS_BYTES = 155648;
constexpr int BAR_LDS_OFF = LDS_BYTES - 16;
static_assert(NWAVES * WAVE_LDS <= BAR_LDS_OFF && pg8::STAGE_BYTES <= BAR_LDS_OFF, "LDS map");

#define LDS_WAIT() asm volatile("s_waitcnt lgkmcnt(0)" ::: "memory")
__device__ __forceinline__ unsigned f2bf(float f) { unsigned u = __builtin_bit_cast(unsigned, f); return (u + 0x7fffu + ((u >> 16) & 1u)) >> 16; }
__device__ __forceinline__ unsigned pk2(float lo, float hi) { return f2bf(lo) | (f2bf(hi) << 16); }
__device__ __forceinline__ float bf2f(unsigned u) { return __builtin_bit_cast(float, u << 16); }
__device__ __forceinline__ float sigm(float z) { return __builtin_amdgcn_rcpf(1.0f + __expf(-z)); }
__device__ __forceinline__ unsigned bf1(float x) { return pg8::pk_bf16(x, 0.f) & 0xffffu; }
constexpr float L2E = 1.4426950408889634f;
__device__ __forceinline__ unsigned f2h(float f) { return pg8::pk_f16(f, 0.f) & 0xffffu; }
__device__ __forceinline__ unsigned pk2h(float lo, float hi) { return pg8::pk_f16(lo, hi); }
#define HG_GATE16(T, j0) float z2[16], a1[16], lf[16]; { float e_[16]; \
        _Pragma("unroll") for (int i = 0; i < 16; ++i) z2[i] = bf2f((T)[((j0) + i) * TLD + lane]) * L2E; \
        _Pragma("unroll") for (int i = 0; i < 16; ++i) e_[i] = __builtin_amdgcn_exp2f(-z2[i]); \
        _Pragma("unroll") for (int i = 0; i < 16; ++i) a1[i] = __builtin_amdgcn_logf(1.0f + e_[i]); \
        _Pragma("unroll") for (int i = 0; i < 16; ++i) lf[i] = __builtin_amdgcn_logf(1.0f + lb * e_[i]) - a1[i]; }
#define HG_GATE(zbits, z2, a1, lf2) const float z2 = bf2f(zbits) * L2E; const float E_ = __builtin_amdgcn_exp2f(-z2); const float a1 = __builtin_amdgcn_logf(1.0f + E_); \
        const float lf2 = (lb > 0.f ? __builtin_amdgcn_logf(1.0f + lb * E_) : 0.f) - a1;
__device__ __forceinline__ float shx(float v, int o, int lane) { return __builtin_bit_cast(float, __builtin_amdgcn_ds_bpermute((lane ^ o) << 2, __builtin_bit_cast(int, v))); }
__device__ __forceinline__ float wave_sum(float v, int lane) {
#pragma unroll
    for (int o = 1; o < 64; o <<= 1) v += shx(v, o, lane);
    return v;
}

struct Args { const float* in[21]; float* out; unsigned char* ws; int pc_lo, pc_hi; };
typedef const __attribute__((address_space(4))) Args* ArgsP;
struct InView { ArgsP ap; __device__ __forceinline__ const float* operator[](int i) const { return ap->in[i]; } };
struct Ctx {
    InView in; float* out; unsigned char* ws;
    LAS unsigned char* lds;
    int tid, lane, wave, G, gw, NGW;
};

__device__ __forceinline__ void transpose_item(const float* W, int K, int N, const float* gain, bf16* WT, int mode, bool f16, LAS float* scr, int item, int lane) {
    const int nblk = N / 32, kb = item / nblk, nb = item % nblk, k0 = 64 * kb, n0 = 32 * nb;
    f32x4 v[8];
#pragma unroll
    for (int i = 0; i < 8; ++i) v[i] = *(const f32x4*)(W + (size_t)(k0 + 8 * i + (lane >> 3)) * N + n0 + 4 * (lane & 7));
#pragma unroll
    for (int i = 0; i < 8; ++i) { const int kk = 8 * i + (lane >> 3); const float g = gain ? gain[k0 + kk] : 1.0f; LAS float* d = scr + kk * 33 + 4 * (lane & 7);
        d[0] = v[i][0] * g; d[1] = v[i][1] * g; d[2] = v[i][2] * g; d[3] = v[i][3] * g; }
    LDS_WAIT();
    const int c = lane & 7;
#pragma unroll
    for (int j = 0; j < 4; ++j) { const int nl = (lane >> 3) + 8 * j; const LAS float* s = scr + (8 * c) * 33 + nl; const int n = n0 + nl;
        const int dr = mode == 0 ? n : ((n >> 7) * 256 + (n & 127) + (mode == 2 ? 128 : 0));
        v4u o; if (f16) { o.x = pk2h(s[0 * 33], s[1 * 33]); o.y = pk2h(s[2 * 33], s[3 * 33]); o.z = pk2h(s[4 * 33], s[5 * 33]); o.w = pk2h(s[6 * 33], s[7 * 33]); }
        else { o.x = pk2(s[0 * 33], s[1 * 33]); o.y = pk2(s[2 * 33], s[3 * 33]); o.z = pk2(s[4 * 33], s[5 * 33]); o.w = pk2(s[6 * 33], s[7 * 33]); }
        *(v4u*)(WT + (size_t)dr * K + k0 + 8 * c) = o; }
    LDS_WAIT();
}
__device__ __forceinline__ void convert_weights(Ctx& F, int lyr, int w0, int nw) {
    LAS float* scr = (LAS float*)(F.lds + F.wave * WAVE_LDS);
    constexpr int I_G = 16 * 88, I_D = 44 * 32, I_IN = 16 * 84, I_OUT = 16 * 32, I_LAYER = 6 * 1408 + I_IN + I_OUT;
    static_assert(I_G == 1408 && I_D == 1408, "items");
    for (int it = w0; it < I_LAYER; it += nw) {
        const int l = lyr; int r = it;
        bf16* wl = (bf16*)(F.ws + WS_W + (size_t)l * WL_STRIDE);
        const size_t og = (size_t)l * D * FF, od = (size_t)l * FF * D;
        if (r < I_G) { transpose_item(F.in[3] + og, D, FF, F.in[2] + l * D, (bf16*)((unsigned char*)wl + WL_GU1), 1, true, scr, r, F.lane); continue; } r -= I_G;
        if (r < I_G) { transpose_item(F.in[4] + og, D, FF, F.in[2] + l * D, (bf16*)((unsigned char*)wl + WL_GU1), 2, true, scr, r, F.lane); continue; } r -= I_G;
        if (r < I_D) { transpose_item(F.in[5] + od, FF, D, nullptr, (bf16*)((unsigned char*)wl + WL_D1), 0, false, scr, r, F.lane); continue; } r -= I_D;
        if (r < I_IN) { transpose_item(F.in[7] + (size_t)l * D * INW, D, INW, F.in[6] + l * D, (bf16*)((unsigned char*)wl + WL_IN), 0, true, scr, r, F.lane); continue; } r -= I_IN;
        if (r < I_OUT) { transpose_item(F.in[8] + (size_t)l * D * D, D, D, nullptr, (bf16*)((unsigned char*)wl + WL_OUT), 0, false, scr, r, F.lane); continue; } r -= I_OUT;
        if (r < I_G) { transpose_item(F.in[17] + og, D, FF, F.in[16] + l * D, (bf16*)((unsigned char*)wl + WL_GU2), 1, true, scr, r, F.lane); continue; } r -= I_G;
        if (r < I_G) { transpose_item(F.in[18] + og, D, FF, F.in[16] + l * D, (bf16*)((unsigned char*)wl + WL_GU2), 2, true, scr, r, F.lane); continue; } r -= I_G;
        transpose_item(F.in[19] + od, FF, D, nullptr, (bf16*)((unsigned char*)wl + WL_D2), 0, false, scr, r, F.lane);
    }
    for (int i = w0 * 64 + F.lane; i < 128 * 128; i += nw * 64)
        *(v4u*)(F.ws + WS_W + (size_t)lyr * WL_STRIDE + WL_IN + (size_t)INW * 1024 * 2 + (size_t)i * 16) = (v4u){0u, 0u, 0u, 0u};
}
__device__ __forceinline__ int win_nfull(int G) { return (MMAIN / 256 * (LDP / 256)) % G; }
__device__ __forceinline__ void prologue(Ctx& F) {
    const int nfull = win_nfull(F.G);
    for (int lyr = 0; lyr < (nfull == 0 ? DEPTH : 1); ++lyr) convert_weights(F, lyr, F.gw, F.NGW);
    {
        bf16* xn = (bf16*)(F.ws + WS_XN); float* rsq = (float*)(F.ws + WS_RSQ); const float* x = F.in[0];
        for (int row = 2 * F.gw; row < MMAIN; row += 2 * F.NGW) {
            const f32x4* xr = (const f32x4*)(x + (size_t)row * D) + F.lane; f32x4 v[8]; float s0 = 0.f, s1 = 0.f;
#pragma unroll
            for (int j = 0; j < 8; ++j) v[j] = xr[64 * j];
#pragma unroll
            for (int j = 0; j < 4; ++j) { s0 += (v[j].x * v[j].x + v[j].y * v[j].y) + (v[j].z * v[j].z + v[j].w * v[j].w); s1 += (v[4 + j].x * v[4 + j].x + v[4 + j].y * v[4 + j].y) + (v[4 + j].z * v[4 + j].z + v[4 + j].w * v[4 + j].w); }
            s0 = wave_sum(s0, F.lane); s1 = wave_sum(s1, F.lane);
            v2u* o8 = (v2u*)(xn + (size_t)row * D) + F.lane;
#pragma unroll
            for (int j = 0; j < 8; ++j) { v2u w; w.x = pk2h(v[j].x, v[j].y); w.y = pk2h(v[j].z, v[j].w); o8[64 * j] = w; }
            if (F.lane < 32) rsq[(size_t)row * 16 + F.lane] = F.lane == 0 ? s0 : (F.lane == 16 ? s1 : 0.f);
        }
    }
    const int gt = F.gw * 64 + F.lane, NGT = F.NGW * 64;
    for (int i = gt; i < 256 * 256; i += NGT) { const int row = i >> 8, c4 = (i & 255) * 4;
        f32x4 v = (f32x4){0.f, 0.f, 0.f, 0.f}; if (row < NMETA) v = *(const f32x4*)(F.in[1] + row * D + c4);
        *(f32x4*)((float*)(F.ws + WS_HM) + row * D + c4) = v; }
}

__device__ __forceinline__ void norm_phase(Ctx& F, const float* main_src) {
    const float* hm = (const float*)(F.ws + WS_HM); bf16* xn = (bf16*)(F.ws + WS_XN);
    for (int row = F.gw; row < MMAIN + NMETA; row += F.NGW) {
        const float* src = row < MMAIN ? main_src + (size_t)row * D : hm + (size_t)(row - MMAIN) * D;
        const f32x4* xr = (const f32x4*)src + F.lane;
        f32x4 v[4]; float s = 0.f;
#pragma unroll
        for (int j = 0; j < 4; ++j) { v[j] = xr[64 * j]; s += (v[j].x * v[j].x + v[j].y * v[j].y) + (v[j].z * v[j].z + v[j].w * v[j].w); }
        const float rinv = rsqrtf(wave_sum(s, F.lane) * (1.f / D) + EPS);
        v2u* o8 = (v2u*)(xn + (size_t)row * D) + F.lane;
#pragma unroll
        for (int j = 0; j < 4; ++j) { v2u w; w.x = pg8::pk_bf16(v[j].x * rinv, v[j].y * rinv); w.y = pg8::pk_bf16(v[j].z * rinv, v[j].w * rinv); o8[64 * j] = w; }
    }
}
__device__ __forceinline__ void final_phase(Ctx& F) {
    const float* gn = F.in[20]; const unsigned short* hb = (const unsigned short*)(F.ws + WS_XN);
    for (int row = F.gw; row < MMAIN; row += F.NGW) {
        const pg8::f16x4* hr = (const pg8::f16x4*)(hb + (size_t)row * D) + F.lane;
        f32x4 v[4]; float s = 0.f;
#pragma unroll
        for (int j = 0; j < 4; ++j) { const pg8::f16x4 h = hr[64 * j]; v[j] = (f32x4){(float)h[0], (float)h[1], (float)h[2], (float)h[3]}; s += (v[j].x * v[j].x + v[j].y * v[j].y) + (v[j].z * v[j].z + v[j].w * v[j].w); }
        const float rinv = rsqrtf(wave_sum(s, F.lane) * (1.f / D) + EPS);
        f32x4* xr = (f32x4*)(F.out + (size_t)row * D) + F.lane;
#pragma unroll
        for (int j = 0; j < 4; ++j) { const f32x4 g = *((const f32x4*)gn + F.lane + 64 * j); xr[64 * j] = v[j] * rinv * g; }
    }
}

__device__ __forceinline__ bf16x8 lds_frag(const LAS bf16* T, int tile, int kk, int r, int q) { return *(const LAS bf16x8*)(T + (16 * tile + r) * TLD + 32 * kk + 8 * q); }
__device__ __forceinline__ void wave_mma64(const LAS bf16* X, const LAS bf16* Y, f32x4 (&acc)[4][4], int r, int q) {
#pragma unroll
    for (int kk = 0; kk < 2; ++kk) {
        bf16x8 xf[4], yf[4];
#pragma unroll
        for (int i = 0; i < 4; ++i) { xf[i] = lds_frag(X, i, kk, r, q); yf[i] = lds_frag(Y, i, kk, r, q); }
#pragma unroll
        for (int it = 0; it < 4; ++it)
#pragma unroll
            for (int jt = 0; jt < 4; ++jt) acc[it][jt] = __builtin_amdgcn_mfma_f32_16x16x32_bf16(xf[it], yf[jt], acc[it][jt], 0, 0, 0);
    }
}
#define ZERO_ACC(a) do { _Pragma("unroll") for (int _i = 0; _i < 4; ++_i) _Pragma("unroll") for (int _j = 0; _j < 4; ++_j) a[_i][_j] = (f32x4){0.f, 0.f, 0.f, 0.f}; } while (0)


template <int KIND, int KSTEPS, bool AF32>
__device__ __forceinline__ void skinny_gemm(Ctx& F, const bf16* A, int lda, const bf16* Bt, int nslab, bf16* O, int ldo, float* hm, float scale) {
    constexpr int K = KSTEPS * 32 * 8, NBT = KIND == 0 ? 2 : 1;
    const int lane = F.lane, r = lane & 15, q = lane >> 4, w = F.wave, tid = F.tid;
    LAS float* part = (LAS float*)F.lds;
    LAS float* partsq = part + 8 * NBT * 256;
    for (int slab = F.gw / NWAVES; slab < nslab; slab += F.G) {
        const int brow0 = KIND == 0 ? ((slab * 16) >> 7) * 256 + ((slab * 16) & 127) : slab * 16;
        bf16x8 af[KSTEPS], bfr[NBT][KSTEPS];
#pragma unroll
        for (int t = 0; t < NBT; ++t) { const bf16* bp = Bt + (size_t)(brow0 + 128 * t + r) * K + w * (K / 8) + 8 * q;
#pragma unroll
            for (int kk = 0; kk < KSTEPS; ++kk) bfr[t][kk] = *(const bf16x8*)(bp + 32 * kk); }
        if (AF32) { const float* ap = hm + (size_t)r * D + w * (K / 8) + 8 * q; float ssq = 0.f;
#pragma unroll
            for (int kk = 0; kk < KSTEPS; ++kk) { const f32x4 x0 = *(const f32x4*)(ap + 32 * kk), x1 = *(const f32x4*)(ap + 32 * kk + 4);
                ssq += ((x0[0] * x0[0] + x0[1] * x0[1]) + (x0[2] * x0[2] + x0[3] * x0[3])) + ((x1[0] * x1[0] + x1[1] * x1[1]) + (x1[2] * x1[2] + x1[3] * x1[3]));
                v4u pk; pk.x = pk2h(x0[0], x0[1]); pk.y = pk2h(x0[2], x0[3]); pk.z = pk2h(x1[0], x1[1]); pk.w = pk2h(x1[2], x1[3]); af[kk] = __builtin_bit_cast(bf16x8, pk); }
            ssq += shx(ssq, 16, lane); ssq += shx(ssq, 32, lane);
            if (q == 0) partsq[w * 16 + r] = ssq;
        } else { const bf16* ap = A + (size_t)r * lda + w * (K / 8) + 8 * q;
#pragma unroll
            for (int kk = 0; kk < KSTEPS; ++kk) af[kk] = *(const bf16x8*)(ap + 32 * kk); }
#pragma unroll
        for (int t = 0; t < NBT; ++t) { f32x4 acc = (f32x4){0.f, 0.f, 0.f, 0.f};
#pragma unroll
            for (int kk = 0; kk < KSTEPS; ++kk) acc = AF32 ? __builtin_amdgcn_mfma_f32_16x16x32_f16(__builtin_bit_cast(pg8::f16x8, bfr[t][kk]), __builtin_bit_cast(pg8::f16x8, af[kk]), acc, 0, 0, 0)
                                                           : __builtin_amdgcn_mfma_f32_16x16x32_bf16(bfr[t][kk], af[kk], acc, 0, 0, 0);
#pragma unroll
            for (int e = 0; e < 4; ++e) part[(w * NBT + t) * 256 + (4 * q + e) * 16 + r] = acc[e]; }
        __syncthreads();
        if (tid < 256) { const int tok = tid >> 4, n = tid & 15; float s = 0.f, s2 = 0.f, sq = 0.f;
#pragma unroll
            for (int ww = 0; ww < 8; ++ww) { s += part[(ww * NBT) * 256 + n * 16 + tok]; if (KIND == 0) s2 += part[(ww * NBT + 1) * 256 + n * 16 + tok]; if (AF32) sq += partsq[ww * 16 + tok]; }
            if (AF32) { const float rinv = rsqrtf(sq * (1.0f / D) + EPS); s *= rinv; s2 *= rinv; }
            if (KIND == 0) O[(size_t)(METAROW + tok) * ldo + slab * 16 + n] = (bf16)f2bf(pg8::silu_f(s) * s2);
            else if (KIND == 1) hm[tok * D + slab * 16 + n] += scale * s;
            else O[(size_t)(METAROW + tok) * ldo + slab * 16 + n] = (bf16)f2bf(s); }
        __syncthreads();
    }
}

constexpr int RTAB_OFF = pg8::STAGE_BYTES, RTAB_UNITS = 12;
static_assert(RTAB_OFF + RTAB_UNITS * 256 * 4 <= BAR_LDS_OFF, "rinv table");
__device__ __forceinline__ void build_rinv_table(Ctx& F, const pg8::StaticOrder& S, const float* rowsq) {
    LAS float* tab = (LAS float*)(F.lds + RTAB_OFF);
    const int rl = F.tid >> 1, h = F.tid & 1;
    f32x4 a[RTAB_UNITS], b[RTAB_UNITS]; bool ok[RTAB_UNITS];
#pragma unroll
    for (int i = 0; i < RTAB_UNITS; ++i) { pg8::Unit u; ok[i] = S.next(i, u);
        if (ok[i]) { const f32x4* rp = (const f32x4*)(rowsq + (size_t)(u.pm * 256 + rl) * 16 + h * 8); a[i] = rp[0]; b[i] = rp[1]; } }
#pragma unroll
    for (int i = 0; i < RTAB_UNITS; ++i) if (ok[i]) { float s = ((a[i][0] + a[i][1]) + (a[i][2] + a[i][3])) + ((b[i][0] + b[i][1]) + (b[i][2] + b[i][3]));
        s += shx(s, 1, F.lane);
        if (h == 0) tab[i * 256 + rl] = rsqrtf(s * (1.0f / D) + EPS); }
    __syncthreads();
}

__device__ __forceinline__ float lb_of(const float* lg, int l, int ch) {
    const float x0 = lg[ch], x1 = lg[384 + ch], x2 = lg[768 + ch], x3 = lg[1152 + ch];
    const float m = fmaxf(fmaxf(x0, x1), fmaxf(x2, x3));
    const float e0 = __expf(x0 - m), e1 = __expf(x1 - m), e2 = __expf(x2 - m), e3 = __expf(x3 - m);
    float c = 0.f; if (l >= 1) c += e1; if (l >= 2) c += e2; if (l >= 3) c += e3;
    return c / (e0 + e1 + e2 + e3);
}
__device__ __forceinline__ int hg_row(int b, int c, int j) { return c == 0 ? (j < 48 ? -1 : METAROW + j - 48) : b * SEQ + (c - 1) * 64 + j; }

#define HG_LOAD_TILE(dst, col0) do { _Pragma("unroll") for (int _i = 0; _i < 8; ++_i) { const int _row = hg_row(b, c, (lane >> 3) + 8 * _i); \
        dst[_i] = *(const v4u*)(P + (size_t)(_row >= 0 ? _row : METAROW) * LDP + (col0) + hd * 64 + 8 * (lane & 7)); if (_row < 0) dst[_i] = (v4u){0u, 0u, 0u, 0u}; } } while (0)
#define HG_STORE_TILE(T, src) do { _Pragma("unroll") for (int _i = 0; _i < 8; ++_i) *(LAS v4u*)((T) + ((lane >> 3) + 8 * _i) * TLD + 8 * (lane & 7)) = src[_i]; } while (0)
#define HG_STORE_TILE_T(T, src) do { _Pragma("unroll") for (int _i = 0; _i < 8; ++_i) { const int _t = (lane >> 3) + 8 * _i; LAS bf16* _d = (T) + (8 * (lane & 7)) * TLD + _t; \
        _d[0 * TLD] = (bf16)(src[_i].x & 0xffffu); _d[1 * TLD] = (bf16)(src[_i].x >> 16); _d[2 * TLD] = (bf16)(src[_i].y & 0xffffu); _d[3 * TLD] = (bf16)(src[_i].y >> 16); \
        _d[4 * TLD] = (bf16)(src[_i].z & 0xffffu); _d[5 * TLD] = (bf16)(src[_i].z >> 16); _d[6 * TLD] = (bf16)(src[_i].w & 0xffffu); _d[7 * TLD] = (bf16)(src[_i].w >> 16); } } while (0)

__device__ __forceinline__ void hgrn_p1_unit(Ctx& F, int l, int unit) {
    const int lane = F.lane, r = lane & 15, q = lane >> 4;
    const int bh = unit / HG_NC, c = unit % HG_NC, b = bh / 6, hd = bh % 6, ch = hd * 64 + lane;
    const bf16* P = (const bf16*)(F.ws + WS_ACT);
    LAS bf16* T0 = (LAS bf16*)(F.lds + F.wave * WAVE_LDS); LAS bf16* T1 = T0 + 64 * TLD;
    v4u zraw[8], vraw[8];
    HG_LOAD_TILE(zraw, P_AF); HG_LOAD_TILE(vraw, P_AI);
    const float lb = lb_of(F.in[9], l, ch), oml = 1.0f - lb;
    HG_STORE_TILE(T1, zraw);
    LDS_WAIT();
    const int jlo = c == 0 ? 48 : 0;
    const float lom2 = __builtin_amdgcn_logf(oml);
    float G = 0.f;
    for (int j0 = jlo; j0 < 64; j0 += 16) { HG_GATE16(T1, j0);
#pragma unroll
        for (int i = 0; i < 16; ++i) G += lf[i]; }
    const float Glast = G; G = 0.f;
    for (int j = 0; j < jlo; ++j) T0[lane * TLD + j] = (bf16)0;
    for (int j0 = jlo; j0 < 64; j0 += 16) { HG_GATE16(T1, j0); float kx[16];
#pragma unroll
        for (int i = 0; i < 16; ++i) { G += lf[i]; kx[i] = (lom2 - z2[i] - a1[i]) + (Glast - G); }
#pragma unroll
        for (int i = 0; i < 16; ++i) kx[i] = __builtin_amdgcn_exp2f(kx[i]);
#pragma unroll
        for (int i = 0; i < 16; ++i) T0[lane * TLD + j0 + i] = (bf16)bf1(kx[i]); }
    ((float*)(F.ws + WS_DEC))[(size_t)unit * 64 + lane] = __builtin_amdgcn_exp2f(Glast);
    LDS_WAIT();
    HG_STORE_TILE_T(T1, vraw);
    LDS_WAIT();
    f32x4 acc[4][4]; ZERO_ACC(acc);
    wave_mma64(T1, T0, acc, r, q);
    float* ds = (float*)(F.ws + WS_DS) + (size_t)unit * 4096;
#pragma unroll
    for (int it = 0; it < 4; ++it)
#pragma unroll
        for (int jt = 0; jt < 4; ++jt)
#pragma unroll
            for (int e = 0; e < 4; ++e) ds[(16 * it + 4 * q + e) * 64 + 16 * jt + r] = acc[it][jt][e];
    LDS_WAIT();
}
__device__ __forceinline__ void hgrn_scan(Ctx& F) {
    typedef float f32x2v __attribute__((ext_vector_type(2)));
    const float* __restrict__ ds = (const float*)(F.ws + WS_DS); const float* __restrict__ dec = (const float*)(F.ws + WS_DEC); bf16* __restrict__ st = (bf16*)(F.ws + WS_ST);
    const int gt = F.gw * 64 + F.lane, NGT = F.NGW * 64;
    for (int idx = gt; idx < NB * 6 * 2048; idx += NGT) {
        const int bh = idx >> 11, e = (idx & 2047) * 2, dk = e & 63; float r0 = 0.f, r1 = 0.f;
        const size_t u0 = (size_t)bh * HG_NC;
#pragma unroll
        for (int c0 = 0; c0 < HG_NC; c0 += 33) {
            f32x2v d[33], x[33];
#pragma unroll
            for (int j = 0; j < 33; ++j) if (c0 + j < HG_NC) { d[j] = *(const f32x2v*)(dec + (u0 + c0 + j) * 64 + dk); x[j] = *(const f32x2v*)(ds + (u0 + c0 + j) * 4096 + e); }
#pragma unroll
            for (int j = 0; j < 33; ++j) if (c0 + j < HG_NC) { *(unsigned*)(st + (u0 + c0 + j) * 4096 + e) = pk2(r0, r1); r0 = r0 * d[j].x + x[j].x; r1 = r1 * d[j].y + x[j].y; }
        }
    }
}
__device__ __forceinline__ void hgrn_p3_unit(Ctx& F, int l, int unit) {
    const int lane = F.lane, r = lane & 15, q = lane >> 4;
    const int bh = unit / HG_NC, c = unit % HG_NC, b = bh / 6, hd = bh % 6, ch = hd * 64 + lane;
    if (c == 0 && b > 0) return;
    const bf16* P = (const bf16*)(F.ws + WS_ACT); bf16* Y = (bf16*)F.out;
    LAS bf16* T0 = (LAS bf16*)(F.lds + F.wave * WAVE_LDS); LAS bf16* T1 = T0 + 64 * TLD; LAS float* EG = (LAS float*)(T1 + 64 * TLD);
    {
        v4u zraw[8], qraw[8];
        HG_LOAD_TILE(zraw, P_AF); HG_LOAD_TILE(qraw, P_AQ);
        HG_STORE_TILE(T1, zraw); HG_STORE_TILE(T0, qraw);
    }
    const float lb = lb_of(F.in[9], l, ch), oml = 1.0f - lb;
    LDS_WAIT();
    const int jlo = c == 0 ? 48 : 0;
    const float lom2 = __builtin_amdgcn_logf(oml);
    float G = 0.f;
    for (int j0 = jlo; j0 < 32; j0 += 16) { HG_GATE16(T1, j0);
#pragma unroll
        for (int i = 0; i < 16; ++i) G += lf[i]; }
    const float Gm = G; G = 0.f;
    for (int j0 = jlo; j0 < 64; j0 += 16) { HG_GATE16(T1, j0); float qx[16], kx[16], qv[16];
#pragma unroll
        for (int i = 0; i < 16; ++i) qv[i] = bf2f(T0[(j0 + i) * TLD + lane]);
#pragma unroll
        for (int i = 0; i < 16; ++i) { G += lf[i]; qx[i] = G - Gm; kx[i] = (lom2 - z2[i] - a1[i]) + (Gm - G); }
#pragma unroll
        for (int i = 0; i < 16; ++i) { qx[i] = __builtin_amdgcn_exp2f(qx[i]); kx[i] = __builtin_amdgcn_exp2f(kx[i]); }
#pragma unroll
        for (int i = 0; i < 16; ++i) { T0[(j0 + i) * TLD + lane] = (bf16)bf1(qv[i] * qx[i]); T1[(j0 + i) * TLD + lane] = (bf16)bf1(kx[i]); } }
    EG[lane] = __builtin_amdgcn_exp2f(Gm);
    LDS_WAIT();
    f32x4 accA[4][4], accO[4][4]; ZERO_ACC(accA); ZERO_ACC(accO);
    wave_mma64(T1, T0, accA, r, q);
    {
        const bf16* st = (const bf16*)(F.ws + WS_ST) + (size_t)unit * 4096;
#pragma unroll
        for (int kk = 0; kk < 2; ++kk) {
            bf16x8 yf[4]; float eg[8]; v4u raw[4];
#pragma unroll
            for (int it = 0; it < 4; ++it) raw[it] = *(const v4u*)(st + (16 * it + r) * 64 + 32 * kk + 8 * q);
#pragma unroll
            for (int i = 0; i < 4; ++i) yf[i] = lds_frag(T0, i, kk, r, q);
#pragma unroll
            for (int j = 0; j < 8; ++j) eg[j] = EG[32 * kk + 8 * q + j];
#pragma unroll
            for (int it = 0; it < 4; ++it) {
                v4u sc;
                sc.x = pk2(bf2f(raw[it].x & 0xffffu) * eg[0], bf2f(raw[it].x >> 16) * eg[1]); sc.y = pk2(bf2f(raw[it].y & 0xffffu) * eg[2], bf2f(raw[it].y >> 16) * eg[3]);
                sc.z = pk2(bf2f(raw[it].z & 0xffffu) * eg[4], bf2f(raw[it].z >> 16) * eg[5]); sc.w = pk2(bf2f(raw[it].w & 0xffffu) * eg[6], bf2f(raw[it].w >> 16) * eg[7]);
                const bf16x8 xf = __builtin_bit_cast(bf16x8, sc);
#pragma unroll
                for (int jt = 0; jt < 4; ++jt) accO[it][jt] = __builtin_amdgcn_mfma_f32_16x16x32_bf16(xf, yf[jt], accO[it][jt], 0, 0, 0);
            }
        }
    }
    v4u vraw[8];
    HG_LOAD_TILE(vraw, P_AI);
    LDS_WAIT();
#pragma unroll
    for (int it = 0; it < 4; ++it)
#pragma unroll
        for (int jt = 0; jt < 4; ++jt) { const int t = 16 * jt + r, s0 = 16 * it + 4 * q; const f32x4 a = accA[it][jt];
            v2u w; w.x = pk2(s0 + 0 <= t ? a[0] : 0.f, s0 + 1 <= t ? a[1] : 0.f); w.y = pk2(s0 + 2 <= t ? a[2] : 0.f, s0 + 3 <= t ? a[3] : 0.f);
            *(LAS v2u*)(T0 + t * TLD + s0) = w; }
    HG_STORE_TILE_T(T1, vraw);
    LDS_WAIT();
    wave_mma64(T1, T0, accO, r, q);
    const float* og = F.in[10] + l * 64;
    v2u graw[4][4]; f32x4 gn[4];
#pragma unroll
    for (int it = 0; it < 4; ++it) gn[it] = *(const f32x4*)(og + 16 * it + 4 * q);
#pragma unroll
    for (int jt = 0; jt < 4; ++jt) { const int row = hg_row(b, c, 16 * jt + r);
#pragma unroll
        for (int it = 0; it < 4; ++it) graw[jt][it] = *(const v2u*)(P + (size_t)(row >= 0 ? row : METAROW) * LDP + P_AG + hd * 64 + 16 * it + 4 * q); }
#pragma unroll
    for (int jt = 0; jt < 4; ++jt) {
        const int t = 16 * jt + r, row = hg_row(b, c, t);
        float ss = 0.f;
#pragma unroll
        for (int it = 0; it < 4; ++it) { const f32x4 o = accO[it][jt]; ss += (o[0] * o[0] + o[1] * o[1]) + (o[2] * o[2] + o[3] * o[3]); }
        ss += shx(ss, 16, lane); ss += shx(ss, 32, lane);
        const float rinv = rsqrtf(ss * (1.0f / 64.0f) + EPS);
        if (row >= 0) {
#pragma unroll
            for (int it = 0; it < 4; ++it) { const int dv0 = 16 * it + 4 * q; const f32x4 o = accO[it][jt]; const v2u gr = graw[jt][it];
                const float g0 = bf2f(gr.x & 0xffffu), g1 = bf2f(gr.x >> 16), g2 = bf2f(gr.y & 0xffffu), g3 = bf2f(gr.y >> 16);
                v2u w; w.x = pg8::pk_bf16(o[0] * rinv * gn[it][0] * pg8::silu_f(g0), o[1] * rinv * gn[it][1] * pg8::silu_f(g1)); w.y = pg8::pk_bf16(o[2] * rinv * gn[it][2] * pg8::silu_f(g2), o[3] * rinv * gn[it][3] * pg8::silu_f(g3));
                *(v2u*)(Y + (size_t)row * D + hd * 64 + dv0) = w; }
        }
    }
    LDS_WAIT();
}

struct AtTile { bf16x8 kf[2][2]; bf16x8 vf[4]; };
__device__ __forceinline__ void attn_load(AtTile& T, const bf16* P, int krow_a, int krow_b, int kcol, int vcol, int r, int q) {
#pragma unroll
    for (int kk = 0; kk < 2; ++kk) { T.kf[0][kk] = *(const bf16x8*)(P + (size_t)(krow_a + r) * LDP + kcol + 32 * kk + 8 * q); T.kf[1][kk] = *(const bf16x8*)(P + (size_t)(krow_b + r) * LDP + kcol + 32 * kk + 8 * q); }
#pragma unroll
    for (int it = 0; it < 4; ++it) { const bf16* va = P + (size_t)(krow_a + 4 * q) * LDP + vcol + 16 * it + r; const bf16* vb = P + (size_t)(krow_b + 4 * q) * LDP + vcol + 16 * it + r;
#pragma unroll
        for (int j = 0; j < 4; ++j) { T.vf[it][j] = (short)va[(size_t)j * LDP]; T.vf[it][4 + j] = (short)vb[(size_t)j * LDP]; } }
}
__device__ __forceinline__ void attn_compute(const AtTile& T, const bf16x8 (&qf)[2][2], f32x4 (&accO)[4][2], float (&mrow)[2], float (&lrow)[2], int mode, int dpos, int r, int q) {
    const int lane = 16 * q + r;
    f32x4 s[2][2];
#pragma unroll
    for (int it = 0; it < 2; ++it)
#pragma unroll
        for (int jt = 0; jt < 2; ++jt) { s[it][jt] = (f32x4){0.f, 0.f, 0.f, 0.f};
#pragma unroll
            for (int kk = 0; kk < 2; ++kk) s[it][jt] = __builtin_amdgcn_mfma_f32_16x16x32_bf16(T.kf[it][kk], qf[jt][kk], s[it][jt], 0, 0, 0); }
    const float NEG = -INFINITY;
    bf16x8 pf[2];
#pragma unroll
    for (int jt = 0; jt < 2; ++jt) {
        float mx = NEG;
#pragma unroll
        for (int it = 0; it < 2; ++it)
#pragma unroll
            for (int e = 0; e < 4; ++e) { const int key = 16 * it + 4 * q + e, t = 16 * jt + r; bool valid;
                if (mode == 0) { const int dd = dpos + t - key; valid = dd >= 0 && dd < 128; } else if (mode == 1) valid = key < 16; else valid = key <= t && key < 16;
                const float v = valid ? s[it][jt][e] * 0.125f : NEG; s[it][jt][e] = v; mx = fmaxf(mx, v); }
        mx = fmaxf(mx, shx(mx, 16, lane)); mx = fmaxf(mx, shx(mx, 32, lane));
        const float mn = fmaxf(mrow[jt], mx), alpha = __expf(mrow[jt] - mn); mrow[jt] = mn;
        float ps = 0.f;
#pragma unroll
        for (int it = 0; it < 2; ++it)
#pragma unroll
            for (int e = 0; e < 4; ++e) { const float pe = __expf(s[it][jt][e] - mn); s[it][jt][e] = pe; ps += pe; }
        ps += shx(ps, 16, lane); ps += shx(ps, 32, lane);
        lrow[jt] = lrow[jt] * alpha + ps;
#pragma unroll
        for (int it = 0; it < 4; ++it) accO[it][jt] = accO[it][jt] * alpha;
        v4u w; w.x = pg8::pk_bf16(s[0][jt][0], s[0][jt][1]); w.y = pg8::pk_bf16(s[0][jt][2], s[0][jt][3]); w.z = pg8::pk_bf16(s[1][jt][0], s[1][jt][1]); w.w = pg8::pk_bf16(s[1][jt][2], s[1][jt][3]);
        pf[jt] = __builtin_bit_cast(bf16x8, w);
    }
#pragma unroll
    for (int it = 0; it < 4; ++it)
#pragma unroll
        for (int jt = 0; jt < 2; ++jt) accO[it][jt] = __builtin_amdgcn_mfma_f32_16x16x32_bf16(T.vf[it], pf[jt], accO[it][jt], 0, 0, 0);
}
__device__ __forceinline__ void attn_unit(Ctx& F, int l, int unit) {
    const int lane = F.lane, r = lane & 15, q = lane >> 4;
    const bf16* P = (const bf16*)(F.ws + WS_ACT); bf16* Y = (bf16*)F.out;
    const bool is_meta = unit >= NB * 6 * 128;
    int b = 0, hq, t0 = 0;
    if (is_meta) hq = unit - NB * 6 * 128; else { b = unit / 768; const int rem = unit % 768; hq = rem >> 7; t0 = (rem & 127) * 32; }
    const int kvh = hq / 3; const float sink = F.in[11][l * 6 + hq];
    const int qrow0 = is_meta ? METAROW : b * SEQ + t0;
    const int kcol = P_BK + kvh * 64, vcol = P_BV + kvh * 64;
    int first = is_meta ? 5 : (t0 >= 128 ? 0 : (128 - t0) / 32);
    AtTile cur, nxt;
    if (first < 5) attn_load(cur, P, b * SEQ + t0 - 128 + 32 * first, b * SEQ + t0 - 128 + 32 * first + 16, kcol, vcol, r, q); else attn_load(cur, P, METAROW, METAROW, kcol, vcol, r, q);
    bf16x8 qf[2][2];
#pragma unroll
    for (int jt = 0; jt < 2; ++jt)
#pragma unroll
        for (int kk = 0; kk < 2; ++kk) qf[jt][kk] = *(const bf16x8*)(P + (size_t)(qrow0 + 16 * jt + r) * LDP + P_BQ + hq * 64 + 32 * kk + 8 * q);
    f32x4 accO[4][2];
#pragma unroll
    for (int it = 0; it < 4; ++it) { accO[it][0] = (f32x4){0.f, 0.f, 0.f, 0.f}; accO[it][1] = (f32x4){0.f, 0.f, 0.f, 0.f}; }
    float mrow[2], lrow[2];
#pragma unroll
    for (int jt = 0; jt < 2; ++jt) { mrow[jt] = sink; lrow[jt] = 1.0f; }
    for (int idx = first; idx < 6; ++idx) {
        if (idx < 4) attn_load(nxt, P, b * SEQ + t0 - 96 + 32 * idx, b * SEQ + t0 - 96 + 32 * idx + 16, kcol, vcol, r, q); else if (idx == 4) attn_load(nxt, P, METAROW, METAROW, kcol, vcol, r, q);
        attn_compute(cur, qf, accO, mrow, lrow, idx < 5 ? 0 : (is_meta ? 2 : 1), 128 - 32 * idx, r, q);
        cur = nxt;
    }
#pragma unroll
    for (int jt = 0; jt < 2; ++jt) {
        if (is_meta && jt > 0) continue;
        const float inv = 1.0f / lrow[jt]; const size_t row = (size_t)(qrow0 + 16 * jt + r);
#pragma unroll
        for (int it = 0; it < 4; ++it) { const f32x4 o = accO[it][jt]; v2u w; w.x = pg8::pk_bf16(o[0] * inv, o[1] * inv); w.y = pg8::pk_bf16(o[2] * inv, o[3] * inv);
            *(v2u*)(Y + row * D + 384 + hq * 64 + 16 * it + 4 * q) = w; }
    }
}

__device__ __forceinline__ void conv_phase(Ctx& F, int l) {
    const bf16* P = (const bf16*)(F.ws + WS_ACT); bf16* Y = (bf16*)F.out;
    LAS float* GL = (LAS float*)F.lds;
    LAS float* OT = GL + 64 * 256;
    const int tid = F.tid, lane = F.lane, wave = F.wave, ch = tid & 255, half = tid >> 8;
    float wt[31];
#pragma unroll
    for (int w = 0; w < 31; ++w) wt[w] = F.in[12][(size_t)(l * 31 + w) * 256 + ch];
    const float bias = F.in[13][l * 256 + ch];
    const f32x4 lg4 = *(const f32x4*)(F.in[14] + l * 256 + 4 * lane), lb4 = *(const f32x4*)(F.in[15] + l * 256 + 4 * lane);
    const int bidc = F.gw / NWAVES;
    for (int uu = bidc; uu < CV_UNITS - 1 + F.G; uu += F.G) {
        int u = uu; if (uu >= CV_UNITS - 1) { if (bidc != F.G - 1) break; u = CV_UNITS - 1; }
        const bool is_meta = (u == CV_UNITS - 1); const int b = is_meta ? 0 : (u >> 7), t0 = is_meta ? 0 : (u & 127) * 32;
        v2u araw[8], graw[8];
#pragma unroll
        for (int ii = 0; ii < 8; ++ii) { const int i = wave + 8 * ii; int row;
            if (is_meta) { const int pos = i - 30; row = (pos >= 0 && pos < NMETA) ? METAROW + pos : -1; }
            else { const int idx = t0 - 30 + i; row = idx >= 0 ? b * SEQ + idx : (idx >= -NMETA ? METAROW + idx + NMETA : -1); }
            const size_t ro = (size_t)(row >= 0 ? row : METAROW) * LDP + P_CU + 4 * lane;
            araw[ii] = *(const v2u*)(P + ro); graw[ii] = *(const v2u*)(P + ro + 256);
            if (row < 0) araw[ii] = (v2u){0u, 0u}; }
#pragma unroll
        for (int ii = 0; ii < 8; ++ii) { const int i = wave + 8 * ii; const v2u a = araw[ii], g = graw[ii]; f32x4 gl;
            gl[0] = bf2f(a.x & 0xffffu) * sigm(bf2f(g.x & 0xffffu)); gl[1] = bf2f(a.x >> 16) * sigm(bf2f(g.x >> 16));
            gl[2] = bf2f(a.y & 0xffffu) * sigm(bf2f(g.y & 0xffffu)); gl[3] = bf2f(a.y >> 16) * sigm(bf2f(g.y >> 16));
            *(LAS f32x4*)(GL + i * 256 + 4 * lane) = gl; }
        __syncthreads();
        float gw_[46], o[16];
#pragma unroll
        for (int i = 0; i < 46; ++i) gw_[i] = GL[(half * 16 + i) * 256 + ch];
#pragma unroll
        for (int jj = 0; jj < 16; ++jj) { float a = bias;
#pragma unroll
            for (int w = 0; w < 31; ++w) a += gw_[jj + w] * wt[w];
            o[jj] = a; }
#pragma unroll
        for (int jj = 0; jj < 16; ++jj) OT[(half * 16 + jj) * 256 + ch] = o[jj];
        __syncthreads();
#pragma unroll
        for (int k = 0; k < 4; ++k) { const int tok = 4 * wave + k; const f32x4 v = *(const LAS f32x4*)(OT + tok * 256 + 4 * lane);
            const float s1 = wave_sum((v[0] + v[1]) + (v[2] + v[3]), lane), s2 = wave_sum((v[0] * v[0] + v[1] * v[1]) + (v[2] * v[2] + v[3] * v[3]), lane);
            const float mean = s1 * (1.0f / 256.0f), var = fmaxf(s2 * (1.0f / 256.0f) - mean * mean, 0.f), rstd = rsqrtf(var + EPS);
            int row; if (is_meta) row = tok < NMETA ? METAROW + tok : -1; else row = b * SEQ + t0 + tok;
            if (row >= 0) { v2u w; w.x = pg8::pk_bf16(pg8::silu_f((v[0] - mean) * rstd * lg4[0] + lb4[0]), pg8::silu_f((v[1] - mean) * rstd * lg4[1] + lb4[1]));
                w.y = pg8::pk_bf16(pg8::silu_f((v[2] - mean) * rstd * lg4[2] + lb4[2]), pg8::silu_f((v[3] - mean) * rstd * lg4[3] + lb4[3]));
                *(v2u*)(Y + (size_t)row * D + 768 + 4 * lane) = w; } }
    }
    __syncthreads();
}

#define XB_TMO      128
#define XB_XCNT(j)  (256  + 64 * (j))
#define XB_XSUB(j)  (1280 + 64 * (j))
#define XB_XGEN(j)  (2304 + 64 * (j))
#define XB_TOP      3328
#define XB_TOPGEN   3392
#define XCD_BAR_WORDS 3456
#define XB_SPIN_CAP (1u << 18)

__device__ __forceinline__ unsigned xb_ld(unsigned* p)              { return __hip_atomic_load(p, __ATOMIC_RELAXED, __HIP_MEMORY_SCOPE_AGENT); }
__device__ __forceinline__ unsigned xb_add(unsigned* p, unsigned v) { return __hip_atomic_fetch_add(p, v, __ATOMIC_RELAXED, __HIP_MEMORY_SCOPE_AGENT); }
__device__ __forceinline__ unsigned xb_xcc_id() { return (unsigned)__builtin_amdgcn_s_getreg((3 << 11) | 20) & 0xFu; }
#define XB_SPIN(cond, bar) do { unsigned _sp = 0; while (cond) { __builtin_amdgcn_s_sleep(1); \
    if ((++_sp & 255u) == 0u) { if (xb_ld(&(bar)[XB_TMO])) break; if (_sp > XB_SPIN_CAP) { atomicAdd(&(bar)[XB_TMO], 1u); break; } } } } while (0)

struct XcdBarrier {
    unsigned* bar; unsigned x;
    volatile LAS unsigned* st;
};

__device__ __forceinline__ XcdBarrier xcd_barrier_post(unsigned* bar, volatile LAS unsigned* st, int tid) {
    XcdBarrier b; b.bar = bar; b.x = xb_xcc_id(); b.st = st;
    if (tid == 0) (void)xb_add(&bar[XB_XCNT(b.x)], 1u);
    return b;
}
__device__ __forceinline__ void xcd_barrier_complete(unsigned* bar, unsigned x, unsigned& nloc, unsigned& nx) {
    const unsigned G = gridDim.x * gridDim.y * gridDim.z;
    unsigned sum, cnt, mine, sp = 0u;
    for (;;) {
        sum = 0u; cnt = 0u; mine = 0u;
#pragma unroll
        for (unsigned j = 0; j < 16; ++j) { const unsigned c = xb_ld(&bar[XB_XCNT(j)]); sum += c; cnt += (c > 0u) ? 1u : 0u; mine = (j == x) ? c : mine; }
        if (sum == G) break;
        __builtin_amdgcn_s_sleep(1);
        if ((++sp & 255u) == 0u) { if (xb_ld(&bar[XB_TMO])) break; if (sp > XB_SPIN_CAP) { atomicAdd(&bar[XB_TMO], 1u); break; } }
    }
    nloc = mine > 0u ? mine : 1u; nx = cnt > 0u ? cnt : 1u;
}

__device__ __forceinline__ void xcd_barrier(const XcdBarrier& b, int tid) {
    asm volatile("s_waitcnt vmcnt(0)" ::: "memory");
    __syncthreads();
    if (tid == 0) {
        unsigned* bar = b.bar;
        __builtin_amdgcn_s_waitcnt(0);
        unsigned nloc = b.st[0], nx = b.st[1];
        if (nloc == 0u) { xcd_barrier_complete(bar, b.x, nloc, nx); b.st[0] = nloc; b.st[1] = nx; }
        const unsigned old = xb_add(&bar[XB_XSUB(b.x)], 1u);
        const unsigned gen = old / nloc;
        if (old + 1u == (gen + 1u) * nloc) {
            __builtin_amdgcn_fence(__ATOMIC_RELEASE, "agent");
            asm volatile("s_waitcnt vmcnt(0)" ::: "memory");
            const unsigned og = xb_add(&bar[XB_TOP], 1u);
            const unsigned tg = og / nx;
            if (og + 1u == (tg + 1u) * nx) xb_add(&bar[XB_TOPGEN], 1u);
            else XB_SPIN(xb_ld(&bar[XB_TOPGEN]) == tg, bar);
            __builtin_amdgcn_fence(__ATOMIC_ACQUIRE, "agent");
            xb_add(&bar[XB_XGEN(b.x)], 1u);
            asm volatile("s_waitcnt vmcnt(0)" ::: "memory");
        } else {
            XB_SPIN(xb_ld(&bar[XB_XGEN(b.x)]) == gen, bar);
            __builtin_amdgcn_fence(__ATOMIC_ACQUIRE, "agent");
            asm volatile("s_waitcnt vmcnt(0)" ::: "memory");
        }
    }
    __syncthreads();
}

constexpr int N_PC = 2 + 9 * DEPTH;
#ifndef PHMASK
#define PHMASK 0xffff
#endif
#define PHON(k) ((PHMASK >> (k)) & 1)
__global__ void __launch_bounds__(NTHREADS, 2) fwd_kernel(Args args) {
    extern __shared__ __attribute__((aligned(16))) unsigned char lds_raw[];
    volatile LAS unsigned* bst = (volatile LAS unsigned*)((LAS unsigned char*)lds_raw + BAR_LDS_OFF);
    if (threadIdx.x == 0) { bst[0] = 0u; bst[1] = 0u; }
    __syncthreads();
    XcdBarrier gbar = xcd_barrier_post((unsigned*)(args.ws + WS_CTL), bst, (int)threadIdx.x);
    const int wave_s = __builtin_amdgcn_readfirstlane((int)threadIdx.x >> 6);
    for (int pc = args.pc_lo; pc < args.pc_hi; ++pc) {
        int lane_; asm volatile("v_mbcnt_lo_u32_b32 %0, -1, 0\n\tv_mbcnt_hi_u32_b32 %0, -1, %0" : "=v"(lane_));
        int tid_ = wave_s * 64 + lane_, pcv = pc, bid_ = blockIdx.x, grd_ = gridDim.x; asm volatile("" : "+v"(tid_)); asm volatile("" : "+s"(pcv), "+s"(bid_), "+s"(grd_));
        Ctx F;
        ArgsP ap = (ArgsP)__builtin_amdgcn_kernarg_segment_ptr(); asm volatile("" : "+s"(ap));
        F.in.ap = ap; F.out = ap->out; F.ws = ap->ws; F.lds = (LAS unsigned char*)lds_raw;
        F.tid = tid_; F.lane = F.tid & 63; F.wave = __builtin_amdgcn_readfirstlane(F.tid >> 6); F.G = grd_;
        F.gw = bid_ * NWAVES + F.wave; F.NGW = F.G * NWAVES;
        bf16* HB = (bf16*)(F.ws + WS_XN); bf16* YB = (bf16*)F.out; bf16* ACT = (bf16*)(F.ws + WS_ACT); float* HM = (float*)(F.ws + WS_HM); float* RSQ = (float*)(F.ws + WS_RSQ);
        const int l = pcv == 0 ? 0 : (pcv - 1) / 9, s = pcv == 0 ? -1 : (pcv == N_PC - 1 ? 9 : (pcv - 1) % 9);
        const unsigned char* wl = F.ws + WS_W + (size_t)l * WL_STRIDE;
        if (s == -1) { if (PHON(0)) prologue(F); }
        else if (s == 0 || s == 7) {
            const bf16* wgu = (const bf16*)(wl + (s == 0 ? WL_GU1 : WL_GU2));
            if (PHON(2)) skinny_gemm<0, 4, true>(F, nullptr, 0, wgu, FF / 16, ACT, FF, HM, 0.f);
            pg8::Gemm g{HB, wgu, MMAIN, 2 * FF, D}; pg8::StaticOrder S; S.init(MMAIN, 2 * FF, F.G, bid_);
            if (PHON(2)) build_rinv_table(F, S, RSQ);
            pg8::EpiSwiGLU E{ACT, FF, (const LAS float*)(F.lds + RTAB_OFF)};
            if (PHON(2)) pg8::gemm_phase<pg8::EpiSwiGLU, pg8::StaticOrder, true, true, true>(F.lds, g, S, E, F.tid);
        } else if (s == 1 || s == 6 || s == 8) {
            const bool isout = (s == 6);
            const bf16* wd = (const bf16*)(wl + (s == 1 ? WL_D1 : (s == 6 ? WL_OUT : WL_D2)));
            if (PHON(3)) { if (isout) skinny_gemm<1, 4, false>(F, YB + (size_t)METAROW * D, D, wd, D / 16, nullptr, 0, HM, 1.0f); else skinny_gemm<1, 11, false>(F, ACT + (size_t)METAROW * FF, FF, wd, D / 16, nullptr, 0, HM, 0.5f); }
            pg8::Gemm g{isout ? YB : ACT, wd, MMAIN, D, isout ? D : FF}; pg8::StaticOrder S; S.init(MMAIN, D, F.G, bid_);
            pg8::EpiResid E{(l == 0 && s == 1) ? F.in[0] : nullptr, HB, RSQ, isout ? 1.0f : 0.5f};
            if (PHON(3)) pg8::gemm_phase<pg8::EpiResid, pg8::StaticOrder, true, true, false>(F.lds, g, S, E, F.tid);
        } else if (s == 2) {
            if (PHON(4)) skinny_gemm<2, 4, true>(F, nullptr, 0, (const bf16*)(wl + WL_IN), INW / 16, ACT, LDP, HM, 0.f);
            pg8::Gemm g{HB, (const bf16*)(wl + WL_IN), MMAIN, LDP, D}; pg8::StaticOrder S; S.init(MMAIN, LDP, F.G, bid_);
            if (PHON(4)) build_rinv_table(F, S, RSQ);
            pg8::EpiStoreBf16 E{ACT, LDP, (const LAS float*)(F.lds + RTAB_OFF)};
            if (PHON(4)) pg8::gemm_phase<pg8::EpiStoreBf16, pg8::StaticOrder, true, true, true>(F.lds, g, S, E, F.tid);
            { const int nfull = win_nfull(F.G), bidw = F.gw / NWAVES;
              if (PHON(0) && nfull != 0 && l + 1 < DEPTH && bidw >= nfull) convert_weights(F, l + 1, (bidw - nfull) * NWAVES + F.wave, (F.G - nfull) * NWAVES); }
        } else if (s == 3) {
#define M1_ATTN() do { for (int u = F.gw; u < AT_UNITS - 6; u += F.NGW) attn_unit(F, l, u); \
                const int mi = F.NGW - 1 - F.gw; if (mi < 8 && (mi & 7) < 4) attn_unit(F, l, AT_UNITS - 6 + mi); else if (mi >= 8 && mi < 16 && (mi & 7) < 2) attn_unit(F, l, AT_UNITS - 2 + (mi & 7)); } while (0)
            if (PHON(5) && F.wave < 4) M1_ATTN();
            if (PHON(6)) for (int k = F.wave; k * F.G + (F.gw / NWAVES) < HG_UNITS; k += NWAVES) hgrn_p1_unit(F, l, k * F.G + (F.gw / NWAVES));
            if (PHON(5) && F.wave >= 4) M1_ATTN();
#undef M1_ATTN
        } else if (s == 4) { if (PHON(7)) conv_phase(F, l); if (PHON(8)) hgrn_scan(F); }
        else if (s == 5) { if (PHON(9)) for (int k = F.wave; k * F.G + (F.gw / NWAVES) < HG_UNITS; k += NWAVES) hgrn_p3_unit(F, l, k * F.G + (F.gw / NWAVES)); }
        else { if (PHON(10)) final_phase(F); }
        if (pc + 1 < args.pc_hi) { if (args.pc_lo < 0) cg::this_grid().sync(); else xcd_barrier(gbar, F.tid); }
    }
}

#ifndef MK_PER_PHASE
#define MK_PER_PHASE 0
#endif
extern "C" void kernel_launch(void* const* d_in, const int* in_sizes, int n_in, void* d_out, int out_size, void* d_ws, size_t ws_size, hipStream_t stream) {
    static int grid = 0;
    if (grid == 0) {
        if (n_in != 21 || in_sizes[0] != MMAIN * D || out_size != MMAIN * D || ws_size < WS_END) { fprintf(stderr, "kernel_launch: unexpected shapes (n_in %d, in0 %d, out %d, ws %zu); nothing launched\n", n_in, n_in > 0 ? in_sizes[0] : -1, out_size, ws_size); grid = -1; return; }
        int dev = 0, cus = 0, per_cu = 0;
        if (hipGetDevice(&dev) != hipSuccess || hipDeviceGetAttribute(&cus, hipDeviceAttributeMultiprocessorCount, dev) != hipSuccess) { grid = -1; return; }
        if (hipFuncSetAttribute((const void*)fwd_kernel, hipFuncAttributeMaxDynamicSharedMemorySize, LDS_BYTES) != hipSuccess) { fprintf(stderr, "kernel_launch: hipFuncSetAttribute failed\n"); grid = -1; return; }
        if (hipOccupancyMaxActiveBlocksPerMultiprocessor(&per_cu, (const void*)fwd_kernel, NTHREADS, LDS_BYTES) != hipSuccess || per_cu < 1) { fprintf(stderr, "kernel_launch: occupancy query says %d\n", per_cu); per_cu = 1; }
        (void)hipGetLastError();
        grid = cus;
    }
    if (grid < 0) return;
    if (hipMemsetAsync((char*)d_ws + WS_CTL, 0, 16384, stream) != hipSuccess) { fprintf(stderr, "kernel_launch: hipMemsetAsync failed\n"); return; }
    Args a{};
    for (int i = 0; i < 21; ++i) a.in[i] = (const float*)d_in[i];
    a.out = (float*)d_out; a.ws = (unsigned char*)d_ws;
#if MK_PER_PHASE
    for (int pc = 0; pc < N_PC; ++pc) { a.pc_lo = pc; a.pc_hi = pc + 1; hipLaunchKernelGGL(fwd_kernel, dim3(grid), dim3(NTHREADS), LDS_BYTES, stream, a); }
#else
    a.pc_lo = 0; a.pc_hi = N_PC;
    void* kargs[] = {&a};
    hipError_t e = hipLaunchCooperativeKernel((const void*)fwd_kernel, dim3(grid), dim3(NTHREADS), kargs, LDS_BYTES, stream);
    if (e != hipSuccess) fprintf(stderr, "kernel_launch: cooperative launch failed: %s (grid %d)\n", hipGetErrorString(e), grid);
#endif
}
```

```cpp
#include <hip/hip_runtime.h>
#include <hip/hip_cooperative_groups.h>
#include <cstdio>
#include <cstdint>
namespace cg = cooperative_groups;

namespace pg8 {
#define PG8_LAS __attribute__((address_space(3)))
typedef unsigned short bf16_t;
typedef short bf16x8 __attribute__((ext_vector_type(8)));
typedef float f32x4 __attribute__((ext_vector_type(4)));
typedef unsigned u32x4 __attribute__((ext_vector_type(4)));
constexpr int BM = 256, BK = 64, HALF = 128, HTB = HALF * BK * 2  , STAGE_BYTES = 8 * HTB, NXCD = 8, WGM = 8;

__host__ __device__ __forceinline__ int lds_byte(int r, int c) { const int st = (r >> 4) * 2 + (c >> 5), rr = r & 15, cc = c & 31, ob = rr * 64 + cc * 2; return st * 1024 + (ob ^ (((ob >> 9) & 1) << 5)); }
__host__ __device__ __forceinline__ void stage_rc(int b, int& R, int& C) { const int st = b / 1024, sb = b % 1024, swz = sb ^ (((sb >> 9) & 1) << 5); R = (st >> 1) * 16 + swz / 64; C = (st & 1) * 32 + (swz % 64) / 2; }
__host__ __device__ __forceinline__ int perm32(int rho) { const int n = rho >> 4, i = rho & 15; return 8 * (i >> 2) + 4 * n + (i & 3); }

struct Unit { int pm, pn, idx; };
struct Gemm { const bf16_t* A; const bf16_t* Bt; int M, N, K; };

struct StaticOrder {
    int nM, nN, nwg, G, c;
    __host__ __device__ void init(int M, int N, int G_, int c_) { nM = M / BM; nN = N / BM; nwg = nM * nN; G = G_; c = c_; }
    __host__ __device__ bool next(int i, Unit& u) const {
        const long L = (long)i * G + c; if (L >= nwg) return false;
        int wgid = (int)L; { const int q = nwg / NXCD, r = nwg % NXCD, xcd = wgid % NXCD, off = wgid / NXCD; wgid = (xcd < r ? xcd * (q + 1) : r * (q + 1) + (xcd - r) * q) + off; }
        const int nig = WGM * nN, gid = wgid / nig, fm = gid * WGM, gsz = (nM - fm) < WGM ? (nM - fm) : WGM;
        u.pm = fm + ((wgid % nig) % gsz); u.pn = (wgid % nig) / gsz; u.idx = i; return true;
    }
    __device__ __forceinline__ void a_ready(const Unit&) const {}
    __device__ __forceinline__ void done(const Unit&) const {}
};

__device__ __forceinline__ unsigned cvt_pk_bf16(float lo, float hi) { unsigned r; asm volatile("v_cvt_pk_bf16_f32 %0, %1, %2" : "=v"(r) : "v"(lo), "v"(hi)); return r; }
typedef float f32x2 __attribute__((ext_vector_type(2)));
typedef __bf16 bf16x2_t __attribute__((ext_vector_type(2)));
typedef unsigned u32x2 __attribute__((ext_vector_type(2)));
typedef _Float16 f16x8 __attribute__((ext_vector_type(8)));
typedef _Float16 f16x4 __attribute__((ext_vector_type(4)));
typedef _Float16 f16x2 __attribute__((ext_vector_type(2)));
__device__ __forceinline__ unsigned pk_f16(float lo, float hi) { f32x2 v = {lo, hi}; f16x2 h = __builtin_convertvector(v, f16x2); return __builtin_bit_cast(unsigned, h); }
__device__ __forceinline__ unsigned pk_bf16(float lo, float hi) { f32x2 v = {lo, hi}; bf16x2_t b = __builtin_convertvector(v, bf16x2_t); return __builtin_bit_cast(unsigned, b); }
__device__ __forceinline__ float silu_f(float x) { return x * __builtin_amdgcn_rcpf(1.0f + __expf(-x)); }

__device__ __forceinline__ float shx_(float v, int o, int lane) { return __builtin_bit_cast(float, __builtin_amdgcn_ds_bpermute((lane ^ o) << 2, __builtin_bit_cast(int, v))); }
#define PG8_ROW_RINV(rinv, tab, u, wr, fr) do { _Pragma("unroll") for (int ai = 0; ai < 2; ++ai) _Pragma("unroll") for (int m = 0; m < 4; ++m) rinv[ai][m] = (tab)[(u).idx * 256 + ai * HALF + (wr) * 64 + m * 16 + (fr)]; } while (0)
struct EpiSwiGLU {
    static constexpr bool PERM = true, AFTER_DRAIN = false;
    bf16_t* O; int ldo; const PG8_LAS float* tab;
    __device__ __forceinline__ void operator()(const f32x4 (&acc)[2][2][4][2], const Unit& u, int wr, int wc, int fr, int fq) const {
        const int row0 = u.pm * BM + wr * 64 + fr; const int col0 = u.pn * 128 + wc * 32 + 8 * fq;
        float rinv[2][4]; PG8_ROW_RINV(rinv, tab, u, wr, fr);
#pragma unroll
        for (int ai = 0; ai < 2; ++ai)
#pragma unroll
            for (int m = 0; m < 4; ++m) { const float ri = rinv[ai][m];
                float g[8], up[8], e[8];
#pragma unroll
                for (int i = 0; i < 4; ++i) { g[i] = acc[ai][0][m][0][i] * ri; g[4 + i] = acc[ai][0][m][1][i] * ri; up[i] = acc[ai][1][m][0][i] * ri; up[4 + i] = acc[ai][1][m][1][i] * ri; }
#pragma unroll
                for (int i = 0; i < 8; ++i) e[i] = __builtin_amdgcn_exp2f(g[i] * -1.4426950408889634f);
#pragma unroll
                for (int i = 0; i < 8; ++i) e[i] = __builtin_amdgcn_rcpf(1.0f + e[i]);
#pragma unroll
                for (int i = 0; i < 8; ++i) g[i] = (g[i] * up[i]) * e[i];
                u32x4 w; w.x = pk_bf16(g[0], g[1]); w.y = pk_bf16(g[2], g[3]); w.z = pk_bf16(g[4], g[5]); w.w = pk_bf16(g[6], g[7]);
                *(u32x4*)(O + (size_t)(row0 + ai * HALF + m * 16) * ldo + col0) = w; }
    }
};
struct EpiStoreBf16 {
    static constexpr bool PERM = true, AFTER_DRAIN = false;
    bf16_t* O; int ldo; const PG8_LAS float* tab;
    __device__ __forceinline__ void operator()(const f32x4 (&acc)[2][2][4][2], const Unit& u, int wr, int wc, int fr, int fq) const {
        const int row0 = u.pm * BM + wr * 64 + fr; const int col0 = u.pn * BM + wc * 32 + 8 * fq;
        float rinv[2][4]; PG8_ROW_RINV(rinv, tab, u, wr, fr);
#pragma unroll
        for (int ai = 0; ai < 2; ++ai)
#pragma unroll
            for (int m = 0; m < 4; ++m) { bf16_t* rowp = O + (size_t)(row0 + ai * HALF + m * 16) * ldo + col0;
#pragma unroll
                for (int bj = 0; bj < 2; ++bj) { const f32x4 v0 = acc[ai][bj][m][0] * rinv[ai][m], v1 = acc[ai][bj][m][1] * rinv[ai][m];
                    u32x4 w; w.x = pk_bf16(v0[0], v0[1]); w.y = pk_bf16(v0[2], v0[3]); w.z = pk_bf16(v1[0], v1[1]); w.w = pk_bf16(v1[2], v1[3]);
                    *(u32x4*)(rowp + bj * HALF) = w; } }
    }
};
struct EpiResid {
    static constexpr bool PERM = true, AFTER_DRAIN = false;
    const float* in32; unsigned short* hb; float* rowsq; float scale;
    __device__ __forceinline__ void operator()(const f32x4 (&acc)[2][2][4][2], const Unit& u, int wr, int wc, int fr, int fq) const {
        const int lane = fq * 16 + fr;
        const int row0 = u.pm * BM + wr * 64 + fr; const int col0 = u.pn * BM + wc * 32 + 8 * fq;
        if (in32) {
#pragma unroll
            for (int ai = 0; ai < 2; ++ai)
#pragma unroll
              for (int mp = 0; mp < 2; ++mp) { f32x4 b0[2][2], b1[2][2];
#pragma unroll
                for (int mm = 0; mm < 2; ++mm)
#pragma unroll
                    for (int bj = 0; bj < 2; ++bj) { const float* ip = in32 + (size_t)(row0 + ai * HALF + (2 * mp + mm) * 16) * 1024 + col0 + bj * HALF; b0[mm][bj] = *(const f32x4*)ip; b1[mm][bj] = *(const f32x4*)(ip + 4); }
#pragma unroll
                for (int mm = 0; mm < 2; ++mm) { const int m = 2 * mp + mm; const int row = row0 + ai * HALF + m * 16; const size_t off = (size_t)row * 1024 + col0; float ss = 0.f;
#pragma unroll
                    for (int bj = 0; bj < 2; ++bj) { const f32x4 o0 = b0[mm][bj] + acc[ai][bj][m][0] * scale, o1 = b1[mm][bj] + acc[ai][bj][m][1] * scale;
                        ss += ((o0[0] * o0[0] + o0[1] * o0[1]) + (o0[2] * o0[2] + o0[3] * o0[3])) + ((o1[0] * o1[0] + o1[1] * o1[1]) + (o1[2] * o1[2] + o1[3] * o1[3]));
                        u32x4 w; w.x = pk_f16(o0[0], o0[1]); w.y = pk_f16(o0[2], o0[3]); w.z = pk_f16(o1[0], o1[1]); w.w = pk_f16(o1[2], o1[3]);
                        *(u32x4*)(hb + off + bj * HALF) = w; }
                    ss += shx_(ss, 16, lane); ss += shx_(ss, 32, lane);
                    if (fq == 0) rowsq[(size_t)row * 16 + u.pn * 4 + wc] = ss; } }
        } else {
#pragma unroll
            for (int ai = 0; ai < 2; ++ai) { f16x8 hv[4][2];
#pragma unroll
                for (int m = 0; m < 4; ++m)
#pragma unroll
                    for (int bj = 0; bj < 2; ++bj) hv[m][bj] = *(const f16x8*)(hb + (size_t)(row0 + ai * HALF + m * 16) * 1024 + col0 + bj * HALF);
#pragma unroll
                for (int m = 0; m < 4; ++m) { const int row = row0 + ai * HALF + m * 16; const size_t off = (size_t)row * 1024 + col0; float ss = 0.f;
#pragma unroll
                    for (int bj = 0; bj < 2; ++bj) { const f16x8 h = hv[m][bj];
                        const f32x4 o0 = (f32x4){(float)h[0], (float)h[1], (float)h[2], (float)h[3]} + acc[ai][bj][m][0] * scale, o1 = (f32x4){(float)h[4], (float)h[5], (float)h[6], (float)h[7]} + acc[ai][bj][m][1] * scale;
                        ss += ((o0[0] * o0[0] + o0[1] * o0[1]) + (o0[2] * o0[2] + o0[3] * o0[3])) + ((o1[0] * o1[0] + o1[1] * o1[1]) + (o1[2] * o1[2] + o1[3] * o1[3]));
                        u32x4 w; w.x = pk_f16(o0[0], o0[1]); w.y = pk_f16(o0[2], o0[3]); w.z = pk_f16(o1[0], o1[1]); w.w = pk_f16(o1[2], o1[3]);
                        *(u32x4*)(hb + off + bj * HALF) = w; }
                    ss += shx_(ss, 16, lane); ss += shx_(ss, 32, lane);
                    if (fq == 0) rowsq[(size_t)row * 16 + u.pn * 4 + wc] = ss; } }
        }
    }
};

template <class Epi, class Sched, bool ALIGN_EPI = false, bool SP2 = false, bool F16 = false>
__device__ __forceinline__ void gemm_phase(PG8_LAS unsigned char* lds, const Gemm g, const Sched& S, const Epi& E, int tid_in) {
    int tid_l = tid_in; asm volatile("" : "+v"(tid_l));
    const int tid = tid_l, wid = __builtin_amdgcn_readfirstlane(tid >> 6), lane = tid & 63, wr = wid >> 2, wc = wid & 3, fr = lane & 15, fq = lane >> 4;
    const int K = g.K, nt = K / BK;
    unsigned voffA[2], voffB[2];
#pragma unroll
    for (int i = 0; i < 2; ++i) { int R, C; stage_rc(tid * 16 + i * 8192, R, C); const int Rb = Epi::PERM ? ((R & ~31) + perm32(R & 31)) : R;
        voffA[i] = (unsigned)(R * K + C) * 2u; voffB[i] = (unsigned)(Rb * K + C) * 2u; }
    const size_t kstep = (size_t)(BK * 2);
    const size_t hstep = (size_t)HALF * K * 2;
    const size_t tstep = 2 * hstep;
    const unsigned ldsw = (unsigned)wid * 1024u;
    const int aoff = lds_byte(wr * 64 + fr, fq * 8), boff = lds_byte(wc * 32 + fr, fq * 8);
#define PG8_SA(b, h) (((b) * 2 + (h)) * HTB)
#define PG8_SB(b, h) ((4 + (b) * 2 + (h)) * HTB)
#define PG8_STAGE(bufoff, gbase, voff) do { _Pragma("unroll") for (int _i = 0; _i < 2; ++_i) \
        __builtin_amdgcn_global_load_lds((const unsigned*)((const char*)(gbase) + (voff)[_i]), (PG8_LAS unsigned*)(lds + (bufoff) + ldsw + _i * 8192), 16, 0, 0); } while (0)
#define PG8_LDA(dst, b, h) do { _Pragma("unroll") for (int m = 0; m < 4; ++m) _Pragma("unroll") for (int k = 0; k < 2; ++k) dst[m][k] = *(const PG8_LAS bf16x8*)(lds + PG8_SA(b, h) + aoff + m * 2048 + k * 1024); } while (0)
#define PG8_LDB(dst, b, h) do { _Pragma("unroll") for (int n = 0; n < 2; ++n) _Pragma("unroll") for (int k = 0; k < 2; ++k) dst[n][k] = *(const PG8_LAS bf16x8*)(lds + PG8_SB(b, h) + boff + n * 2048 + k * 1024); } while (0)
#define PG8_MMA(ai, bj, At, Bt) do { __builtin_amdgcn_s_setprio(1); _Pragma("unroll") for (int m = 0; m < 4; ++m) _Pragma("unroll") for (int n = 0; n < 2; ++n) _Pragma("unroll") for (int k = 0; k < 2; ++k) \
        acc[ai][bj][m][n] = F16 ? __builtin_amdgcn_mfma_f32_16x16x32_f16(__builtin_bit_cast(f16x8, Bt[n][k]), __builtin_bit_cast(f16x8, At[m][k]), acc[ai][bj][m][n], 0, 0, 0) \
                                : __builtin_amdgcn_mfma_f32_16x16x32_bf16(Bt[n][k], At[m][k], acc[ai][bj][m][n], 0, 0, 0); __builtin_amdgcn_s_setprio(0); } while (0)
#define PG8_WAIT_V(n) asm volatile("s_waitcnt vmcnt(" #n ")" ::: "memory")
#define PG8_WAIT_L(n) asm volatile("s_waitcnt lgkmcnt(" #n ")" ::: "memory")
#define PG8_BAR __builtin_amdgcn_s_barrier()
#define PG8_SCHED __builtin_amdgcn_sched_barrier(0)
    Unit cur, nxt; int ui = 0;
    if (!S.next(0, cur)) return;
    f32x4 acc[2][2][4][2];
#pragma unroll
    for (int a = 0; a < 2; ++a)
#pragma unroll
        for (int b = 0; b < 2; ++b)
#pragma unroll
            for (int m = 0; m < 4; ++m)
#pragma unroll
                for (int n = 0; n < 2; ++n) acc[a][b][m][n] = (f32x4){0.f, 0.f, 0.f, 0.f};
    bf16x8 At[4][2], B0[2][2], B1[2][2];
    const char* cA = (const char*)g.A + (size_t)cur.pm * tstep; const char* cB = (const char*)g.Bt + (size_t)cur.pn * tstep;
    S.a_ready(cur);
    if constexpr (SP2) {
        PG8_STAGE(PG8_SB(0, 0), cB, voffB); PG8_STAGE(PG8_SB(0, 1), cB + hstep, voffB); PG8_STAGE(PG8_SA(0, 0), cA, voffA); PG8_STAGE(PG8_SA(0, 1), cA + hstep, voffA);
        if (wr == 1) PG8_BAR;
        PG8_WAIT_V(2); PG8_BAR;
        PG8_STAGE(PG8_SB(1, 0), cB + kstep, voffB); PG8_STAGE(PG8_SA(1, 0), cA + kstep, voffA); PG8_STAGE(PG8_SB(1, 1), cB + hstep + kstep, voffB);
        PG8_WAIT_V(6); PG8_BAR;
    } else {
        PG8_STAGE(PG8_SB(0, 0), cB, voffB); PG8_STAGE(PG8_SA(0, 0), cA, voffA); PG8_STAGE(PG8_SB(0, 1), cB + hstep, voffB); PG8_STAGE(PG8_SA(0, 1), cA + hstep, voffA);
        if (wr == 1) PG8_BAR;
        PG8_WAIT_V(4); PG8_BAR;
        PG8_STAGE(PG8_SB(1, 0), cB + kstep, voffB); PG8_STAGE(PG8_SA(1, 0), cA + kstep, voffA); PG8_STAGE(PG8_SB(1, 1), cB + hstep + kstep, voffB);
        PG8_WAIT_V(6); PG8_BAR;
    }
    for (;;) {
        const bool has_next = S.next(ui + 1, nxt);
        const char* nA = has_next ? (const char*)g.A + (size_t)nxt.pm * tstep : cA; const char* nB = has_next ? (const char*)g.Bt + (size_t)nxt.pn * tstep : cB;
        for (int t = 0; t < nt; t += 2) {
            const bool last = (t == nt - 2);
            const char* a1 = cA + (size_t)(t + 1) * kstep;
            const char* a2 = last ? nA : cA + (size_t)(t + 2) * kstep; const char* b2 = last ? nB : cB + (size_t)(t + 2) * kstep;
            const char* a3 = a2 + kstep; const char* b3 = b2 + kstep;
            if (last && has_next) S.a_ready(nxt);
            if constexpr (SP2) {
            PG8_LDB(B0, 0, 0); PG8_LDB(B1, 0, 1); PG8_SCHED; PG8_LDA(At, 0, 0); PG8_STAGE(PG8_SA(1, 1), a1 + hstep, voffA);
            PG8_WAIT_V(8); PG8_WAIT_L(0); PG8_BAR; PG8_MMA(0, 0, At, B0); PG8_MMA(0, 1, At, B1); PG8_BAR; PG8_SCHED;
            PG8_LDA(At, 0, 1); PG8_STAGE(PG8_SB(0, 0), b2, voffB); PG8_STAGE(PG8_SB(0, 1), b2 + hstep, voffB); PG8_STAGE(PG8_SA(0, 0), a2, voffA);
            PG8_WAIT_V(8); PG8_WAIT_L(0); PG8_BAR; PG8_MMA(1, 0, At, B0); PG8_MMA(1, 1, At, B1); PG8_BAR; PG8_SCHED;
            PG8_LDB(B0, 1, 0); PG8_LDB(B1, 1, 1); PG8_SCHED; PG8_LDA(At, 1, 0); PG8_STAGE(PG8_SA(0, 1), a2 + hstep, voffA);
            PG8_WAIT_V(8); PG8_WAIT_L(0); PG8_BAR; PG8_MMA(0, 0, At, B0); PG8_MMA(0, 1, At, B1); PG8_BAR; PG8_SCHED;
            PG8_LDA(At, 1, 1); PG8_STAGE(PG8_SB(1, 0), b3, voffB); PG8_STAGE(PG8_SB(1, 1), b3 + hstep, voffB); PG8_STAGE(PG8_SA(1, 0), a3, voffA);
            PG8_WAIT_V(8); PG8_WAIT_L(0); PG8_BAR; PG8_MMA(1, 0, At, B0); PG8_MMA(1, 1, At, B1); PG8_BAR; PG8_SCHED;
            } else {
            PG8_LDB(B0, 0, 0); PG8_SCHED; PG8_LDA(At, 0, 0); PG8_STAGE(PG8_SA(1, 1), a1 + hstep, voffA);
            PG8_WAIT_L(8); PG8_BAR; PG8_WAIT_L(0); PG8_MMA(0, 0, At, B0); PG8_BAR; PG8_SCHED;
            PG8_LDB(B1, 0, 1); PG8_STAGE(PG8_SB(0, 0), b2, voffB);
            PG8_BAR; PG8_WAIT_L(0); PG8_MMA(0, 1, At, B1); PG8_BAR;
            PG8_LDA(At, 0, 1); PG8_STAGE(PG8_SA(0, 0), a2, voffA);
            PG8_BAR; PG8_WAIT_L(0); PG8_MMA(1, 0, At, B0); PG8_BAR; PG8_SCHED;
            PG8_STAGE(PG8_SB(0, 1), b2 + hstep, voffB);
            PG8_WAIT_V(6); PG8_BAR; PG8_MMA(1, 1, At, B1); PG8_BAR;
            PG8_LDB(B0, 1, 0); PG8_SCHED; PG8_LDA(At, 1, 0); PG8_STAGE(PG8_SA(0, 1), a2 + hstep, voffA);
            PG8_WAIT_L(8); PG8_BAR; PG8_WAIT_L(0); PG8_MMA(0, 0, At, B0); PG8_BAR; PG8_SCHED;
            PG8_LDB(B1, 1, 1); PG8_STAGE(PG8_SB(1, 0), b3, voffB);
            PG8_BAR; PG8_WAIT_L(0); PG8_MMA(0, 1, At, B1); PG8_BAR;
            PG8_LDA(At, 1, 1); PG8_STAGE(PG8_SA(1, 0), a3, voffA);
            PG8_BAR; PG8_WAIT_L(0); PG8_MMA(1, 0, At, B0); PG8_BAR; PG8_SCHED;
            PG8_STAGE(PG8_SB(1, 1), b3 + hstep, voffB);
            PG8_WAIT_V(6); PG8_BAR; PG8_MMA(1, 1, At, B1); PG8_BAR;
            }
        }
        if constexpr (ALIGN_EPI) { if (wr == 0) PG8_BAR; }
        if constexpr (!Epi::AFTER_DRAIN) { E(acc, cur, wr, wc, fr, fq); S.done(cur); }
        if (!has_next) break;
#pragma unroll
        for (int a = 0; a < 2; ++a)
#pragma unroll
            for (int b = 0; b < 2; ++b)
#pragma unroll
                for (int m = 0; m < 4; ++m)
#pragma unroll
                    for (int n = 0; n < 2; ++n) acc[a][b][m][n] = (f32x4){0.f, 0.f, 0.f, 0.f};
        cur = nxt; cA = nA; cB = nB; ++ui;
        if constexpr (ALIGN_EPI) { if (wr == 1) PG8_BAR; }
    }
    PG8_WAIT_V(0);
    if constexpr (!ALIGN_EPI) { if (wr == 0) PG8_BAR; }
    PG8_BAR;
    if constexpr (Epi::AFTER_DRAIN) { E.fused(acc, cur, wr, wc, fr, fq, lds, wid, lane); S.done(cur); }
#undef PG8_SA
#undef PG8_SB
#undef PG8_STAGE
#undef PG8_LDA
#undef PG8_LDB
#undef PG8_MMA
#undef PG8_WAIT_V
#undef PG8_WAIT_L
#undef PG8_BAR
#undef PG8_SCHED
}
}

#define LAS __attribute__((address_space(3)))
typedef unsigned short bf16;
typedef unsigned v4u __attribute__((ext_vector_type(4)));
typedef unsigned v2u __attribute__((ext_vector_type(2)));
typedef float f32x4 __attribute__((ext_vector_type(4)));
typedef short bf16x8 __attribute__((ext_vector_type(8)));

constexpr int NWAVES = 8, NTHREADS = 512;
constexpr int D = 1024, FF = 2816, NB = 8, SEQ = 4096, NMETA = 16, DEPTH = 4;
constexpr int MMAIN = NB * SEQ;
constexpr int METAROW = MMAIN;
constexpr int MR = MMAIN + 256;
constexpr int INW = 2688, LDP = 2816;
constexpr int P_AQ = 0, P_AF = 384, P_AI = 768, P_AG = 1152, P_BQ = 1536, P_BK = 1920, P_BV = 2048, P_CU = 2176;
constexpr float EPS = 1e-6f;
constexpr int HG_NC = 65;
constexpr int HG_UNITS = NB * 6 * HG_NC;
constexpr int AT_UNITS = NB * 6 * 128 + 6;
constexpr int CV_UNITS = NB * 128 + 1;

constexpr size_t MiB = 1u << 20;
constexpr size_t WS_CTL = 0, CTL_ZERO_BYTES = 1 * MiB;
constexpr size_t WS_HM = 1 * MiB;
constexpr size_t WS_W = 2 * MiB;
constexpr size_t WL_GU1 = 0, WL_D1 = 11 * MiB, WL_IN = WL_D1 + 5632 * 1024, WL_OUT = 22 * MiB, WL_GU2 = 24 * MiB, WL_D2 = 35 * MiB, WL_STRIDE = 40 * MiB + 512 * 1024;
constexpr size_t WS_XN = 164 * MiB;
constexpr size_t WS_ACT = 229 * MiB;
constexpr size_t WS_DS = 407 * MiB;
constexpr size_t WS_ST = 456 * MiB;
constexpr size_t WS_DEC = 481 * MiB;
constexpr size_t WS_RSQ = 482 * MiB;
constexpr size_t WS_END = 484 * MiB;
static_assert(WS_W + 4 * WL_STRIDE <= WS_XN && WS_XN + (size_t)MR * D * 2 <= WS_ACT && WS_ACT + (size_t)MR * LDP * 2 <= WS_DS && WS_DS + (size_t)HG_UNITS * 4096 * 4 <= WS_ST && WS_ST + (size_t)HG_UNITS * 4096 * 2 <= WS_DEC && WS_DEC + (size_t)HG_UNITS * 64 * 4 <= WS_RSQ && WS_RSQ + (size_t)MMAIN * 64 <= WS_END, "ws map");
static_assert(WL_IN + (size_t)LDP * 1024 * 2 <= WL_OUT && WL_D2 + (size_t)1024 * FF * 2 <= WL_STRIDE, "weight map");

constexpr int TLD = 72;
constexpr int TILE_BYTES = 64 * TLD * 2;
constexpr int WAVE_LDS = 2 * TILE_BYTES + 512;
constexpr int LDS_BYTES = 155648;
constexpr int BAR_LDS_OFF = LDS_BYTES - 16;
static_assert(NWAVES * WAVE_LDS <= BAR_LDS_OFF && pg8::STAGE_BYTES <= BAR_LDS_OFF, "LDS map");

#define LDS_WAIT() asm volatile("s_waitcnt lgkmcnt(0)" ::: "memory")
__device__ __forceinline__ unsigned f2bf(float f) { unsigned u = __builtin_bit_cast(unsigned, f); return (u + 0x7fffu + ((u >> 16) & 1u)) >> 16; }
__device__ __forceinline__ unsigned pk2(float lo, float hi) { return f2bf(lo) | (f2bf(hi) << 16); }
__device__ __forceinline__ float bf2f(unsigned u) { return __builtin_bit_cast(float, u << 16); }
__device__ __forceinline__ float sigm(float z) { return __builtin_amdgcn_rcpf(1.0f + __expf(-z)); }
__device__ __forceinline__ unsigned bf1(float x) { return pg8::pk_bf16(x, 0.f) & 0xffffu; }
constexpr float L2E = 1.4426950408889634f;
__device__ __forceinline__ unsigned f2h(float f) { return pg8::pk_f16(f, 0.f) & 0xffffu; }
__device__ __forceinline__ unsigned pk2h(float lo, float hi) { return pg8::pk_f16(lo, hi); }
#define HG_GATE16(T, j0) float z2[16], a1[16], lf[16]; { float e_[16]; \
        _Pragma("unroll") for (int i = 0; i < 16; ++i) z2[i] = bf2f((T)[((j0) + i) * TLD + lane]) * L2E; \
        _Pragma("unroll") for (int i = 0; i < 16; ++i) e_[i] = __builtin_amdgcn_exp2f(-z2[i]); \
        _Pragma("unroll") for (int i = 0; i < 16; ++i) a1[i] = __builtin_amdgcn_logf(1.0f + e_[i]); \
        _Pragma("unroll") for (int i = 0; i < 16; ++i) lf[i] = __builtin_amdgcn_logf(1.0f + lb * e_[i]) - a1[i]; }
#define HG_GATE(zbits, z2, a1, lf2) const float z2 = bf2f(zbits) * L2E; const float E_ = __builtin_amdgcn_exp2f(-z2); const float a1 = __builtin_amdgcn_logf(1.0f + E_); \
        const float lf2 = (lb > 0.f ? __builtin_amdgcn_logf(1.0f + lb * E_) : 0.f) - a1;
__device__ __forceinline__ float shx(float v, int o, int lane) { return __builtin_bit_cast(float, __builtin_amdgcn_ds_bpermute((lane ^ o) << 2, __builtin_bit_cast(int, v))); }
__device__ __forceinline__ float wave_sum(float v, int lane) {
#pragma unroll
    for (int o = 1; o < 64; o <<= 1) v += shx(v, o, lane);
    return v;
}

struct Args { const float* in[21]; float* out; unsigned char* ws; int pc_lo, pc_hi; };
typedef const __attribute__((address_space(4))) Args* ArgsP;
struct InView { ArgsP ap; __device__ __forceinline__ const float* operator[](int i) const { return ap->in[i]; } };
struct Ctx {
    InView in; float* out; unsigned char* ws;
    LAS unsigned char* lds;
    int tid, lane, wave, G, gw, NGW;
};

__device__ __forceinline__ void transpose_item(const float* W, int K, int N, const float* gain, bf16* WT, int mode, bool f16, LAS float* scr, int item, int lane) {
    const int nblk = N / 32, kb = item / nblk, nb = item % nblk, k0 = 64 * kb, n0 = 32 * nb;
    f32x4 v[8];
#pragma unroll
    for (int i = 0; i < 8; ++i) v[i] = *(const f32x4*)(W + (size_t)(k0 + 8 * i + (lane >> 3)) * N + n0 + 4 * (lane & 7));
#pragma unroll
    for (int i = 0; i < 8; ++i) { const int kk = 8 * i + (lane >> 3); const float g = gain ? gain[k0 + kk] : 1.0f; LAS float* d = scr + kk * 33 + 4 * (lane & 7);
        d[0] = v[i][0] * g; d[1] = v[i][1] * g; d[2] = v[i][2] * g; d[3] = v[i][3] * g; }
    LDS_WAIT();
    const int c = lane & 7;
#pragma unroll
    for (int j = 0; j < 4; ++j) { const int nl = (lane >> 3) + 8 * j; const LAS float* s = scr + (8 * c) * 33 + nl; const int n = n0 + nl;
        const int dr = mode == 0 ? n : ((n >> 7) * 256 + (n & 127) + (mode == 2 ? 128 : 0));
        v4u o; if (f16) { o.x = pk2h(s[0 * 33], s[1 * 33]); o.y = pk2h(s[2 * 33], s[3 * 33]); o.z = pk2h(s[4 * 33], s[5 * 33]); o.w = pk2h(s[6 * 33], s[7 * 33]); }
        else { o.x = pk2(s[0 * 33], s[1 * 33]); o.y = pk2(s[2 * 33], s[3 * 33]); o.z = pk2(s[4 * 33], s[5 * 33]); o.w = pk2(s[6 * 33], s[7 * 33]); }
        *(v4u*)(WT + (size_t)dr * K + k0 + 8 * c) = o; }
    LDS_WAIT();
}
__device__ __forceinline__ void prologue(Ctx& F) {
    LAS float* scr = (LAS float*)(F.lds + F.wave * WAVE_LDS);
    constexpr int I_G = 16 * 88, I_D = 44 * 32, I_IN = 16 * 84, I_OUT = 16 * 32, I_LAYER = 6 * 1408 + I_IN + I_OUT;
    static_assert(I_G == 1408 && I_D == 1408, "items");
    for (int it = F.gw; it < DEPTH * I_LAYER; it += F.NGW) {
        const int l = it / I_LAYER; int r = it % I_LAYER;
        bf16* wl = (bf16*)(F.ws + WS_W + (size_t)l * WL_STRIDE);
        const size_t og = (size_t)l * D * FF, od = (size_t)l * FF * D;
        if (r < I_G) { transpose_item(F.in[3] + og, D, FF, F.in[2] + l * D, (bf16*)((unsigned char*)wl + WL_GU1), 1, true, scr, r, F.lane); continue; } r -= I_G;
        if (r < I_G) { transpose_item(F.in[4] + og, D, FF, F.in[2] + l * D, (bf16*)((unsigned char*)wl + WL_GU1), 2, true, scr, r, F.lane); continue; } r -= I_G;
        if (r < I_D) { transpose_item(F.in[5] + od, FF, D, nullptr, (bf16*)((unsigned char*)wl + WL_D1), 0, false, scr, r, F.lane); continue; } r -= I_D;
        if (r < I_IN) { transpose_item(F.in[7] + (size_t)l * D * INW, D, INW, F.in[6] + l * D, (bf16*)((unsigned char*)wl + WL_IN), 0, true, scr, r, F.lane); continue; } r -= I_IN;
        if (r < I_OUT) { transpose_item(F.in[8] + (size_t)l * D * D, D, D, nullptr, (bf16*)((unsigned char*)wl + WL_OUT), 0, false, scr, r, F.lane); continue; } r -= I_OUT;
        if (r < I_G) { transpose_item(F.in[17] + og, D, FF, F.in[16] + l * D, (bf16*)((unsigned char*)wl + WL_GU2), 1, true, scr, r, F.lane); continue; } r -= I_G;
        if (r < I_G) { transpose_item(F.in[18] + og, D, FF, F.in[16] + l * D, (bf16*)((unsigned char*)wl + WL_GU2), 2, true, scr, r, F.lane); continue; } r -= I_G;
        transpose_item(F.in[19] + od, FF, D, nullptr, (bf16*)((unsigned char*)wl + WL_D2), 0, false, scr, r, F.lane);
    }
    {
        bf16* xn = (bf16*)(F.ws + WS_XN); float* rsq = (float*)(F.ws + WS_RSQ); const float* x = F.in[0];
        for (int row = 2 * F.gw; row < MMAIN; row += 2 * F.NGW) {
            const f32x4* xr = (const f32x4*)(x + (size_t)row * D) + F.lane; f32x4 v[8]; float s0 = 0.f, s1 = 0.f;
#pragma unroll
            for (int j = 0; j < 8; ++j) v[j] = xr[64 * j];
#pragma unroll
            for (int j = 0; j < 4; ++j) { s0 += (v[j].x * v[j].x + v[j].y * v[j].y) + (v[j].z * v[j].z + v[j].w * v[j].w); s1 += (v[4 + j].x * v[4 + j].x + v[4 + j].y * v[4 + j].y) + (v[4 + j].z * v[4 + j].z + v[4 + j].w * v[4 + j].w); }
            s0 = wave_sum(s0, F.lane); s1 = wave_sum(s1, F.lane);
            v2u* o8 = (v2u*)(xn + (size_t)row * D) + F.lane;
#pragma unroll
            for (int j = 0; j < 8; ++j) { v2u w; w.x = pk2h(v[j].x, v[j].y); w.y = pk2h(v[j].z, v[j].w); o8[64 * j] = w; }
            if (F.lane < 32) rsq[(size_t)row * 16 + F.lane] = F.lane == 0 ? s0 : (F.lane == 16 ? s1 : 0.f);
        }
    }
    const int gt = F.gw * 64 + F.lane, NGT = F.NGW * 64;
    for (int i = gt; i < DEPTH * 128 * 128; i += NGT) { const int l = i / (128 * 128), e = i % (128 * 128);
        *(v4u*)(F.ws + WS_W + (size_t)l * WL_STRIDE + WL_IN + (size_t)INW * 1024 * 2 + (size_t)e * 16) = (v4u){0u, 0u, 0u, 0u}; }
    for (int i = gt; i < 256 * 256; i += NGT) { const int row = i >> 8, c4 = (i & 255) * 4;
        f32x4 v = (f32x4){0.f, 0.f, 0.f, 0.f}; if (row < NMETA) v = *(const f32x4*)(F.in[1] + row * D + c4);
        *(f32x4*)((float*)(F.ws + WS_HM) + row * D + c4) = v; }
}

__device__ __forceinline__ void norm_phase(Ctx& F, const float* main_src) {
    const float* hm = (const float*)(F.ws + WS_HM); bf16* xn = (bf16*)(F.ws + WS_XN);
    for (int row = F.gw; row < MMAIN + NMETA; row += F.NGW) {
        const float* src = row < MMAIN ? main_src + (size_t)row * D : hm + (size_t)(row - MMAIN) * D;
        const f32x4* xr = (const f32x4*)src + F.lane;
        f32x4 v[4]; float s = 0.f;
#pragma unroll
        for (int j = 0; j < 4; ++j) { v[j] = xr[64 * j]; s += (v[j].x * v[j].x + v[j].y * v[j].y) + (v[j].z * v[j].z + v[j].w * v[j].w); }
        const float rinv = rsqrtf(wave_sum(s, F.lane) * (1.f / D) + EPS);
        v2u* o8 = (v2u*)(xn + (size_t)row * D) + F.lane;
#pragma unroll
        for (int j = 0; j < 4; ++j) { v2u w; w.x = pg8::pk_bf16(v[j].x * rinv, v[j].y * rinv); w.y = pg8::pk_bf16(v[j].z * rinv, v[j].w * rinv); o8[64 * j] = w; }
    }
}
__device__ __forceinline__ void final_phase(Ctx& F) {
    const float* gn = F.in[20]; const unsigned short* hb = (const unsigned short*)(F.ws + WS_XN);
    for (int row = F.gw; row < MMAIN; row += F.NGW) {
        const pg8::f16x4* hr = (const pg8::f16x4*)(hb + (size_t)row * D) + F.lane;
        f32x4 v[4]; float s = 0.f;
#pragma unroll
        for (int j = 0; j < 4; ++j) { const pg8::f16x4 h = hr[64 * j]; v[j] = (f32x4){(float)h[0], (float)h[1], (float)h[2], (float)h[3]}; s += (v[j].x * v[j].x + v[j].y * v[j].y) + (v[j].z * v[j].z + v[j].w * v[j].w); }
        const float rinv = rsqrtf(wave_sum(s, F.lane) * (1.f / D) + EPS);
        f32x4* xr = (f32x4*)(F.out + (size_t)row * D) + F.lane;
#pragma unroll
        for (int j = 0; j < 4; ++j) { const f32x4 g = *((const f32x4*)gn + F.lane + 64 * j); xr[64 * j] = v[j] * rinv * g; }
    }
}

__device__ __forceinline__ bf16x8 lds_frag(const LAS bf16* T, int tile, int kk, int r, int q) { return *(const LAS bf16x8*)(T + (16 * tile + r) * TLD + 32 * kk + 8 * q); }
__device__ __forceinline__ void wave_mma64(const LAS bf16* X, const LAS bf16* Y, f32x4 (&acc)[4][4], int r, int q) {
#pragma unroll
    for (int kk = 0; kk < 2; ++kk) {
        bf16x8 xf[4], yf[4];
#pragma unroll
        for (int i = 0; i < 4; ++i) { xf[i] = lds_frag(X, i, kk, r, q); yf[i] = lds_frag(Y, i, kk, r, q); }
#pragma unroll
        for (int it = 0; it < 4; ++it)
#pragma unroll
            for (int jt = 0; jt < 4; ++jt) acc[it][jt] = __builtin_amdgcn_mfma_f32_16x16x32_bf16(xf[it], yf[jt], acc[it][jt], 0, 0, 0);
    }
}
#define ZERO_ACC(a) do { _Pragma("unroll") for (int _i = 0; _i < 4; ++_i) _Pragma("unroll") for (int _j = 0; _j < 4; ++_j) a[_i][_j] = (f32x4){0.f, 0.f, 0.f, 0.f}; } while (0)


template <int KIND, int KSTEPS, bool AF32>
__device__ __forceinline__ void skinny_gemm(Ctx& F, const bf16* A, int lda, const bf16* Bt, int nslab, bf16* O, int ldo, float* hm, float scale) {
    constexpr int K = KSTEPS * 32 * 8, NBT = KIND == 0 ? 2 : 1;
    const int lane = F.lane, r = lane & 15, q = lane >> 4, w = F.wave, tid = F.tid;
    LAS float* part = (LAS float*)F.lds;
    LAS float* partsq = part + 8 * NBT * 256;
    for (int slab = F.gw / NWAVES; slab < nslab; slab += F.G) {
        const int brow0 = KIND == 0 ? ((slab * 16) >> 7) * 256 + ((slab * 16) & 127) : slab * 16;
        bf16x8 af[KSTEPS], bfr[NBT][KSTEPS];
#pragma unroll
        for (int t = 0; t < NBT; ++t) { const bf16* bp = Bt + (size_t)(brow0 + 128 * t + r) * K + w * (K / 8) + 8 * q;
#pragma unroll
            for (int kk = 0; kk < KSTEPS; ++kk) bfr[t][kk] = *(const bf16x8*)(bp + 32 * kk); }
        if (AF32) { const float* ap = hm + (size_t)r * D + w * (K / 8) + 8 * q; float ssq = 0.f;
#pragma unroll
            for (int kk = 0; kk < KSTEPS; ++kk) { const f32x4 x0 = *(const f32x4*)(ap + 32 * kk), x1 = *(const f32x4*)(ap + 32 * kk + 4);
                ssq += ((x0[0] * x0[0] + x0[1] * x0[1]) + (x0[2] * x0[2] + x0[3] * x0[3])) + ((x1[0] * x1[0] + x1[1] * x1[1]) + (x1[2] * x1[2] + x1[3] * x1[3]));
                v4u pk; pk.x = pk2h(x0[0], x0[1]); pk.y = pk2h(x0[2], x0[3]); pk.z = pk2h(x1[0], x1[1]); pk.w = pk2h(x1[2], x1[3]); af[kk] = __builtin_bit_cast(bf16x8, pk); }
            ssq += shx(ssq, 16, lane); ssq += shx(ssq, 32, lane);
            if (q == 0) partsq[w * 16 + r] = ssq;
        } else { const bf16* ap = A + (size_t)r * lda + w * (K / 8) + 8 * q;
#pragma unroll
            for (int kk = 0; kk < KSTEPS; ++kk) af[kk] = *(const bf16x8*)(ap + 32 * kk); }
#pragma unroll
        for (int t = 0; t < NBT; ++t) { f32x4 acc = (f32x4){0.f, 0.f, 0.f, 0.f};
#pragma unroll
            for (int kk = 0; kk < KSTEPS; ++kk) acc = AF32 ? __builtin_amdgcn_mfma_f32_16x16x32_f16(__builtin_bit_cast(pg8::f16x8, bfr[t][kk]), __builtin_bit_cast(pg8::f16x8, af[kk]), acc, 0, 0, 0)
                                                           : __builtin_amdgcn_mfma_f32_16x16x32_bf16(bfr[t][kk], af[kk], acc, 0, 0, 0);
#pragma unroll
            for (int e = 0; e < 4; ++e) part[(w * NBT + t) * 256 + (4 * q + e) * 16 + r] = acc[e]; }
        __syncthreads();
        if (tid < 256) { const int tok = tid >> 4, n = tid & 15; float s = 0.f, s2 = 0.f, sq = 0.f;
#pragma unroll
            for (int ww = 0; ww < 8; ++ww) { s += part[(ww * NBT) * 256 + n * 16 + tok]; if (KIND == 0) s2 += part[(ww * NBT + 1) * 256 + n * 16 + tok]; if (AF32) sq += partsq[ww * 16 + tok]; }
            if (AF32) { const float rinv = rsqrtf(sq * (1.0f / D) + EPS); s *= rinv; s2 *= rinv; }
            if (KIND == 0) O[(size_t)(METAROW + tok) * ldo + slab * 16 + n] = (bf16)f2bf(pg8::silu_f(s) * s2);
            else if (KIND == 1) hm[tok * D + slab * 16 + n] += scale * s;
            else O[(size_t)(METAROW + tok) * ldo + slab * 16 + n] = (bf16)f2bf(s); }
        __syncthreads();
    }
}

constexpr int RTAB_OFF = pg8::STAGE_BYTES, RTAB_UNITS = 12;
static_assert(RTAB_OFF + RTAB_UNITS * 256 * 4 <= BAR_LDS_OFF, "rinv table");
__device__ __forceinline__ void build_rinv_table(Ctx& F, const pg8::StaticOrder& S, const float* rowsq) {
    LAS float* tab = (LAS float*)(F.lds + RTAB_OFF);
    const int rl = F.tid >> 1, h = F.tid & 1;
    f32x4 a[RTAB_UNITS], b[RTAB_UNITS]; bool ok[RTAB_UNITS];
#pragma unroll
    for (int i = 0; i < RTAB_UNITS; ++i) { pg8::Unit u; ok[i] = S.next(i, u);
        if (ok[i]) { const f32x4* rp = (const f32x4*)(rowsq + (size_t)(u.pm * 256 + rl) * 16 + h * 8); a[i] = rp[0]; b[i] = rp[1]; } }
#pragma unroll
    for (int i = 0; i < RTAB_UNITS; ++i) if (ok[i]) { float s = ((a[i][0] + a[i][1]) + (a[i][2] + a[i][3])) + ((b[i][0] + b[i][1]) + (b[i][2] + b[i][3]));
        s += shx(s, 1, F.lane);
        if (h == 0) tab[i * 256 + rl] = rsqrtf(s * (1.0f / D) + EPS); }
    __syncthreads();
}

__device__ __forceinline__ float lb_of(const float* lg, int l, int ch) {
    const float x0 = lg[ch], x1 = lg[384 + ch], x2 = lg[768 + ch], x3 = lg[1152 + ch];
    const float m = fmaxf(fmaxf(x0, x1), fmaxf(x2, x3));
    const float e0 = __expf(x0 - m), e1 = __expf(x1 - m), e2 = __expf(x2 - m), e3 = __expf(x3 - m);
    float c = 0.f; if (l >= 1) c += e1; if (l >= 2) c += e2; if (l >= 3) c += e3;
    return c / (e0 + e1 + e2 + e3);
}
__device__ __forceinline__ int hg_row(int b, int c, int j) { return c == 0 ? (j < 48 ? -1 : METAROW + j - 48) : b * SEQ + (c - 1) * 64 + j; }

#define HG_LOAD_TILE(dst, col0) do { _Pragma("unroll") for (int _i = 0; _i < 8; ++_i) { const int _row = hg_row(b, c, (lane >> 3) + 8 * _i); \
        dst[_i] = *(const v4u*)(P + (size_t)(_row >= 0 ? _row : METAROW) * LDP + (col0) + hd * 64 + 8 * (lane & 7)); if (_row < 0) dst[_i] = (v4u){0u, 0u, 0u, 0u}; } } while (0)
#define HG_STORE_TILE(T, src) do { _Pragma("unroll") for (int _i = 0; _i < 8; ++_i) *(LAS v4u*)((T) + ((lane >> 3) + 8 * _i) * TLD + 8 * (lane & 7)) = src[_i]; } while (0)
#define HG_STORE_TILE_T(T, src) do { _Pragma("unroll") for (int _i = 0; _i < 8; ++_i) { const int _t = (lane >> 3) + 8 * _i; LAS bf16* _d = (T) + (8 * (lane & 7)) * TLD + _t; \
        _d[0 * TLD] = (bf16)(src[_i].x & 0xffffu); _d[1 * TLD] = (bf16)(src[_i].x >> 16); _d[2 * TLD] = (bf16)(src[_i].y & 0xffffu); _d[3 * TLD] = (bf16)(src[_i].y >> 16); \
        _d[4 * TLD] = (bf16)(src[_i].z & 0xffffu); _d[5 * TLD] = (bf16)(src[_i].z >> 16); _d[6 * TLD] = (bf16)(src[_i].w & 0xffffu); _d[7 * TLD] = (bf16)(src[_i].w >> 16); } } while (0)

__device__ __forceinline__ void hgrn_p1_unit(Ctx& F, int l, int unit) {
    const int lane = F.lane, r = lane & 15, q = lane >> 4;
    const int bh = unit / HG_NC, c = unit % HG_NC, b = bh / 6, hd = bh % 6, ch = hd * 64 + lane;
    const bf16* P = (const bf16*)(F.ws + WS_ACT);
    LAS bf16* T0 = (LAS bf16*)(F.lds + F.wave * WAVE_LDS); LAS bf16* T1 = T0 + 64 * TLD;
    v4u zraw[8], vraw[8];
    HG_LOAD_TILE(zraw, P_AF); HG_LOAD_TILE(vraw, P_AI);
    const float lb = lb_of(F.in[9], l, ch), oml = 1.0f - lb;
    HG_STORE_TILE(T1, zraw);
    LDS_WAIT();
    const int jlo = c == 0 ? 48 : 0;
    const float lom2 = __builtin_amdgcn_logf(oml);
    float G = 0.f;
    for (int j0 = jlo; j0 < 64; j0 += 16) { HG_GATE16(T1, j0);
#pragma unroll
        for (int i = 0; i < 16; ++i) G += lf[i]; }
    const float Glast = G; G = 0.f;
    for (int j = 0; j < jlo; ++j) T0[lane * TLD + j] = (bf16)0;
    for (int j0 = jlo; j0 < 64; j0 += 16) { HG_GATE16(T1, j0); float kx[16];
#pragma unroll
        for (int i = 0; i < 16; ++i) { G += lf[i]; kx[i] = (lom2 - z2[i] - a1[i]) + (Glast - G); }
#pragma unroll
        for (int i = 0; i < 16; ++i) kx[i] = __builtin_amdgcn_exp2f(kx[i]);
#pragma unroll
        for (int i = 0; i < 16; ++i) T0[lane * TLD + j0 + i] = (bf16)bf1(kx[i]); }
    ((float*)(F.ws + WS_DEC))[(size_t)unit * 64 + lane] = __builtin_amdgcn_exp2f(Glast);
    LDS_WAIT();
    HG_STORE_TILE_T(T1, vraw);
    LDS_WAIT();
    f32x4 acc[4][4]; ZERO_ACC(acc);
    wave_mma64(T1, T0, acc, r, q);
    float* ds = (float*)(F.ws + WS_DS) + (size_t)unit * 4096;
#pragma unroll
    for (int it = 0; it < 4; ++it)
#pragma unroll
        for (int jt = 0; jt < 4; ++jt)
#pragma unroll
            for (int e = 0; e < 4; ++e) ds[(16 * it + 4 * q + e) * 64 + 16 * jt + r] = acc[it][jt][e];
    LDS_WAIT();
}
__device__ __forceinline__ void hgrn_scan(Ctx& F) {
    typedef float f32x2v __attribute__((ext_vector_type(2)));
    const float* __restrict__ ds = (const float*)(F.ws + WS_DS); const float* __restrict__ dec = (const float*)(F.ws + WS_DEC); bf16* __restrict__ st = (bf16*)(F.ws + WS_ST);
    const int gt = F.gw * 64 + F.lane, NGT = F.NGW * 64;
    for (int idx = gt; idx < NB * 6 * 2048; idx += NGT) {
        const int bh = idx >> 11, e = (idx & 2047) * 2, dk = e & 63; float r0 = 0.f, r1 = 0.f;
        const size_t u0 = (size_t)bh * HG_NC;
#pragma unroll
        for (int c0 = 0; c0 < HG_NC; c0 += 33) {
            f32x2v d[33], x[33];
#pragma unroll
            for (int j = 0; j < 33; ++j) if (c0 + j < HG_NC) { d[j] = *(const f32x2v*)(dec + (u0 + c0 + j) * 64 + dk); x[j] = *(const f32x2v*)(ds + (u0 + c0 + j) * 4096 + e); }
#pragma unroll
            for (int j = 0; j < 33; ++j) if (c0 + j < HG_NC) { *(unsigned*)(st + (u0 + c0 + j) * 4096 + e) = pk2(r0, r1); r0 = r0 * d[j].x + x[j].x; r1 = r1 * d[j].y + x[j].y; }
        }
    }
}
__device__ __forceinline__ void hgrn_p3_unit(Ctx& F, int l, int unit) {
    const int lane = F.lane, r = lane & 15, q = lane >> 4;
    const int bh = unit / HG_NC, c = unit % HG_NC, b = bh / 6, hd = bh % 6, ch = hd * 64 + lane;
    if (c == 0 && b > 0) return;
    const bf16* P = (const bf16*)(F.ws + WS_ACT); bf16* Y = (bf16*)F.out;
    LAS bf16* T0 = (LAS bf16*)(F.lds + F.wave * WAVE_LDS); LAS bf16* T1 = T0 + 64 * TLD; LAS float* EG = (LAS float*)(T1 + 64 * TLD);
    {
        v4u zraw[8], qraw[8];
        HG_LOAD_TILE(zraw, P_AF); HG_LOAD_TILE(qraw, P_AQ);
        HG_STORE_TILE(T1, zraw); HG_STORE_TILE(T0, qraw);
    }
    const float lb = lb_of(F.in[9], l, ch), oml = 1.0f - lb;
    LDS_WAIT();
    const int jlo = c == 0 ? 48 : 0;
    const float lom2 = __builtin_amdgcn_logf(oml);
    float G = 0.f;
    for (int j0 = jlo; j0 < 32; j0 += 16) { HG_GATE16(T1, j0);
#pragma unroll
        for (int i = 0; i < 16; ++i) G += lf[i]; }
    const float Gm = G; G = 0.f;
    for (int j0 = jlo; j0 < 64; j0 += 16) { HG_GATE16(T1, j0); float qx[16], kx[16], qv[16];
#pragma unroll
        for (int i = 0; i < 16; ++i) qv[i] = bf2f(T0[(j0 + i) * TLD + lane]);
#pragma unroll
        for (int i = 0; i < 16; ++i) { G += lf[i]; qx[i] = G - Gm; kx[i] = (lom2 - z2[i] - a1[i]) + (Gm - G); }
#pragma unroll
        for (int i = 0; i < 16; ++i) { qx[i] = __builtin_amdgcn_exp2f(qx[i]); kx[i] = __builtin_amdgcn_exp2f(kx[i]); }
#pragma unroll
        for (int i = 0; i < 16; ++i) { T0[(j0 + i) * TLD + lane] = (bf16)bf1(qv[i] * qx[i]); T1[(j0 + i) * TLD + lane] = (bf16)bf1(kx[i]); } }
    EG[lane] = __builtin_amdgcn_exp2f(Gm);
    LDS_WAIT();
    f32x4 accA[4][4], accO[4][4]; ZERO_ACC(accA); ZERO_ACC(accO);
    wave_mma64(T1, T0, accA, r, q);
    {
        const bf16* st = (const bf16*)(F.ws + WS_ST) + (size_t)unit * 4096;
#pragma unroll
        for (int kk = 0; kk < 2; ++kk) {
            bf16x8 yf[4]; float eg[8]; v4u raw[4];
#pragma unroll
            for (int it = 0; it < 4; ++it) raw[it] = *(const v4u*)(st + (16 * it + r) * 64 + 32 * kk + 8 * q);
#pragma unroll
            for (int i = 0; i < 4; ++i) yf[i] = lds_frag(T0, i, kk, r, q);
#pragma unroll
            for (int j = 0; j < 8; ++j) eg[j] = EG[32 * kk + 8 * q + j];
#pragma unroll
            for (int it = 0; it < 4; ++it) {
                v4u sc;
                sc.x = pk2(bf2f(raw[it].x & 0xffffu) * eg[0], bf2f(raw[it].x >> 16) * eg[1]); sc.y = pk2(bf2f(raw[it].y & 0xffffu) * eg[2], bf2f(raw[it].y >> 16) * eg[3]);
                sc.z = pk2(bf2f(raw[it].z & 0xffffu) * eg[4], bf2f(raw[it].z >> 16) * eg[5]); sc.w = pk2(bf2f(raw[it].w & 0xffffu) * eg[6], bf2f(raw[it].w >> 16) * eg[7]);
                const bf16x8 xf = __builtin_bit_cast(bf16x8, sc);
#pragma unroll
                for (int jt = 0; jt < 4; ++jt) accO[it][jt] = __builtin_amdgcn_mfma_f32_16x16x32_bf16(xf, yf[jt], accO[it][jt], 0, 0, 0);
            }
        }
    }
    v4u vraw[8];
    HG_LOAD_TILE(vraw, P_AI);
    LDS_WAIT();
#pragma unroll
    for (int it = 0; it < 4; ++it)
#pragma unroll
        for (int jt = 0; jt < 4; ++jt) { const int t = 16 * jt + r, s0 = 16 * it + 4 * q; const f32x4 a = accA[it][jt];
            v2u w; w.x = pk2(s0 + 0 <= t ? a[0] : 0.f, s0 + 1 <= t ? a[1] : 0.f); w.y = pk2(s0 + 2 <= t ? a[2] : 0.f, s0 + 3 <= t ? a[3] : 0.f);
            *(LAS v2u*)(T0 + t * TLD + s0) = w; }
    HG_STORE_TILE_T(T1, vraw);
    LDS_WAIT();
    wave_mma64(T1, T0, accO, r, q);
    const float* og = F.in[10] + l * 64;
    v2u graw[4][4]; f32x4 gn[4];
#pragma unroll
    for (int it = 0; it < 4; ++it) gn[it] = *(const f32x4*)(og + 16 * it + 4 * q);
#pragma unroll
    for (int jt = 0; jt < 4; ++jt) { const int row = hg_row(b, c, 16 * jt + r);
#pragma unroll
        for (int it = 0; it < 4; ++it) graw[jt][it] = *(const v2u*)(P + (size_t)(row >= 0 ? row : METAROW) * LDP + P_AG + hd * 64 + 16 * it + 4 * q); }
#pragma unroll
    for (int jt = 0; jt < 4; ++jt) {
        const int t = 16 * jt + r, row = hg_row(b, c, t);
        float ss = 0.f;
#pragma unroll
        for (int it = 0; it < 4; ++it) { const f32x4 o = accO[it][jt]; ss += (o[0] * o[0] + o[1] * o[1]) + (o[2] * o[2] + o[3] * o[3]); }
        ss += shx(ss, 16, lane); ss += shx(ss, 32, lane);
        const float rinv = rsqrtf(ss * (1.0f / 64.0f) + EPS);
        if (row >= 0) {
#pragma unroll
            for (int it = 0; it < 4; ++it) { const int dv0 = 16 * it + 4 * q; const f32x4 o = accO[it][jt]; const v2u gr = graw[jt][it];
                const float g0 = bf2f(gr.x & 0xffffu), g1 = bf2f(gr.x >> 16), g2 = bf2f(gr.y & 0xffffu), g3 = bf2f(gr.y >> 16);
                v2u w; w.x = pg8::pk_bf16(o[0] * rinv * gn[it][0] * pg8::silu_f(g0), o[1] * rinv * gn[it][1] * pg8::silu_f(g1)); w.y = pg8::pk_bf16(o[2] * rinv * gn[it][2] * pg8::silu_f(g2), o[3] * rinv * gn[it][3] * pg8::silu_f(g3));
                *(v2u*)(Y + (size_t)row * D + hd * 64 + dv0) = w; }
        }
    }
    LDS_WAIT();
}

struct AtTile { bf16x8 kf[2][2]; bf16x8 vf[4]; };
__device__ __forceinline__ void attn_load(AtTile& T, const bf16* P, int krow_a, int krow_b, int kcol, int vcol, int r, int q) {
#pragma unroll
    for (int kk = 0; kk < 2; ++kk) { T.kf[0][kk] = *(const bf16x8*)(P + (size_t)(krow_a + r) * LDP + kcol + 32 * kk + 8 * q); T.kf[1][kk] = *(const bf16x8*)(P + (size_t)(krow_b + r) * LDP + kcol + 32 * kk + 8 * q); }
#pragma unroll
    for (int it = 0; it < 4; ++it) { const bf16* va = P + (size_t)(krow_a + 4 * q) * LDP + vcol + 16 * it + r; const bf16* vb = P + (size_t)(krow_b + 4 * q) * LDP + vcol + 16 * it + r;
#pragma unroll
        for (int j = 0; j < 4; ++j) { T.vf[it][j] = (short)va[(size_t)j * LDP]; T.vf[it][4 + j] = (short)vb[(size_t)j * LDP]; } }
}
__device__ __forceinline__ void attn_compute(const AtTile& T, const bf16x8 (&qf)[2][2], f32x4 (&accO)[4][2], float (&mrow)[2], float (&lrow)[2], int mode, int dpos, int r, int q) {
    const int lane = 16 * q + r;
    f32x4 s[2][2];
#pragma unroll
    for (int it = 0; it < 2; ++it)
#pragma unroll
        for (int jt = 0; jt < 2; ++jt) { s[it][jt] = (f32x4){0.f, 0.f, 0.f, 0.f};
#pragma unroll
            for (int kk = 0; kk < 2; ++kk) s[it][jt] = __builtin_amdgcn_mfma_f32_16x16x32_bf16(T.kf[it][kk], qf[jt][kk], s[it][jt], 0, 0, 0); }
    const float NEG = -INFINITY;
    bf16x8 pf[2];
#pragma unroll
    for (int jt = 0; jt < 2; ++jt) {
        float mx = NEG;
#pragma unroll
        for (int it = 0; it < 2; ++it)
#pragma unroll
            for (int e = 0; e < 4; ++e) { const int key = 16 * it + 4 * q + e, t = 16 * jt + r; bool valid;
                if (mode == 0) { const int dd = dpos + t - key; valid = dd >= 0 && dd < 128; } else if (mode == 1) valid = key < 16; else valid = key <= t && key < 16;
                const float v = valid ? s[it][jt][e] * 0.125f : NEG; s[it][jt][e] = v; mx = fmaxf(mx, v); }
        mx = fmaxf(mx, shx(mx, 16, lane)); mx = fmaxf(mx, shx(mx, 32, lane));
        const float mn = fmaxf(mrow[jt], mx), alpha = __expf(mrow[jt] - mn); mrow[jt] = mn;
        float ps = 0.f;
#pragma unroll
        for (int it = 0; it < 2; ++it)
#pragma unroll
            for (int e = 0; e < 4; ++e) { const float pe = __expf(s[it][jt][e] - mn); s[it][jt][e] = pe; ps += pe; }
        ps += shx(ps, 16, lane); ps += shx(ps, 32, lane);
        lrow[jt] = lrow[jt] * alpha + ps;
#pragma unroll
        for (int it = 0; it < 4; ++it) accO[it][jt] = accO[it][jt] * alpha;
        v4u w; w.x = pg8::pk_bf16(s[0][jt][0], s[0][jt][1]); w.y = pg8::pk_bf16(s[0][jt][2], s[0][jt][3]); w.z = pg8::pk_bf16(s[1][jt][0], s[1][jt][1]); w.w = pg8::pk_bf16(s[1][jt][2], s[1][jt][3]);
        pf[jt] = __builtin_bit_cast(bf16x8, w);
    }
#pragma unroll
    for (int it = 0; it < 4; ++it)
#pragma unroll
        for (int jt = 0; jt < 2; ++jt) accO[it][jt] = __builtin_amdgcn_mfma_f32_16x16x32_bf16(T.vf[it], pf[jt], accO[it][jt], 0, 0, 0);
}
__device__ __forceinline__ void attn_unit(Ctx& F, int l, int unit) {
    const int lane = F.lane, r = lane & 15, q = lane >> 4;
    const bf16* P = (const bf16*)(F.ws + WS_ACT); bf16* Y = (bf16*)F.out;
    const bool is_meta = unit >= NB * 6 * 128;
    int b = 0, hq, t0 = 0;
    if (is_meta) hq = unit - NB * 6 * 128; else { b = unit / 768; const int rem = unit % 768; hq = rem >> 7; t0 = (rem & 127) * 32; }
    const int kvh = hq / 3; const float sink = F.in[11][l * 6 + hq];
    const int qrow0 = is_meta ? METAROW : b * SEQ + t0;
    const int kcol = P_BK + kvh * 64, vcol = P_BV + kvh * 64;
    int first = is_meta ? 5 : (t0 >= 128 ? 0 : (128 - t0) / 32);
    AtTile cur, nxt;
    if (first < 5) attn_load(cur, P, b * SEQ + t0 - 128 + 32 * first, b * SEQ + t0 - 128 + 32 * first + 16, kcol, vcol, r, q); else attn_load(cur, P, METAROW, METAROW, kcol, vcol, r, q);
    bf16x8 qf[2][2];
#pragma unroll
    for (int jt = 0; jt < 2; ++jt)
#pragma unroll
        for (int kk = 0; kk < 2; ++kk) qf[jt][kk] = *(const bf16x8*)(P + (size_t)(qrow0 + 16 * jt + r) * LDP + P_BQ + hq * 64 + 32 * kk + 8 * q);
    f32x4 accO[4][2];
#pragma unroll
    for (int it = 0; it < 4; ++it) { accO[it][0] = (f32x4){0.f, 0.f, 0.f, 0.f}; accO[it][1] = (f32x4){0.f, 0.f, 0.f, 0.f}; }
    float mrow[2], lrow[2];
#pragma unroll
    for (int jt = 0; jt < 2; ++jt) { mrow[jt] = sink; lrow[jt] = 1.0f; }
    for (int idx = first; idx < 6; ++idx) {
        if (idx < 4) attn_load(nxt, P, b * SEQ + t0 - 96 + 32 * idx, b * SEQ + t0 - 96 + 32 * idx + 16, kcol, vcol, r, q); else if (idx == 4) attn_load(nxt, P, METAROW, METAROW, kcol, vcol, r, q);
        attn_compute(cur, qf, accO, mrow, lrow, idx < 5 ? 0 : (is_meta ? 2 : 1), 128 - 32 * idx, r, q);
        cur = nxt;
    }
#pragma unroll
    for (int jt = 0; jt < 2; ++jt) {
        if (is_meta && jt > 0) continue;
        const float inv = 1.0f / lrow[jt]; const size_t row = (size_t)(qrow0 + 16 * jt + r);
#pragma unroll
        for (int it = 0; it < 4; ++it) { const f32x4 o = accO[it][jt]; v2u w; w.x = pg8::pk_bf16(o[0] * inv, o[1] * inv); w.y = pg8::pk_bf16(o[2] * inv, o[3] * inv);
            *(v2u*)(Y + row * D + 384 + hq * 64 + 16 * it + 4 * q) = w; }
    }
}

__device__ __forceinline__ void conv_phase(Ctx& F, int l) {
    const bf16* P = (const bf16*)(F.ws + WS_ACT); bf16* Y = (bf16*)F.out;
    LAS float* GL = (LAS float*)F.lds;
    LAS float* OT = GL + 64 * 256;
    const int tid = F.tid, lane = F.lane, wave = F.wave, ch = tid & 255, half = tid >> 8;
    float wt[31];
#pragma unroll
    for (int w = 0; w < 31; ++w) wt[w] = F.in[12][(size_t)(l * 31 + w) * 256 + ch];
    const float bias = F.in[13][l * 256 + ch];
    const f32x4 lg4 = *(const f32x4*)(F.in[14] + l * 256 + 4 * lane), lb4 = *(const f32x4*)(F.in[15] + l * 256 + 4 * lane);
    const int bidc = F.gw / NWAVES;
    for (int uu = bidc; uu < CV_UNITS - 1 + F.G; uu += F.G) {
        int u = uu; if (uu >= CV_UNITS - 1) { if (bidc != F.G - 1) break; u = CV_UNITS - 1; }
        const bool is_meta = (u == CV_UNITS - 1); const int b = is_meta ? 0 : (u >> 7), t0 = is_meta ? 0 : (u & 127) * 32;
        v2u araw[8], graw[8];
#pragma unroll
        for (int ii = 0; ii < 8; ++ii) { const int i = wave + 8 * ii; int row;
            if (is_meta) { const int pos = i - 30; row = (pos >= 0 && pos < NMETA) ? METAROW + pos : -1; }
            else { const int idx = t0 - 30 + i; row = idx >= 0 ? b * SEQ + idx : (idx >= -NMETA ? METAROW + idx + NMETA : -1); }
            const size_t ro = (size_t)(row >= 0 ? row : METAROW) * LDP + P_CU + 4 * lane;
            araw[ii] = *(const v2u*)(P + ro); graw[ii] = *(const v2u*)(P + ro + 256);
            if (row < 0) araw[ii] = (v2u){0u, 0u}; }
#pragma unroll
        for (int ii = 0; ii < 8; ++ii) { const int i = wave + 8 * ii; const v2u a = araw[ii], g = graw[ii]; f32x4 gl;
            gl[0] = bf2f(a.x & 0xffffu) * sigm(bf2f(g.x & 0xffffu)); gl[1] = bf2f(a.x >> 16) * sigm(bf2f(g.x >> 16));
            gl[2] = bf2f(a.y & 0xffffu) * sigm(bf2f(g.y & 0xffffu)); gl[3] = bf2f(a.y >> 16) * sigm(bf2f(g.y >> 16));
            *(LAS f32x4*)(GL + i * 256 + 4 * lane) = gl; }
        __syncthreads();
        float gw_[46], o[16];
#pragma unroll
        for (int i = 0; i < 46; ++i) gw_[i] = GL[(half * 16 + i) * 256 + ch];
#pragma unroll
        for (int jj = 0; jj < 16; ++jj) { float a = bias;
#pragma unroll
            for (int w = 0; w < 31; ++w) a += gw_[jj + w] * wt[w];
            o[jj] = a; }
#pragma unroll
        for (int jj = 0; jj < 16; ++jj) OT[(half * 16 + jj) * 256 + ch] = o[jj];
        __syncthreads();
#pragma unroll
        for (int k = 0; k < 4; ++k) { const int tok = 4 * wave + k; const f32x4 v = *(const LAS f32x4*)(OT + tok * 256 + 4 * lane);
            const float s1 = wave_sum((v[0] + v[1]) + (v[2] + v[3]), lane), s2 = wave_sum((v[0] * v[0] + v[1] * v[1]) + (v[2] * v[2] + v[3] * v[3]), lane);
            const float mean = s1 * (1.0f / 256.0f), var = fmaxf(s2 * (1.0f / 256.0f) - mean * mean, 0.f), rstd = rsqrtf(var + EPS);
            int row; if (is_meta) row = tok < NMETA ? METAROW + tok : -1; else row = b * SEQ + t0 + tok;
            if (row >= 0) { v2u w; w.x = pg8::pk_bf16(pg8::silu_f((v[0] - mean) * rstd * lg4[0] + lb4[0]), pg8::silu_f((v[1] - mean) * rstd * lg4[1] + lb4[1]));
                w.y = pg8::pk_bf16(pg8::silu_f((v[2] - mean) * rstd * lg4[2] + lb4[2]), pg8::silu_f((v[3] - mean) * rstd * lg4[3] + lb4[3]));
                *(v2u*)(Y + (size_t)row * D + 768 + 4 * lane) = w; } }
    }
    __syncthreads();
}

#define XB_TMO      128
#define XB_XCNT(j)  (256  + 64 * (j))
#define XB_XSUB(j)  (1280 + 64 * (j))
#define XB_XGEN(j)  (2304 + 64 * (j))
#define XB_TOP      3328
#define XB_TOPGEN   3392
#define XCD_BAR_WORDS 3456
#define XB_SPIN_CAP (1u << 18)

__device__ __forceinline__ unsigned xb_ld(unsigned* p)              { return __hip_atomic_load(p, __ATOMIC_RELAXED, __HIP_MEMORY_SCOPE_AGENT); }
__device__ __forceinline__ unsigned xb_add(unsigned* p, unsigned v) { return __hip_atomic_fetch_add(p, v, __ATOMIC_RELAXED, __HIP_MEMORY_SCOPE_AGENT); }
__device__ __forceinline__ unsigned xb_xcc_id() { return (unsigned)__builtin_amdgcn_s_getreg((3 << 11) | 20) & 0xFu; }
#define XB_SPIN(cond, bar) do { unsigned _sp = 0; while (cond) { __builtin_amdgcn_s_sleep(1); \
    if ((++_sp & 255u) == 0u) { if (xb_ld(&(bar)[XB_TMO])) break; if (_sp > XB_SPIN_CAP) { atomicAdd(&(bar)[XB_TMO], 1u); break; } } } } while (0)

struct XcdBarrier {
    unsigned* bar; unsigned x;
    volatile LAS unsigned* st;
};

__device__ __forceinline__ XcdBarrier xcd_barrier_post(unsigned* bar, volatile LAS unsigned* st, int tid) {
    XcdBarrier b; b.bar = bar; b.x = xb_xcc_id(); b.st = st;
    if (tid == 0) (void)xb_add(&bar[XB_XCNT(b.x)], 1u);
    return b;
}
__device__ __forceinline__ void xcd_barrier_complete(unsigned* bar, unsigned x, unsigned& nloc, unsigned& nx) {
    const unsigned G = gridDim.x * gridDim.y * gridDim.z;
    unsigned sum, cnt, mine, sp = 0u;
    for (;;) {
        sum = 0u; cnt = 0u; mine = 0u;
#pragma unroll
        for (unsigned j = 0; j < 16; ++j) { const unsigned c = xb_ld(&bar[XB_XCNT(j)]); sum += c; cnt += (c > 0u) ? 1u : 0u; mine = (j == x) ? c : mine; }
        if (sum == G) break;
        __builtin_amdgcn_s_sleep(1);
        if ((++sp & 255u) == 0u) { if (xb_ld(&bar[XB_TMO])) break; if (sp > XB_SPIN_CAP) { atomicAdd(&bar[XB_TMO], 1u); break; } }
    }
    nloc = mine > 0u ? mine : 1u; nx = cnt > 0u ? cnt : 1u;
}

__device__ __forceinline__ void xcd_barrier(const XcdBarrier& b, int tid) {
    asm volatile("s_waitcnt vmcnt(0)" ::: "memory");
    __syncthreads();
    if (tid == 0) {
        unsigned* bar = b.bar;
        __builtin_amdgcn_s_waitcnt(0);
        unsigned nloc = b.st[0], nx = b.st[1];
        if (nloc == 0u) { xcd_barrier_complete(bar, b.x, nloc, nx); b.st[0] = nloc; b.st[1] = nx; }
        const unsigned old = xb_add(&bar[XB_XSUB(b.x)], 1u);
        const unsigned gen = old / nloc;
        if (old + 1u == (gen + 1u) * nloc) {
            __builtin_amdgcn_fence(__ATOMIC_RELEASE, "agent");
            asm volatile("s_waitcnt vmcnt(0)" ::: "memory");
            const unsigned og = xb_add(&bar[XB_TOP], 1u);
            const unsigned tg = og / nx;
            if (og + 1u == (tg + 1u) * nx) xb_add(&bar[XB_TOPGEN], 1u);
            else XB_SPIN(xb_ld(&bar[XB_TOPGEN]) == tg, bar);
            __builtin_amdgcn_fence(__ATOMIC_ACQUIRE, "agent");
            xb_add(&bar[XB_XGEN(b.x)], 1u);
            asm volatile("s_waitcnt vmcnt(0)" ::: "memory");
        } else {
            XB_SPIN(xb_ld(&bar[XB_XGEN(b.x)]) == gen, bar);
            __builtin_amdgcn_fence(__ATOMIC_ACQUIRE, "agent");
            asm volatile("s_waitcnt vmcnt(0)" ::: "memory");
        }
    }
    __syncthreads();
}

constexpr int N_PC = 2 + 9 * DEPTH;
#ifndef PHMASK
#define PHMASK 0xffff
#endif
#define PHON(k) ((PHMASK >> (k)) & 1)
__global__ void __launch_bounds__(NTHREADS, 2) fwd_kernel(Args args) {
    extern __shared__ __attribute__((aligned(16))) unsigned char lds_raw[];
    volatile LAS unsigned* bst = (volatile LAS unsigned*)((LAS unsigned char*)lds_raw + BAR_LDS_OFF);
    if (threadIdx.x == 0) { bst[0] = 0u; bst[1] = 0u; }
    __syncthreads();
    XcdBarrier gbar = xcd_barrier_post((unsigned*)(args.ws + WS_CTL), bst, (int)threadIdx.x);
    const int wave_s = __builtin_amdgcn_readfirstlane((int)threadIdx.x >> 6);
    for (int pc = args.pc_lo; pc < args.pc_hi; ++pc) {
        int lane_; asm volatile("v_mbcnt_lo_u32_b32 %0, -1, 0\n\tv_mbcnt_hi_u32_b32 %0, -1, %0" : "=v"(lane_));
        int tid_ = wave_s * 64 + lane_, pcv = pc, bid_ = blockIdx.x, grd_ = gridDim.x; asm volatile("" : "+v"(tid_)); asm volatile("" : "+s"(pcv), "+s"(bid_), "+s"(grd_));
        Ctx F;
        ArgsP ap = (ArgsP)__builtin_amdgcn_kernarg_segment_ptr(); asm volatile("" : "+s"(ap));
        F.in.ap = ap; F.out = ap->out; F.ws = ap->ws; F.lds = (LAS unsigned char*)lds_raw;
        F.tid = tid_; F.lane = F.tid & 63; F.wave = __builtin_amdgcn_readfirstlane(F.tid >> 6); F.G = grd_;
        F.gw = bid_ * NWAVES + F.wave; F.NGW = F.G * NWAVES;
        bf16* HB = (bf16*)(F.ws + WS_XN); bf16* YB = (bf16*)F.out; bf16* ACT = (bf16*)(F.ws + WS_ACT); float* HM = (float*)(F.ws + WS_HM); float* RSQ = (float*)(F.ws + WS_RSQ);
        const int l = pcv == 0 ? 0 : (pcv - 1) / 9, s = pcv == 0 ? -1 : (pcv == N_PC - 1 ? 9 : (pcv - 1) % 9);
        const unsigned char* wl = F.ws + WS_W + (size_t)l * WL_STRIDE;
        if (s == -1) { if (PHON(0)) prologue(F); }
        else if (s == 0 || s == 7) {
            const bf16* wgu = (const bf16*)(wl + (s == 0 ? WL_GU1 : WL_GU2));
            if (PHON(2)) skinny_gemm<0, 4, true>(F, nullptr, 0, wgu, FF / 16, ACT, FF, HM, 0.f);
            pg8::Gemm g{HB, wgu, MMAIN, 2 * FF, D}; pg8::StaticOrder S; S.init(MMAIN, 2 * FF, F.G, bid_);
            if (PHON(2)) build_rinv_table(F, S, RSQ);
            pg8::EpiSwiGLU E{ACT, FF, (const LAS float*)(F.lds + RTAB_OFF)};
            if (PHON(2)) pg8::gemm_phase<pg8::EpiSwiGLU, pg8::StaticOrder, true, true, true>(F.lds, g, S, E, F.tid);
        } else if (s == 1 || s == 6 || s == 8) {
            const bool isout = (s == 6);
            const bf16* wd = (const bf16*)(wl + (s == 1 ? WL_D1 : (s == 6 ? WL_OUT : WL_D2)));
            if (PHON(3)) { if (isout) skinny_gemm<1, 4, false>(F, YB + (size_t)METAROW * D, D, wd, D / 16, nullptr, 0, HM, 1.0f); else skinny_gemm<1, 11, false>(F, ACT + (size_t)METAROW * FF, FF, wd, D / 16, nullptr, 0, HM, 0.5f); }
            pg8::Gemm g{isout ? YB : ACT, wd, MMAIN, D, isout ? D : FF}; pg8::StaticOrder S; S.init(MMAIN, D, F.G, bid_);
            pg8::EpiResid E{(l == 0 && s == 1) ? F.in[0] : nullptr, HB, RSQ, isout ? 1.0f : 0.5f};
            if (PHON(3)) pg8::gemm_phase<pg8::EpiResid, pg8::StaticOrder, true, true, false>(F.lds, g, S, E, F.tid);
        } else if (s == 2) {
            if (PHON(4)) skinny_gemm<2, 4, true>(F, nullptr, 0, (const bf16*)(wl + WL_IN), INW / 16, ACT, LDP, HM, 0.f);
            pg8::Gemm g{HB, (const bf16*)(wl + WL_IN), MMAIN, LDP, D}; pg8::StaticOrder S; S.init(MMAIN, LDP, F.G, bid_);
            if (PHON(4)) build_rinv_table(F, S, RSQ);
            pg8::EpiStoreBf16 E{ACT, LDP, (const LAS float*)(F.lds + RTAB_OFF)};
            if (PHON(4)) pg8::gemm_phase<pg8::EpiStoreBf16, pg8::StaticOrder, true, true, true>(F.lds, g, S, E, F.tid);
        } else if (s == 3) {
#define M1_ATTN() do { for (int u = F.gw; u < AT_UNITS - 6; u += F.NGW) attn_unit(F, l, u); \
                const int mi = F.NGW - 1 - F.gw; if (mi < 8 && (mi & 7) < 4) attn_unit(F, l, AT_UNITS - 6 + mi); else if (mi >= 8 && mi < 16 && (mi & 7) < 2) attn_unit(F, l, AT_UNITS - 2 + (mi & 7)); } while (0)
            if (PHON(5) && F.wave < 4) M1_ATTN();
            if (PHON(6)) for (int k = F.wave; k * F.G + (F.gw / NWAVES) < HG_UNITS; k += NWAVES) hgrn_p1_unit(F, l, k * F.G + (F.gw / NWAVES));
            if (PHON(5) && F.wave >= 4) M1_ATTN();
#undef M1_ATTN
        } else if (s == 4) { if (PHON(7)) conv_phase(F, l); if (PHON(8)) hgrn_scan(F); }
        else if (s == 5) { if (PHON(9)) for (int k = F.wave; k * F.G + (F.gw / NWAVES) < HG_UNITS; k += NWAVES) hgrn_p3_unit(F, l, k * F.G + (F.gw / NWAVES)); }
        else { if (PHON(10)) final_phase(F); }
        if (pc + 1 < args.pc_hi) { if (args.pc_lo < 0) cg::this_grid().sync(); else xcd_barrier(gbar, F.tid); }
    }
}

#ifndef MK_PER_PHASE
#define MK_PER_PHASE 0
#endif
extern "C" void kernel_launch(void* const* d_in, const int* in_sizes, int n_in, void* d_out, int out_size, void* d_ws, size_t ws_size, hipStream_t stream) {
    static int grid = 0;
    if (grid == 0) {
        if (n_in != 21 || in_sizes[0] != MMAIN * D || out_size != MMAIN * D || ws_size < WS_END) { fprintf(stderr, "kernel_launch: unexpected shapes (n_in %d, in0 %d, out %d, ws %zu); nothing launched\n", n_in, n_in > 0 ? in_sizes[0] : -1, out_size, ws_size); grid = -1; return; }
        int dev = 0, cus = 0, per_cu = 0;
        if (hipGetDevice(&dev) != hipSuccess || hipDeviceGetAttribute(&cus, hipDeviceAttributeMultiprocessorCount, dev) != hipSuccess) { grid = -1; return; }
        if (hipFuncSetAttribute((const void*)fwd_kernel, hipFuncAttributeMaxDynamicSharedMemorySize, LDS_BYTES) != hipSuccess) { fprintf(stderr, "kernel_launch: hipFuncSetAttribute failed\n"); grid = -1; return; }
        if (hipOccupancyMaxActiveBlocksPerMultiprocessor(&per_cu, (const void*)fwd_kernel, NTHREADS, LDS_BYTES) != hipSuccess || per_cu < 1) { fprintf(stderr, "kernel_launch: occupancy query says %d\n", per_cu); per_cu = 1; }
        (void)hipGetLastError();
        grid = cus;
    }
    if (grid < 0) return;
    if (hipMemsetAsync((char*)d_ws + WS_CTL, 0, 16384, stream) != hipSuccess) { fprintf(stderr, "kernel_launch: hipMemsetAsync failed\n"); return; }
    Args a{};
    for (int i = 0; i < 21; ++i) a.in[i] = (const float*)d_in[i];
    a.out = (float*)d_out; a.ws = (unsigned char*)d_ws;
#if MK_PER_PHASE
    for (int pc = 0; pc < N_PC; ++pc) { a.pc_lo = pc; a.pc_hi = pc + 1; hipLaunchKernelGGL(fwd_kernel, dim3(grid), dim3(NTHREADS), LDS_BYTES, stream, a); }
#else
    a.pc_lo = 0; a.pc_hi = N_PC;
    void* kargs[] = {&a};
    hipError_t e = hipLaunchCooperativeKernel((const void*)fwd_kernel, dim3(grid), dim3(NTHREADS), kargs, LDS_BYTES, stream);
    if (e != hipSuccess) fprintf(stderr, "kernel_launch: cooperative launch failed: %s (grid %d)\n", hipGetErrorString(e), grid);
#endif
}
```

```cpp
#include <hip/hip_runtime.h>
#include <hip/hip_cooperative_groups.h>
#include <cstdio>
#include <cstdint>
namespace cg = cooperative_groups;

namespace pg8 {
#define PG8_LAS __attribute__((address_space(3)))
typedef unsigned short bf16_t;
typedef short bf16x8 __attribute__((ext_vector_type(8)));
typedef float f32x4 __attribute__((ext_vector_type(4)));
typedef unsigned u32x4 __attribute__((ext_vector_type(4)));
constexpr int BM = 256, BK = 64, HALF = 128, HTB = HALF * BK * 2  , STAGE_BYTES = 8 * HTB, NXCD = 8, WGM = 8;

__host__ __device__ __forceinline__ int lds_byte(int r, int c) { const int st = (r >> 4) * 2 + (c >> 5), rr = r & 15, cc = c & 31, ob = rr * 64 + cc * 2; return st * 1024 + (ob ^ (((ob >> 9) & 1) << 5)); }
__host__ __device__ __forceinline__ void stage_rc(int b, int& R, int& C) { const int st = b / 1024, sb = b % 1024, swz = sb ^ (((sb >> 9) & 1) << 5); R = (st >> 1) * 16 + swz / 64; C = (st & 1) * 32 + (swz % 64) / 2; }
__host__ __device__ __forceinline__ int perm32(int rho) { const int n = rho >> 4, i = rho & 15; return 8 * (i >> 2) + 4 * n + (i & 3); }

struct Unit { int pm, pn, idx; };
struct Gemm { const bf16_t* A; const bf16_t* Bt; int M, N, K; };

struct StaticOrder {
    int nM, nN, nwg, G, c;
    __host__ __device__ void init(int M, int N, int G_, int c_) { nM = M / BM; nN = N / BM; nwg = nM * nN; G = G_; c = c_; }
    __host__ __device__ bool next(int i, Unit& u) const {
        const long L = (long)i * G + c; if (L >= nwg) return false;
        int wgid = (int)L; { const int q = nwg / NXCD, r = nwg % NXCD, xcd = wgid % NXCD, off = wgid / NXCD; wgid = (xcd < r ? xcd * (q + 1) : r * (q + 1) + (xcd - r) * q) + off; }
        const int nig = WGM * nN, gid = wgid / nig, fm = gid * WGM, gsz = (nM - fm) < WGM ? (nM - fm) : WGM;
        u.pm = fm + ((wgid % nig) % gsz); u.pn = (wgid % nig) / gsz; u.idx = i; return true;
    }
    __device__ __forceinline__ void a_ready(const Unit&) const {}
    __device__ __forceinline__ void done(const Unit&) const {}
};

__device__ __forceinline__ unsigned cvt_pk_bf16(float lo, float hi) { unsigned r; asm volatile("v_cvt_pk_bf16_f32 %0, %1, %2" : "=v"(r) : "v"(lo), "v"(hi)); return r; }
typedef float f32x2 __attribute__((ext_vector_type(2)));
typedef __bf16 bf16x2_t __attribute__((ext_vector_type(2)));
typedef unsigned u32x2 __attribute__((ext_vector_type(2)));
typedef _Float16 f16x8 __attribute__((ext_vector_type(8)));
typedef _Float16 f16x4 __attribute__((ext_vector_type(4)));
typedef _Float16 f16x2 __attribute__((ext_vector_type(2)));
__device__ __forceinline__ unsigned pk_f16(float lo, float hi) { f32x2 v = {lo, hi}; f16x2 h = __builtin_convertvector(v, f16x2); return __builtin_bit_cast(unsigned, h); }
__device__ __forceinline__ unsigned pk_bf16(float lo, float hi) { f32x2 v = {lo, hi}; bf16x2_t b = __builtin_convertvector(v, bf16x2_t); return __builtin_bit_cast(unsigned, b); }
__device__ __forceinline__ float silu_f(float x) { return x * __builtin_amdgcn_rcpf(1.0f + __expf(-x)); }

__device__ __forceinline__ float shx_(float v, int o, int lane) { return __builtin_bit_cast(float, __builtin_amdgcn_ds_bpermute((lane ^ o) << 2, __builtin_bit_cast(int, v))); }
#define PG8_ROW_RINV(rinv, tab, u, wr, fr) do { _Pragma("unroll") for (int ai = 0; ai < 2; ++ai) _Pragma("unroll") for (int m = 0; m < 4; ++m) rinv[ai][m] = (tab)[(u).idx * 256 + ai * HALF + (wr) * 64 + m * 16 + (fr)]; } while (0)
struct EpiSwiGLU {
    static constexpr bool PERM = true, AFTER_DRAIN = false;
    bf16_t* O; int ldo; const PG8_LAS float* tab;
    __device__ __forceinline__ void operator()(const f32x4 (&acc)[2][2][4][2], const Unit& u, int wr, int wc, int fr, int fq) const {
        const int row0 = u.pm * BM + wr * 64 + fr; const int col0 = u.pn * 128 + wc * 32 + 8 * fq;
        float rinv[2][4]; PG8_ROW_RINV(rinv, tab, u, wr, fr);
#pragma unroll
        for (int ai = 0; ai < 2; ++ai)
#pragma unroll
            for (int m = 0; m < 4; ++m) { const float ri = rinv[ai][m];
                float g[8], up[8], e[8];
#pragma unroll
                for (int i = 0; i < 4; ++i) { g[i] = acc[ai][0][m][0][i] * ri; g[4 + i] = acc[ai][0][m][1][i] * ri; up[i] = acc[ai][1][m][0][i] * ri; up[4 + i] = acc[ai][1][m][1][i] * ri; }
#pragma unroll
                for (int i = 0; i < 8; ++i) e[i] = __builtin_amdgcn_exp2f(g[i] * -1.4426950408889634f);
#pragma unroll
                for (int i = 0; i < 8; ++i) e[i] = __builtin_amdgcn_rcpf(1.0f + e[i]);
#pragma unroll
                for (int i = 0; i < 8; ++i) g[i] = (g[i] * up[i]) * e[i];
                u32x4 w; w.x = pk_bf16(g[0], g[1]); w.y = pk_bf16(g[2], g[3]); w.z = pk_bf16(g[4], g[5]); w.w = pk_bf16(g[6], g[7]);
                *(u32x4*)(O + (size_t)(row0 + ai * HALF + m * 16) * ldo + col0) = w; }
    }
};
struct EpiStoreBf16 {
    static constexpr bool PERM = true, AFTER_DRAIN = false;
    bf16_t* O; int ldo; const PG8_LAS float* tab;
    __device__ __forceinline__ void operator()(const f32x4 (&acc)[2][2][4][2], const Unit& u, int wr, int wc, int fr, int fq) const {
        const int row0 = u.pm * BM + wr * 64 + fr; const int col0 = u.pn * BM + wc * 32 + 8 * fq;
        float rinv[2][4]; PG8_ROW_RINV(rinv, tab, u, wr, fr);
#pragma unroll
        for (int ai = 0; ai < 2; ++ai)
#pragma unroll
            for (int m = 0; m < 4; ++m) { bf16_t* rowp = O + (size_t)(row0 + ai * HALF + m * 16) * ldo + col0;
#pragma unroll
                for (int bj = 0; bj < 2; ++bj) { const f32x4 v0 = acc[ai][bj][m][0] * rinv[ai][m], v1 = acc[ai][bj][m][1] * rinv[ai][m];
                    u32x4 w; w.x = pk_bf16(v0[0], v0[1]); w.y = pk_bf16(v0[2], v0[3]); w.z = pk_bf16(v1[0], v1[1]); w.w = pk_bf16(v1[2], v1[3]);
                    *(u32x4*)(rowp + bj * HALF) = w; } }
    }
};
struct EpiResid {
    static constexpr bool PERM = true, AFTER_DRAIN = false;
    const float* in32; unsigned short* hb; float* rowsq; float scale;
    __device__ __forceinline__ void operator()(const f32x4 (&acc)[2][2][4][2], const Unit& u, int wr, int wc, int fr, int fq) const {
        const int lane = fq * 16 + fr;
        const int row0 = u.pm * BM + wr * 64 + fr; const int col0 = u.pn * BM + wc * 32 + 8 * fq;
        if (in32) {
#pragma unroll
            for (int ai = 0; ai < 2; ++ai)
#pragma unroll
              for (int mp = 0; mp < 2; ++mp) { f32x4 b0[2][2], b1[2][2];
#pragma unroll
                for (int mm = 0; mm < 2; ++mm)
#pragma unroll
                    for (int bj = 0; bj < 2; ++bj) { const float* ip = in32 + (size_t)(row0 + ai * HALF + (2 * mp + mm) * 16) * 1024 + col0 + bj * HALF; b0[mm][bj] = *(const f32x4*)ip; b1[mm][bj] = *(const f32x4*)(ip + 4); }
#pragma unroll
                for (int mm = 0; mm < 2; ++mm) { const int m = 2 * mp + mm; const int row = row0 + ai * HALF + m * 16; const size_t off = (size_t)row * 1024 + col0; float ss = 0.f;
#pragma unroll
                    for (int bj = 0; bj < 2; ++bj) { const f32x4 o0 = b0[mm][bj] + acc[ai][bj][m][0] * scale, o1 = b1[mm][bj] + acc[ai][bj][m][1] * scale;
                        ss += ((o0[0] * o0[0] + o0[1] * o0[1]) + (o0[2] * o0[2] + o0[3] * o0[3])) + ((o1[0] * o1[0] + o1[1] * o1[1]) + (o1[2] * o1[2] + o1[3] * o1[3]));
                        u32x4 w; w.x = pk_f16(o0[0], o0[1]); w.y = pk_f16(o0[2], o0[3]); w.z = pk_f16(o1[0], o1[1]); w.w = pk_f16(o1[2], o1[3]);
                        *(u32x4*)(hb + off + bj * HALF) = w; }
                    ss += shx_(ss, 16, lane); ss += shx_(ss, 32, lane);
                    if (fq == 0) rowsq[(size_t)row * 16 + u.pn * 4 + wc] = ss; } }
        } else {
#pragma unroll
            for (int ai = 0; ai < 2; ++ai) { f16x8 hv[4][2];
#pragma unroll
                for (int m = 0; m < 4; ++m)
#pragma unroll
                    for (int bj = 0; bj < 2; ++bj) hv[m][bj] = *(const f16x8*)(hb + (size_t)(row0 + ai * HALF + m * 16) * 1024 + col0 + bj * HALF);
#pragma unroll
                for (int m = 0; m < 4; ++m) { const int row = row0 + ai * HALF + m * 16; const size_t off = (size_t)row * 1024 + col0; float ss = 0.f;
#pragma unroll
                    for (int bj = 0; bj < 2; ++bj) { const f16x8 h = hv[m][bj];
                        const f32x4 o0 = (f32x4){(float)h[0], (float)h[1], (float)h[2], (float)h[3]} + acc[ai][bj][m][0] * scale, o1 = (f32x4){(float)h[4], (float)h[5], (float)h[6], (float)h[7]} + acc[ai][bj][m][1] * scale;
                        ss += ((o0[0] * o0[0] + o0[1] * o0[1]) + (o0[2] * o0[2] + o0[3] * o0[3])) + ((o1[0] * o1[0] + o1[1] * o1[1]) + (o1[2] * o1[2] + o1[3] * o1[3]));
                        u32x4 w; w.x = pk_f16(o0[0], o0[1]); w.y = pk_f16(o0[2], o0[3]); w.z = pk_f16(o1[0], o1[1]); w.w = pk_f16(o1[2], o1[3]);
                        *(u32x4*)(hb + off + bj * HALF) = w; }
                    ss += shx_(ss, 16, lane); ss += shx_(ss, 32, lane);
                    if (fq == 0) rowsq[(size_t)row * 16 + u.pn * 4 + wc] = ss; } }
        }
    }
};

template <class Epi, class Sched, bool ALIGN_EPI = false, bool SP2 = false, bool F16 = false>
__device__ __forceinline__ void gemm_phase(PG8_LAS unsigned char* lds, const Gemm g, const Sched& S, const Epi& E, int tid_in) {
    int tid_l = tid_in; asm volatile("" : "+v"(tid_l));
    const int tid = tid_l, wid = __builtin_amdgcn_readfirstlane(tid >> 6), lane = tid & 63, wr = wid >> 2, wc = wid & 3, fr = lane & 15, fq = lane >> 4;
    const int K = g.K, nt = K / BK;
    unsigned voffA[2], voffB[2];
#pragma unroll
    for (int i = 0; i < 2; ++i) { int R, C; stage_rc(tid * 16 + i * 8192, R, C); const int Rb = Epi::PERM ? ((R & ~31) + perm32(R & 31)) : R;
        voffA[i] = (unsigned)(R * K + C) * 2u; voffB[i] = (unsigned)(Rb * K + C) * 2u; }
    const size_t kstep = (size_t)(BK * 2);
    const size_t hstep = (size_t)HALF * K * 2;
    const size_t tstep = 2 * hstep;
    const unsigned ldsw = (unsigned)wid * 1024u;
    const int aoff = lds_byte(wr * 64 + fr, fq * 8), boff = lds_byte(wc * 32 + fr, fq * 8);
#define PG8_SA(b, h) (((b) * 2 + (h)) * HTB)
#define PG8_SB(b, h) ((4 + (b) * 2 + (h)) * HTB)
#define PG8_STAGE(bufoff, gbase, voff) do { _Pragma("unroll") for (int _i = 0; _i < 2; ++_i) \
        __builtin_amdgcn_global_load_lds((const unsigned*)((const char*)(gbase) + (voff)[_i]), (PG8_LAS unsigned*)(lds + (bufoff) + ldsw + _i * 8192), 16, 0, 0); } while (0)
#define PG8_LDA(dst, b, h) do { _Pragma("unroll") for (int m = 0; m < 4; ++m) _Pragma("unroll") for (int k = 0; k < 2; ++k) dst[m][k] = *(const PG8_LAS bf16x8*)(lds + PG8_SA(b, h) + aoff + m * 2048 + k * 1024); } while (0)
#define PG8_LDB(dst, b, h) do { _Pragma("unroll") for (int n = 0; n < 2; ++n) _Pragma("unroll") for (int k = 0; k < 2; ++k) dst[n][k] = *(const PG8_LAS bf16x8*)(lds + PG8_SB(b, h) + boff + n * 2048 + k * 1024); } while (0)
#define PG8_MMA(ai, bj, At, Bt) do { __builtin_amdgcn_s_setprio(1); _Pragma("unroll") for (int m = 0; m < 4; ++m) _Pragma("unroll") for (int n = 0; n < 2; ++n) _Pragma("unroll") for (int k = 0; k < 2; ++k) \
        acc[ai][bj][m][n] = F16 ? __builtin_amdgcn_mfma_f32_16x16x32_f16(__builtin_bit_cast(f16x8, Bt[n][k]), __builtin_bit_cast(f16x8, At[m][k]), acc[ai][bj][m][n], 0, 0, 0) \
                                : __builtin_amdgcn_mfma_f32_16x16x32_bf16(Bt[n][k], At[m][k], acc[ai][bj][m][n], 0, 0, 0); __builtin_amdgcn_s_setprio(0); } while (0)
#define PG8_WAIT_V(n) asm volatile("s_waitcnt vmcnt(" #n ")" ::: "memory")
#define PG8_WAIT_L(n) asm volatile("s_waitcnt lgkmcnt(" #n ")" ::: "memory")
#define PG8_BAR __builtin_amdgcn_s_barrier()
#define PG8_SCHED __builtin_amdgcn_sched_barrier(0)
    Unit cur, nxt; int ui = 0;
    if (!S.next(0, cur)) return;
    f32x4 acc[2][2][4][2];
#pragma unroll
    for (int a = 0; a < 2; ++a)
#pragma unroll
        for (int b = 0; b < 2; ++b)
#pragma unroll
            for (int m = 0; m < 4; ++m)
#pragma unroll
                for (int n = 0; n < 2; ++n) acc[a][b][m][n] = (f32x4){0.f, 0.f, 0.f, 0.f};
    bf16x8 At[4][2], B0[2][2], B1[2][2];
    const char* cA = (const char*)g.A + (size_t)cur.pm * tstep; const char* cB = (const char*)g.Bt + (size_t)cur.pn * tstep;
    S.a_ready(cur);
    if constexpr (SP2) {
        PG8_STAGE(PG8_SB(0, 0), cB, voffB); PG8_STAGE(PG8_SB(0, 1), cB + hstep, voffB); PG8_STAGE(PG8_SA(0, 0), cA, voffA); PG8_STAGE(PG8_SA(0, 1), cA + hstep, voffA);
        if (wr == 1) PG8_BAR;
        PG8_WAIT_V(2); PG8_BAR;
        PG8_STAGE(PG8_SB(1, 0), cB + kstep, voffB); PG8_STAGE(PG8_SA(1, 0), cA + kstep, voffA); PG8_STAGE(PG8_SB(1, 1), cB + hstep + kstep, voffB);
        PG8_WAIT_V(6); PG8_BAR;
    } else {
        PG8_STAGE(PG8_SB(0, 0), cB, voffB); PG8_STAGE(PG8_SA(0, 0), cA, voffA); PG8_STAGE(PG8_SB(0, 1), cB + hstep, voffB); PG8_STAGE(PG8_SA(0, 1), cA + hstep, voffA);
        if (wr == 1) PG8_BAR;
        PG8_WAIT_V(4); PG8_BAR;
        PG8_STAGE(PG8_SB(1, 0), cB + kstep, voffB); PG8_STAGE(PG8_SA(1, 0), cA + kstep, voffA); PG8_STAGE(PG8_SB(1, 1), cB + hstep + kstep, voffB);
        PG8_WAIT_V(6); PG8_BAR;
    }
    for (;;) {
        const bool has_next = S.next(ui + 1, nxt);
        const char* nA = has_next ? (const char*)g.A + (size_t)nxt.pm * tstep : cA; const char* nB = has_next ? (const char*)g.Bt + (size_t)nxt.pn * tstep : cB;
        for (int t = 0; t < nt; t += 2) {
            const bool last = (t == nt - 2);
            const char* a1 = cA + (size_t)(t + 1) * kstep;
            const char* a2 = last ? nA : cA + (size_t)(t + 2) * kstep; const char* b2 = last ? nB : cB + (size_t)(t + 2) * kstep;
            const char* a3 = a2 + kstep; const char* b3 = b2 + kstep;
            if (last && has_next) S.a_ready(nxt);
            if constexpr (SP2) {
            PG8_LDB(B0, 0, 0); PG8_LDB(B1, 0, 1); PG8_SCHED; PG8_LDA(At, 0, 0); PG8_STAGE(PG8_SA(1, 1), a1 + hstep, voffA);
            PG8_WAIT_V(8); PG8_WAIT_L(0); PG8_BAR; PG8_MMA(0, 0, At, B0); PG8_MMA(0, 1, At, B1); PG8_BAR; PG8_SCHED;
            PG8_LDA(At, 0, 1); PG8_STAGE(PG8_SB(0, 0), b2, voffB); PG8_STAGE(PG8_SB(0, 1), b2 + hstep, voffB); PG8_STAGE(PG8_SA(0, 0), a2, voffA);
            PG8_WAIT_V(8); PG8_WAIT_L(0); PG8_BAR; PG8_MMA(1, 0, At, B0); PG8_MMA(1, 1, At, B1); PG8_BAR; PG8_SCHED;
            PG8_LDB(B0, 1, 0); PG8_LDB(B1, 1, 1); PG8_SCHED; PG8_LDA(At, 1, 0); PG8_STAGE(PG8_SA(0, 1), a2 + hstep, voffA);
            PG8_WAIT_V(8); PG8_WAIT_L(0); PG8_BAR; PG8_MMA(0, 0, At, B0); PG8_MMA(0, 1, At, B1); PG8_BAR; PG8_SCHED;
            PG8_LDA(At, 1, 1); PG8_STAGE(PG8_SB(1, 0), b3, voffB); PG8_STAGE(PG8_SB(1, 1), b3 + hstep, voffB); PG8_STAGE(PG8_SA(1, 0), a3, voffA);
            PG8_WAIT_V(8); PG8_WAIT_L(0); PG8_BAR; PG8_MMA(1, 0, At, B0); PG8_MMA(1, 1, At, B1); PG8_BAR; PG8_SCHED;
            } else {
            PG8_LDB(B0, 0, 0); PG8_SCHED; PG8_LDA(At, 0, 0); PG8_STAGE(PG8_SA(1, 1), a1 + hstep, voffA);
            PG8_WAIT_L(8); PG8_BAR; PG8_WAIT_L(0); PG8_MMA(0, 0, At, B0); PG8_BAR; PG8_SCHED;
            PG8_LDB(B1, 0, 1); PG8_STAGE(PG8_SB(0, 0), b2, voffB);
            PG8_BAR; PG8_WAIT_L(0); PG8_MMA(0, 1, At, B1); PG8_BAR;
            PG8_LDA(At, 0, 1); PG8_STAGE(PG8_SA(0, 0), a2, voffA);
            PG8_BAR; PG8_WAIT_L(0); PG8_MMA(1, 0, At, B0); PG8_BAR; PG8_SCHED;
            PG8_STAGE(PG8_SB(0, 1), b2 + hstep, voffB);
            PG8_WAIT_V(6); PG8_BAR; PG8_MMA(1, 1, At, B1); PG8_BAR;
            PG8_LDB(B0, 1, 0); PG8_SCHED; PG8_LDA(At, 1, 0); PG8_STAGE(PG8_SA(0, 1), a2 + hstep, voffA);
            PG8_WAIT_L(8); PG8_BAR; PG8_WAIT_L(0); PG8_MMA(0, 0, At, B0); PG8_BAR; PG8_SCHED;
            PG8_LDB(B1, 1, 1); PG8_STAGE(PG8_SB(1, 0), b3, voffB);
            PG8_BAR; PG8_WAIT_L(0); PG8_MMA(0, 1, At, B1); PG8_BAR;
            PG8_LDA(At, 1, 1); PG8_STAGE(PG8_SA(1, 0), a3, voffA);
            PG8_BAR; PG8_WAIT_L(0); PG8_MMA(1, 0, At, B0); PG8_BAR; PG8_SCHED;
            PG8_STAGE(PG8_SB(1, 1), b3 + hstep, voffB);
            PG8_WAIT_V(6); PG8_BAR; PG8_MMA(1, 1, At, B1); PG8_BAR;
            }
        }
        if constexpr (ALIGN_EPI) { if (wr == 0) PG8_BAR; }
        if constexpr (!Epi::AFTER_DRAIN) { E(acc, cur, wr, wc, fr, fq); S.done(cur); }
        if (!has_next) break;
#pragma unroll
        for (int a = 0; a < 2; ++a)
#pragma unroll
            for (int b = 0; b < 2; ++b)
#pragma unroll
                for (int m = 0; m < 4; ++m)
#pragma unroll
                    for (int n = 0; n < 2; ++n) acc[a][b][m][n] = (f32x4){0.f, 0.f, 0.f, 0.f};
        cur = nxt; cA = nA; cB = nB; ++ui;
        if constexpr (ALIGN_EPI) { if (wr == 1) PG8_BAR; }
    }
    PG8_WAIT_V(0);
    if constexpr (!ALIGN_EPI) { if (wr == 0) PG8_BAR; }
    PG8_BAR;
    if constexpr (Epi::AFTER_DRAIN) { E.fused(acc, cur, wr, wc, fr, fq, lds, wid, lane); S.done(cur); }
#undef PG8_SA
#undef PG8_SB
#undef PG8_STAGE
#undef PG8_LDA
#undef PG8_LDB
#undef PG8_MMA
#undef PG8_WAIT_V
#undef PG8_WAIT_L
#undef PG8_BAR
#undef PG8_SCHED
}
}

#define LAS __attribute__((address_space(3)))
typedef unsigned short bf16;
typedef unsigned v4u __attribute__((ext_vector_type(4)));
typedef unsigned v2u __attribute__((ext_vector_type(2)));
typedef float f32x4 __attribute__((ext_vector_type(4)));
typedef short bf16x8 __attribute__((ext_vector_type(8)));

constexpr int NWAVES = 8, NTHREADS = 512;
constexpr int D = 1024, FF = 2816, NB = 8, SEQ = 4096, NMETA = 16, DEPTH = 4;
constexpr int MMAIN = NB * SEQ;
constexpr int METAROW = MMAIN;
constexpr int MR = MMAIN + 256;
constexpr int INW = 2688, LDP = 2816;
constexpr int P_AQ = 0, P_AF = 384, P_AI = 768, P_AG = 1152, P_BQ = 1536, P_BK = 1920, P_BV = 2048, P_CU = 2176;
constexpr float EPS = 1e-6f;
constexpr int HG_NC = 65;
constexpr int HG_UNITS = NB * 6 * HG_NC;
constexpr int AT_UNITS = NB * 6 * 128 + 6;
constexpr int CV_UNITS = NB * 128 + 1;

constexpr size_t MiB = 1u << 20;
constexpr size_t WS_CTL = 0, CTL_ZERO_BYTES = 1 * MiB;
constexpr size_t WS_HM = 1 * MiB;
constexpr size_t WS_W = 2 * MiB;
constexpr size_t WL_GU1 = 0, WL_D1 = 11 * MiB, WL_IN = WL_D1 + 5632 * 1024, WL_OUT = 22 * MiB, WL_GU2 = 24 * MiB, WL_D2 = 35 * MiB, WL_STRIDE = 40 * MiB + 512 * 1024;
constexpr size_t WS_XN = 164 * MiB;
constexpr size_t WS_ACT = 229 * MiB;
constexpr size_t WS_DS = 407 * MiB;
constexpr size_t WS_ST = 456 * MiB;
constexpr size_t WS_DEC = 481 * MiB;
constexpr size_t WS_RSQ = 482 * MiB;
constexpr size_t WS_END = 484 * MiB;
static_assert(WS_W + 4 * WL_STRIDE <= WS_XN && WS_XN + (size_t)MR * D * 2 <= WS_ACT && WS_ACT + (size_t)MR * LDP * 2 <= WS_DS && WS_DS + (size_t)HG_UNITS * 4096 * 4 <= WS_ST && WS_ST + (size_t)HG_UNITS * 4096 * 2 <= WS_DEC && WS_DEC + (size_t)HG_UNITS * 64 * 4 <= WS_RSQ && WS_RSQ + (size_t)MMAIN * 64 <= WS_END, "ws map");
static_assert(WL_IN + (size_t)LDP * 1024 * 2 <= WL_OUT && WL_D2 + (size_t)1024 * FF * 2 <= WL_STRIDE, "weight map");

constexpr int TLD = 72;
constexpr int TILE_BYTES = 64 * TLD * 2;
constexpr int WAVE_LDS = 2 * TILE_BYTES + 512;
constexpr int LDS_BYTES = 155648;
constexpr int BAR_LDS_OFF = LDS_BYTES - 16;
static_assert(NWAVES * WAVE_LDS <= BAR_LDS_OFF && pg8::STAGE_BYTES <= BAR_LDS_OFF, "LDS map");

#define LDS_WAIT() asm volatile("s_waitcnt lgkmcnt(0)" ::: "memory")
__device__ __forceinline__ unsigned f2bf(float f) { unsigned u = __builtin_bit_cast(unsigned, f); return (u + 0x7fffu + ((u >> 16) & 1u)) >> 16; }
__device__ __forceinline__ unsigned pk2(float lo, float hi) { return f2bf(lo) | (f2bf(hi) << 16); }
__device__ __forceinline__ float bf2f(unsigned u) { return __builtin_bit_cast(float, u << 16); }
__device__ __forceinline__ float sigm(float z) { return __builtin_amdgcn_rcpf(1.0f + __expf(-z)); }
__device__ __forceinline__ unsigned bf1(float x) { return pg8::pk_bf16(x, 0.f) & 0xffffu; }
constexpr float L2E = 1.4426950408889634f;
__device__ __forceinline__ unsigned f2h(float f) { return pg8::pk_f16(f, 0.f) & 0xffffu; }
__device__ __forceinline__ unsigned pk2h(float lo, float hi) { return pg8::pk_f16(lo, hi); }
#define HG_GATE16(T, j0) float z2[16], a1[16], lf[16]; { float e_[16]; \
        _Pragma("unroll") for (int i = 0; i < 16; ++i) z2[i] = bf2f((T)[((j0) + i) * TLD + lane]) * L2E; \
        _Pragma("unroll") for (int i = 0; i < 16; ++i) e_[i] = __builtin_amdgcn_exp2f(-z2[i]); \
        _Pragma("unroll") for (int i = 0; i < 16; ++i) a1[i] = __builtin_amdgcn_logf(1.0f + e_[i]); \
        _Pragma("unroll") for (int i = 0; i < 16; ++i) lf[i] = __builtin_amdgcn_logf(1.0f + lb * e_[i]) - a1[i]; }
#define HG_GATE(zbits, z2, a1, lf2) const float z2 = bf2f(zbits) * L2E; const float E_ = __builtin_amdgcn_exp2f(-z2); const float a1 = __builtin_amdgcn_logf(1.0f + E_); \
        const float lf2 = (lb > 0.f ? __builtin_amdgcn_logf(1.0f + lb * E_) : 0.f) - a1;
__device__ __forceinline__ float shx(float v, int o, int lane) { return __builtin_bit_cast(float, __builtin_amdgcn_ds_bpermute((lane ^ o) << 2, __builtin_bit_cast(int, v))); }
__device__ __forceinline__ float wave_sum(float v, int lane) {
#pragma unroll
    for (int o = 1; o < 64; o <<= 1) v += shx(v, o, lane);
    return v;
}

struct Args { const float* in[21]; float* out; unsigned char* ws; int pc_lo, pc_hi; };
typedef const __attribute__((address_space(4))) Args* ArgsP;
struct InView { ArgsP ap; __device__ __forceinline__ const float* operator[](int i) const { return ap->in[i]; } };
struct Ctx {
    InView in; float* out; unsigned char* ws;
    LAS unsigned char* lds;
    int tid, lane, wave, G, gw, NGW;
};

__device__ __forceinline__ void transpose_item(const float* W, int K, int N, const float* gain, bf16* WT, int mode, bool f16, LAS float* scr, int item, int lane) {
    const int nblk = N / 32, kb = item / nblk, nb = item % nblk, k0 = 64 * kb, n0 = 32 * nb;
    f32x4 v[8];
#pragma unroll
    for (int i = 0; i < 8; ++i) v[i] = *(const f32x4*)(W + (size_t)(k0 + 8 * i + (lane >> 3)) * N + n0 + 4 * (lane & 7));
#pragma unroll
    for (int i = 0; i < 8; ++i) { const int kk = 8 * i + (lane >> 3); const float g = gain ? gain[k0 + kk] : 1.0f; LAS float* d = scr + kk * 33 + 4 * (lane & 7);
        d[0] = v[i][0] * g; d[1] = v[i][1] * g; d[2] = v[i][2] * g; d[3] = v[i][3] * g; }
    LDS_WAIT();
    const int c = lane & 7;
#pragma unroll
    for (int j = 0; j < 4; ++j) { const int nl = (lane >> 3) + 8 * j; const LAS float* s = scr + (8 * c) * 33 + nl; const int n = n0 + nl;
        const int dr = mode == 0 ? n : ((n >> 7) * 256 + (n & 127) + (mode == 2 ? 128 : 0));
        v4u o; if (f16) { o.x = pk2h(s[0 * 33], s[1 * 33]); o.y = pk2h(s[2 * 33], s[3 * 33]); o.z = pk2h(s[4 * 33], s[5 * 33]); o.w = pk2h(s[6 * 33], s[7 * 33]); }
        else { o.x = pk2(s[0 * 33], s[1 * 33]); o.y = pk2(s[2 * 33], s[3 * 33]); o.z = pk2(s[4 * 33], s[5 * 33]); o.w = pk2(s[6 * 33], s[7 * 33]); }
        *(v4u*)(WT + (size_t)dr * K + k0 + 8 * c) = o; }
    LDS_WAIT();
}
__device__ __forceinline__ void prologue(Ctx& F) {
    LAS float* scr = (LAS float*)(F.lds + F.wave * WAVE_LDS);
    constexpr int I_G = 16 * 88, I_D = 44 * 32, I_IN = 16 * 84, I_OUT = 16 * 32, I_LAYER = 6 * 1408 + I_IN + I_OUT;
    static_assert(I_G == 1408 && I_D == 1408, "items");
    for (int it = F.gw; it < DEPTH * I_LAYER; it += F.NGW) {
        const int l = it / I_LAYER; int r = it % I_LAYER;
        bf16* wl = (bf16*)(F.ws + WS_W + (size_t)l * WL_STRIDE);
        const size_t og = (size_t)l * D * FF, od = (size_t)l * FF * D;
        if (r < I_G) { transpose_item(F.in[3] + og, D, FF, F.in[2] + l * D, (bf16*)((unsigned char*)wl + WL_GU1), 1, true, scr, r, F.lane); continue; } r -= I_G;
        if (r < I_G) { transpose_item(F.in[4] + og, D, FF, F.in[2] + l * D, (bf16*)((unsigned char*)wl + WL_GU1), 2, true, scr, r, F.lane); continue; } r -= I_G;
        if (r < I_D) { transpose_item(F.in[5] + od, FF, D, nullptr, (bf16*)((unsigned char*)wl + WL_D1), 0, false, scr, r, F.lane); continue; } r -= I_D;
        if (r < I_IN) { transpose_item(F.in[7] + (size_t)l * D * INW, D, INW, F.in[6] + l * D, (bf16*)((unsigned char*)wl + WL_IN), 0, true, scr, r, F.lane); continue; } r -= I_IN;
        if (r < I_OUT) { transpose_item(F.in[8] + (size_t)l * D * D, D, D, nullptr, (bf16*)((unsigned char*)wl + WL_OUT), 0, false, scr, r, F.lane); continue; } r -= I_OUT;
        if (r < I_G) { transpose_item(F.in[17] + og, D, FF, F.in[16] + l * D, (bf16*)((unsigned char*)wl + WL_GU2), 1, true, scr, r, F.lane); continue; } r -= I_G;
        if (r < I_G) { transpose_item(F.in[18] + og, D, FF, F.in[16] + l * D, (bf16*)((unsigned char*)wl + WL_GU2), 2, true, scr, r, F.lane); continue; } r -= I_G;
        transpose_item(F.in[19] + od, FF, D, nullptr, (bf16*)((unsigned char*)wl + WL_D2), 0, false, scr, r, F.lane);
    }
    {
        bf16* xn = (bf16*)(F.ws + WS_XN); float* rsq = (float*)(F.ws + WS_RSQ); const float* x = F.in[0];
        for (int row = 2 * F.gw; row < MMAIN; row += 2 * F.NGW) {
            const f32x4* xr = (const f32x4*)(x + (size_t)row * D) + F.lane; f32x4 v[8]; float s0 = 0.f, s1 = 0.f;
#pragma unroll
            for (int j = 0; j < 8; ++j) v[j] = xr[64 * j];
#pragma unroll
            for (int j = 0; j < 4; ++j) { s0 += (v[j].x * v[j].x + v[j].y * v[j].y) + (v[j].z * v[j].z + v[j].w * v[j].w); s1 += (v[4 + j].x * v[4 + j].x + v[4 + j].y * v[4 + j].y) + (v[4 + j].z * v[4 + j].z + v[4 + j].w * v[4 + j].w); }
            s0 = wave_sum(s0, F.lane); s1 = wave_sum(s1, F.lane);
            v2u* o8 = (v2u*)(xn + (size_t)row * D) + F.lane;
#pragma unroll
            for (int j = 0; j < 8; ++j) { v2u w; w.x = pk2h(v[j].x, v[j].y); w.y = pk2h(v[j].z, v[j].w); o8[64 * j] = w; }
            if (F.lane < 32) rsq[(size_t)row * 16 + F.lane] = F.lane == 0 ? s0 : (F.lane == 16 ? s1 : 0.f);
        }
    }
    const int gt = F.gw * 64 + F.lane, NGT = F.NGW * 64;
    for (int i = gt; i < DEPTH * 128 * 128; i += NGT) { const int l = i / (128 * 128), e = i % (128 * 128);
        *(v4u*)(F.ws + WS_W + (size_t)l * WL_STRIDE + WL_IN + (size_t)INW * 1024 * 2 + (size_t)e * 16) = (v4u){0u, 0u, 0u, 0u}; }
    for (int i = gt; i < 256 * 256; i += NGT) { const int row = i >> 8, c4 = (i & 255) * 4;
        f32x4 v = (f32x4){0.f, 0.f, 0.f, 0.f}; if (row < NMETA) v = *(const f32x4*)(F.in[1] + row * D + c4);
        *(f32x4*)((float*)(F.ws + WS_HM) + row * D + c4) = v; }
}

__device__ __forceinline__ void norm_phase(Ctx& F, const float* main_src) {
    const float* hm = (const float*)(F.ws + WS_HM); bf16* xn = (bf16*)(F.ws + WS_XN);
    for (int row = F.gw; row < MMAIN + NMETA; row += F.NGW) {
        const float* src = row < MMAIN ? main_src + (size_t)row * D : hm + (size_t)(row - MMAIN) * D;
        const f32x4* xr = (const f32x4*)src + F.lane;
        f32x4 v[4]; float s = 0.f;
#pragma unroll
        for (int j = 0; j < 4; ++j) { v[j] = xr[64 * j]; s += (v[j].x * v[j].x + v[j].y * v[j].y) + (v[j].z * v[j].z + v[j].w * v[j].w); }
        const float rinv = rsqrtf(wave_sum(s, F.lane) * (1.f / D) + EPS);
        v2u* o8 = (v2u*)(xn + (size_t)row * D) + F.lane;
#pragma unroll
        for (int j = 0; j < 4; ++j) { v2u w; w.x = pg8::pk_bf16(v[j].x * rinv, v[j].y * rinv); w.y = pg8::pk_bf16(v[j].z * rinv, v[j].w * rinv); o8[64 * j] = w; }
    }
}
__device__ __forceinline__ void final_phase(Ctx& F) {
    const float* gn = F.in[20]; const unsigned short* hb = (const unsigned short*)(F.ws + WS_XN);
    for (int row = F.gw; row < MMAIN; row += F.NGW) {
        const pg8::f16x4* hr = (const pg8::f16x4*)(hb + (size_t)row * D) + F.lane;
        f32x4 v[4]; float s = 0.f;
#pragma unroll
        for (int j = 0; j < 4; ++j) { const pg8::f16x4 h = hr[64 * j]; v[j] = (f32x4){(float)h[0], (float)h[1], (float)h[2], (float)h[3]}; s += (v[j].x * v[j].x + v[j].y * v[j].y) + (v[j].z * v[j].z + v[j].w * v[j].w); }
        const float rinv = rsqrtf(wave_sum(s, F.lane) * (1.f / D) + EPS);
        f32x4* xr = (f32x4*)(F.out + (size_t)row * D) + F.lane;
#pragma unroll
        for (int j = 0; j < 4; ++j) { const f32x4 g = *((const f32x4*)gn + F.lane + 64 * j); xr[64 * j] = v[j] * rinv * g; }
    }
}

__device__ __forceinline__ bf16x8 lds_frag(const LAS bf16* T, int tile, int kk, int r, int q) { return *(const LAS bf16x8*)(T + (16 * tile + r) * TLD + 32 * kk + 8 * q); }
__device__ __forceinline__ void wave_mma64(const LAS bf16* X, const LAS bf16* Y, f32x4 (&acc)[4][4], int r, int q) {
#pragma unroll
    for (int kk = 0; kk < 2; ++kk) {
        bf16x8 xf[4], yf[4];
#pragma unroll
        for (int i = 0; i < 4; ++i) { xf[i] = lds_frag(X, i, kk, r, q); yf[i] = lds_frag(Y, i, kk, r, q); }
#pragma unroll
        for (int it = 0; it < 4; ++it)
#pragma unroll
            for (int jt = 0; jt < 4; ++jt) acc[it][jt] = __builtin_amdgcn_mfma_f32_16x16x32_bf16(xf[it], yf[jt], acc[it][jt], 0, 0, 0);
    }
}
#define ZERO_ACC(a) do { _Pragma("unroll") for (int _i = 0; _i < 4; ++_i) _Pragma("unroll") for (int _j = 0; _j < 4; ++_j) a[_i][_j] = (f32x4){0.f, 0.f, 0.f, 0.f}; } while (0)


template <int KIND, int KSTEPS, bool AF32>
__device__ __forceinline__ void skinny_gemm(Ctx& F, const bf16* A, int lda, const bf16* Bt, int nslab, bf16* O, int ldo, float* hm, float scale) {
    constexpr int K = KSTEPS * 32 * 8, NBT = KIND == 0 ? 2 : 1;
    const int lane = F.lane, r = lane & 15, q = lane >> 4, w = F.wave, tid = F.tid;
    LAS float* part = (LAS float*)F.lds;
    LAS float* partsq = part + 8 * NBT * 256;
    for (int slab = F.gw / NWAVES; slab < nslab; slab += F.G) {
        const int brow0 = KIND == 0 ? ((slab * 16) >> 7) * 256 + ((slab * 16) & 127) : slab * 16;
        bf16x8 af[KSTEPS], bfr[NBT][KSTEPS];
#pragma unroll
        for (int t = 0; t < NBT; ++t) { const bf16* bp = Bt + (size_t)(brow0 + 128 * t + r) * K + w * (K / 8) + 8 * q;
#pragma unroll
            for (int kk = 0; kk < KSTEPS; ++kk) bfr[t][kk] = *(const bf16x8*)(bp + 32 * kk); }
        if (AF32) { const float* ap = hm + (size_t)r * D + w * (K / 8) + 8 * q; float ssq = 0.f;
#pragma unroll
            for (int kk = 0; kk < KSTEPS; ++kk) { const f32x4 x0 = *(const f32x4*)(ap + 32 * kk), x1 = *(const f32x4*)(ap + 32 * kk + 4);
                ssq += ((x0[0] * x0[0] + x0[1] * x0[1]) + (x0[2] * x0[2] + x0[3] * x0[3])) + ((x1[0] * x1[0] + x1[1] * x1[1]) + (x1[2] * x1[2] + x1[3] * x1[3]));
                v4u pk; pk.x = pk2h(x0[0], x0[1]); pk.y = pk2h(x0[2], x0[3]); pk.z = pk2h(x1[0], x1[1]); pk.w = pk2h(x1[2], x1[3]); af[kk] = __builtin_bit_cast(bf16x8, pk); }
            ssq += shx(ssq, 16, lane); ssq += shx(ssq, 32, lane);
            if (q == 0) partsq[w * 16 + r] = ssq;
        } else { const bf16* ap = A + (size_t)r * lda + w * (K / 8) + 8 * q;
#pragma unroll
            for (int kk = 0; kk < KSTEPS; ++kk) af[kk] = *(const bf16x8*)(ap + 32 * kk); }
#pragma unroll
        for (int t = 0; t < NBT; ++t) { f32x4 acc = (f32x4){0.f, 0.f, 0.f, 0.f};
#pragma unroll
            for (int kk = 0; kk < KSTEPS; ++kk) acc = AF32 ? __builtin_amdgcn_mfma_f32_16x16x32_f16(__builtin_bit_cast(pg8::f16x8, bfr[t][kk]), __builtin_bit_cast(pg8::f16x8, af[kk]), acc, 0, 0, 0)
                                                           : __builtin_amdgcn_mfma_f32_16x16x32_bf16(bfr[t][kk], af[kk], acc, 0, 0, 0);
#pragma unroll
            for (int e = 0; e < 4; ++e) part[(w * NBT + t) * 256 + (4 * q + e) * 16 + r] = acc[e]; }
        __syncthreads();
        if (tid < 256) { const int tok = tid >> 4, n = tid & 15; float s = 0.f, s2 = 0.f, sq = 0.f;
#pragma unroll
            for (int ww = 0; ww < 8; ++ww) { s += part[(ww * NBT) * 256 + n * 16 + tok]; if (KIND == 0) s2 += part[(ww * NBT + 1) * 256 + n * 16 + tok]; if (AF32) sq += partsq[ww * 16 + tok]; }
            if (AF32) { const float rinv = rsqrtf(sq * (1.0f / D) + EPS); s *= rinv; s2 *= rinv; }
            if (KIND == 0) O[(size_t)(METAROW + tok) * ldo + slab * 16 + n] = (bf16)f2bf(pg8::silu_f(s) * s2);
            else if (KIND == 1) hm[tok * D + slab * 16 + n] += scale * s;
            else O[(size_t)(METAROW + tok) * ldo + slab * 16 + n] = (bf16)f2bf(s); }
        __syncthreads();
    }
}

constexpr int RTAB_OFF = pg8::STAGE_BYTES, RTAB_UNITS = 12;
static_assert(RTAB_OFF + RTAB_UNITS * 256 * 4 <= BAR_LDS_OFF, "rinv table");
__device__ __forceinline__ void build_rinv_table(Ctx& F, const pg8::StaticOrder& S, const float* rowsq) {
    LAS float* tab = (LAS float*)(F.lds + RTAB_OFF);
    const int rl = F.tid >> 1, h = F.tid & 1;
    f32x4 a[RTAB_UNITS], b[RTAB_UNITS]; bool ok[RTAB_UNITS];
#pragma unroll
    for (int i = 0; i < RTAB_UNITS; ++i) { pg8::Unit u; ok[i] = S.next(i, u);
        if (ok[i]) { const f32x4* rp = (const f32x4*)(rowsq + (size_t)(u.pm * 256 + rl) * 16 + h * 8); a[i] = rp[0]; b[i] = rp[1]; } }
#pragma unroll
    for (int i = 0; i < RTAB_UNITS; ++i) if (ok[i]) { float s = ((a[i][0] + a[i][1]) + (a[i][2] + a[i][3])) + ((b[i][0] + b[i][1]) + (b[i][2] + b[i][3]));
        s += shx(s, 1, F.lane);
        if (h == 0) tab[i * 256 + rl] = rsqrtf(s * (1.0f / D) + EPS); }
    __syncthreads();
}

__device__ __forceinline__ float lb_of(const float* lg, int l, int ch) {
    const float x0 = lg[ch], x1 = lg[384 + ch], x2 = lg[768 + ch], x3 = lg[1152 + ch];
    const float m = fmaxf(fmaxf(x0, x1), fmaxf(x2, x3));
    const float e0 = __expf(x0 - m), e1 = __expf(x1 - m), e2 = __expf(x2 - m), e3 = __expf(x3 - m);
    float c = 0.f; if (l >= 1) c += e1; if (l >= 2) c += e2; if (l >= 3) c += e3;
    return c / (e0 + e1 + e2 + e3);
}
__device__ __forceinline__ int hg_row(int b, int c, int j) { return c == 0 ? (j < 48 ? -1 : METAROW + j - 48) : b * SEQ + (c - 1) * 64 + j; }

#define HG_LOAD_TILE(dst, col0) do { _Pragma("unroll") for (int _i = 0; _i < 8; ++_i) { const int _row = hg_row(b, c, (lane >> 3) + 8 * _i); \
        dst[_i] = *(const v4u*)(P + (size_t)(_row >= 0 ? _row : METAROW) * LDP + (col0) + hd * 64 + 8 * (lane & 7)); if (_row < 0) dst[_i] = (v4u){0u, 0u, 0u, 0u}; } } while (0)
#define HG_STORE_TILE(T, src) do { _Pragma("unroll") for (int _i = 0; _i < 8; ++_i) *(LAS v4u*)((T) + ((lane >> 3) + 8 * _i) * TLD + 8 * (lane & 7)) = src[_i]; } while (0)
#define HG_STORE_TILE_T(T, src) do { _Pragma("unroll") for (int _i = 0; _i < 8; ++_i) { const int _t = (lane >> 3) + 8 * _i; LAS bf16* _d = (T) + (8 * (lane & 7)) * TLD + _t; \
        _d[0 * TLD] = (bf16)(src[_i].x & 0xffffu); _d[1 * TLD] = (bf16)(src[_i].x >> 16); _d[2 * TLD] = (bf16)(src[_i].y & 0xffffu); _d[3 * TLD] = (bf16)(src[_i].y >> 16); \
        _d[4 * TLD] = (bf16)(src[_i].z & 0xffffu); _d[5 * TLD] = (bf16)(src[_i].z >> 16); _d[6 * TLD] = (bf16)(src[_i].w & 0xffffu); _d[7 * TLD] = (bf16)(src[_i].w >> 16); } } while (0)

__device__ __forceinline__ void hgrn_p1_unit(Ctx& F, int l, int unit) {
    const int lane = F.lane, r = lane & 15, q = lane >> 4;
    const int bh = unit / HG_NC, c = unit % HG_NC, b = bh / 6, hd = bh % 6, ch = hd * 64 + lane;
    const bf16* P = (const bf16*)(F.ws + WS_ACT);
    LAS bf16* T0 = (LAS bf16*)(F.lds + F.wave * WAVE_LDS); LAS bf16* T1 = T0 + 64 * TLD;
    v4u zraw[8], vraw[8];
    HG_LOAD_TILE(zraw, P_AF); HG_LOAD_TILE(vraw, P_AI);
    const float lb = lb_of(F.in[9], l, ch), oml = 1.0f - lb;
    HG_STORE_TILE(T1, zraw);
    LDS_WAIT();
    const int jlo = c == 0 ? 48 : 0;
    const float lom2 = __builtin_amdgcn_logf(oml);
    float G = 0.f;
    for (int j0 = jlo; j0 < 64; j0 += 16) { HG_GATE16(T1, j0);
#pragma unroll
        for (int i = 0; i < 16; ++i) G += lf[i]; }
    const float Glast = G; G = 0.f;
    for (int j = 0; j < jlo; j += 8) *(LAS v4u*)(T0 + lane * TLD + j) = (v4u){0u, 0u, 0u, 0u};
    for (int j0 = jlo; j0 < 64; j0 += 16) { HG_GATE16(T1, j0); float kx[16];
#pragma unroll
        for (int i = 0; i < 16; ++i) { G += lf[i]; kx[i] = (lom2 - z2[i] - a1[i]) + (Glast - G); }
#pragma unroll
        for (int i = 0; i < 16; ++i) kx[i] = __builtin_amdgcn_exp2f(kx[i]);
        v4u w0, w1;
        w0.x = pg8::pk_bf16(kx[0], kx[1]); w0.y = pg8::pk_bf16(kx[2], kx[3]); w0.z = pg8::pk_bf16(kx[4], kx[5]); w0.w = pg8::pk_bf16(kx[6], kx[7]);
        w1.x = pg8::pk_bf16(kx[8], kx[9]); w1.y = pg8::pk_bf16(kx[10], kx[11]); w1.z = pg8::pk_bf16(kx[12], kx[13]); w1.w = pg8::pk_bf16(kx[14], kx[15]);
        *(LAS v4u*)(T0 + lane * TLD + j0) = w0; *(LAS v4u*)(T0 + lane * TLD + j0 + 8) = w1; }
    ((float*)(F.ws + WS_DEC))[(size_t)unit * 64 + lane] = __builtin_amdgcn_exp2f(Glast);
    LDS_WAIT();
    HG_STORE_TILE_T(T1, vraw);
    LDS_WAIT();
    f32x4 acc[4][4]; ZERO_ACC(acc);
    wave_mma64(T1, T0, acc, r, q);
    float* ds = (float*)(F.ws + WS_DS) + (size_t)unit * 4096;
#pragma unroll
    for (int it = 0; it < 4; ++it)
#pragma unroll
        for (int jt = 0; jt < 4; ++jt)
#pragma unroll
            for (int e = 0; e < 4; ++e) ds[(16 * it + 4 * q + e) * 64 + 16 * jt + r] = acc[it][jt][e];
    LDS_WAIT();
}
__device__ __forceinline__ void hgrn_scan(Ctx& F) {
    typedef float f32x2v __attribute__((ext_vector_type(2)));
    const float* __restrict__ ds = (const float*)(F.ws + WS_DS); const float* __restrict__ dec = (const float*)(F.ws + WS_DEC); bf16* __restrict__ st = (bf16*)(F.ws + WS_ST);
    const int gt = F.gw * 64 + F.lane, NGT = F.NGW * 64;
    for (int idx = gt; idx < NB * 6 * 2048; idx += NGT) {
        const int bh = idx >> 11, e = (idx & 2047) * 2, dk = e & 63; float r0 = 0.f, r1 = 0.f;
        const size_t u0 = (size_t)bh * HG_NC;
#pragma unroll
        for (int c0 = 0; c0 < HG_NC; c0 += 33) {
            f32x2v d[33], x[33];
#pragma unroll
            for (int j = 0; j < 33; ++j) if (c0 + j < HG_NC) { d[j] = *(const f32x2v*)(dec + (u0 + c0 + j) * 64 + dk); x[j] = *(const f32x2v*)(ds + (u0 + c0 + j) * 4096 + e); }
#pragma unroll
            for (int j = 0; j < 33; ++j) if (c0 + j < HG_NC) { *(unsigned*)(st + (u0 + c0 + j) * 4096 + e) = pk2(r0, r1); r0 = r0 * d[j].x + x[j].x; r1 = r1 * d[j].y + x[j].y; }
        }
    }
}
__device__ __forceinline__ void hgrn_p3_unit(Ctx& F, int l, int unit) {
    const int lane = F.lane, r = lane & 15, q = lane >> 4;
    const int bh = unit / HG_NC, c = unit % HG_NC, b = bh / 6, hd = bh % 6, ch = hd * 64 + lane;
    if (c == 0 && b > 0) return;
    const bf16* P = (const bf16*)(F.ws + WS_ACT); bf16* Y = (bf16*)F.out;
    LAS bf16* T0 = (LAS bf16*)(F.lds + F.wave * WAVE_LDS); LAS bf16* T1 = T0 + 64 * TLD; LAS float* EG = (LAS float*)(T1 + 64 * TLD);
    {
        v4u zraw[8], qraw[8];
        HG_LOAD_TILE(zraw, P_AF); HG_LOAD_TILE(qraw, P_AQ);
        HG_STORE_TILE(T1, zraw); HG_STORE_TILE(T0, qraw);
    }
    const float lb = lb_of(F.in[9], l, ch), oml = 1.0f - lb;
    LDS_WAIT();
    const int jlo = c == 0 ? 48 : 0;
    const float lom2 = __builtin_amdgcn_logf(oml);
    float G = 0.f;
    for (int j0 = jlo; j0 < 32; j0 += 16) { HG_GATE16(T1, j0);
#pragma unroll
        for (int i = 0; i < 16; ++i) G += lf[i]; }
    const float Gm = G; G = 0.f;
    for (int j0 = jlo; j0 < 64; j0 += 16) { HG_GATE16(T1, j0); float qx[16], kx[16], qv[16];
#pragma unroll
        for (int i = 0; i < 16; ++i) qv[i] = bf2f(T0[(j0 + i) * TLD + lane]);
#pragma unroll
        for (int i = 0; i < 16; ++i) { G += lf[i]; qx[i] = G - Gm; kx[i] = (lom2 - z2[i] - a1[i]) + (Gm - G); }
#pragma unroll
        for (int i = 0; i < 16; ++i) { qx[i] = __builtin_amdgcn_exp2f(qx[i]); kx[i] = __builtin_amdgcn_exp2f(kx[i]); }
#pragma unroll
        for (int i = 0; i < 16; ++i) { T0[(j0 + i) * TLD + lane] = (bf16)bf1(qv[i] * qx[i]); T1[(j0 + i) * TLD + lane] = (bf16)bf1(kx[i]); } }
    EG[lane] = __builtin_amdgcn_exp2f(Gm);
    LDS_WAIT();
    f32x4 accA[4][4], accO[4][4]; ZERO_ACC(accA); ZERO_ACC(accO);
    wave_mma64(T1, T0, accA, r, q);
    {
        const bf16* st = (const bf16*)(F.ws + WS_ST) + (size_t)unit * 4096;
#pragma unroll
        for (int kk = 0; kk < 2; ++kk) {
            bf16x8 yf[4]; float eg[8]; v4u raw[4];
#pragma unroll
            for (int it = 0; it < 4; ++it) raw[it] = *(const v4u*)(st + (16 * it + r) * 64 + 32 * kk + 8 * q);
#pragma unroll
            for (int i = 0; i < 4; ++i) yf[i] = lds_frag(T0, i, kk, r, q);
#pragma unroll
            for (int j = 0; j < 8; ++j) eg[j] = EG[32 * kk + 8 * q + j];
#pragma unroll
            for (int it = 0; it < 4; ++it) {
                v4u sc;
                sc.x = pk2(bf2f(raw[it].x & 0xffffu) * eg[0], bf2f(raw[it].x >> 16) * eg[1]); sc.y = pk2(bf2f(raw[it].y & 0xffffu) * eg[2], bf2f(raw[it].y >> 16) * eg[3]);
                sc.z = pk2(bf2f(raw[it].z & 0xffffu) * eg[4], bf2f(raw[it].z >> 16) * eg[5]); sc.w = pk2(bf2f(raw[it].w & 0xffffu) * eg[6], bf2f(raw[it].w >> 16) * eg[7]);
                const bf16x8 xf = __builtin_bit_cast(bf16x8, sc);
#pragma unroll
                for (int jt = 0; jt < 4; ++jt) accO[it][jt] = __builtin_amdgcn_mfma_f32_16x16x32_bf16(xf, yf[jt], accO[it][jt], 0, 0, 0);
            }
        }
    }
    v4u vraw[8];
    HG_LOAD_TILE(vraw, P_AI);
    LDS_WAIT();
#pragma unroll
    for (int it = 0; it < 4; ++it)
#pragma unroll
        for (int jt = 0; jt < 4; ++jt) { const int t = 16 * jt + r, s0 = 16 * it + 4 * q; const f32x4 a = accA[it][jt];
            v2u w; w.x = pk2(s0 + 0 <= t ? a[0] : 0.f, s0 + 1 <= t ? a[1] : 0.f); w.y = pk2(s0 + 2 <= t ? a[2] : 0.f, s0 + 3 <= t ? a[3] : 0.f);
            *(LAS v2u*)(T0 + t * TLD + s0) = w; }
    HG_STORE_TILE_T(T1, vraw);
    LDS_WAIT();
    wave_mma64(T1, T0, accO, r, q);
    const float* og = F.in[10] + l * 64;
    v2u graw[4][4]; f32x4 gn[4];
#pragma unroll
    for (int it = 0; it < 4; ++it) gn[it] = *(const f32x4*)(og + 16 * it + 4 * q);
#pragma unroll
    for (int jt = 0; jt < 4; ++jt) { const int row = hg_row(b, c, 16 * jt + r);
#pragma unroll
        for (int it = 0; it < 4; ++it) graw[jt][it] = *(const v2u*)(P + (size_t)(row >= 0 ? row : METAROW) * LDP + P_AG + hd * 64 + 16 * it + 4 * q); }
#pragma unroll
    for (int jt = 0; jt < 4; ++jt) {
        const int t = 16 * jt + r, row = hg_row(b, c, t);
        float ss = 0.f;
#pragma unroll
        for (int it = 0; it < 4; ++it) { const f32x4 o = accO[it][jt]; ss += (o[0] * o[0] + o[1] * o[1]) + (o[2] * o[2] + o[3] * o[3]); }
        ss += shx(ss, 16, lane); ss += shx(ss, 32, lane);
        const float rinv = rsqrtf(ss * (1.0f / 64.0f) + EPS);
        if (row >= 0) {
#pragma unroll
            for (int it = 0; it < 4; ++it) { const int dv0 = 16 * it + 4 * q; const f32x4 o = accO[it][jt]; const v2u gr = graw[jt][it];
                const float g0 = bf2f(gr.x & 0xffffu), g1 = bf2f(gr.x >> 16), g2 = bf2f(gr.y & 0xffffu), g3 = bf2f(gr.y >> 16);
                v2u w; w.x = pg8::pk_bf16(o[0] * rinv * gn[it][0] * pg8::silu_f(g0), o[1] * rinv * gn[it][1] * pg8::silu_f(g1)); w.y = pg8::pk_bf16(o[2] * rinv * gn[it][2] * pg8::silu_f(g2), o[3] * rinv * gn[it][3] * pg8::silu_f(g3));
                *(v2u*)(Y + (size_t)row * D + hd * 64 + dv0) = w; }
        }
    }
    LDS_WAIT();
}

struct AtTile { bf16x8 kf[2][2]; bf16x8 vf[4]; };
__device__ __forceinline__ void attn_load(AtTile& T, const bf16* P, int krow_a, int krow_b, int kcol, int vcol, int r, int q) {
#pragma unroll
    for (int kk = 0; kk < 2; ++kk) { T.kf[0][kk] = *(const bf16x8*)(P + (size_t)(krow_a + r) * LDP + kcol + 32 * kk + 8 * q); T.kf[1][kk] = *(const bf16x8*)(P + (size_t)(krow_b + r) * LDP + kcol + 32 * kk + 8 * q); }
#pragma unroll
    for (int it = 0; it < 4; ++it) { const bf16* va = P + (size_t)(krow_a + 4 * q) * LDP + vcol + 16 * it + r; const bf16* vb = P + (size_t)(krow_b + 4 * q) * LDP + vcol + 16 * it + r;
#pragma unroll
        for (int j = 0; j < 4; ++j) { T.vf[it][j] = (short)va[(size_t)j * LDP]; T.vf[it][4 + j] = (short)vb[(size_t)j * LDP]; } }
}
__device__ __forceinline__ void attn_compute(const AtTile& T, const bf16x8 (&qf)[2][2], f32x4 (&accO)[4][2], float (&mrow)[2], float (&lrow)[2], int mode, int dpos, int r, int q) {
    const int lane = 16 * q + r;
    f32x4 s[2][2];
#pragma unroll
    for (int it = 0; it < 2; ++it)
#pragma unroll
        for (int jt = 0; jt < 2; ++jt) { s[it][jt] = (f32x4){0.f, 0.f, 0.f, 0.f};
#pragma unroll
            for (int kk = 0; kk < 2; ++kk) s[it][jt] = __builtin_amdgcn_mfma_f32_16x16x32_bf16(T.kf[it][kk], qf[jt][kk], s[it][jt], 0, 0, 0); }
    const float NEG = -INFINITY;
    bf16x8 pf[2];
#pragma unroll
    for (int jt = 0; jt < 2; ++jt) {
        float mx = NEG;
#pragma unroll
        for (int it = 0; it < 2; ++it)
#pragma unroll
            for (int e = 0; e < 4; ++e) { const int key = 16 * it + 4 * q + e, t = 16 * jt + r; bool valid;
                if (mode == 0) { const int dd = dpos + t - key; valid = dd >= 0 && dd < 128; } else if (mode == 1) valid = key < 16; else valid = key <= t && key < 16;
                const float v = valid ? s[it][jt][e] * 0.125f : NEG; s[it][jt][e] = v; mx = fmaxf(mx, v); }
        mx = fmaxf(mx, shx(mx, 16, lane)); mx = fmaxf(mx, shx(mx, 32, lane));
        const float mn = fmaxf(mrow[jt], mx), alpha = __expf(mrow[jt] - mn); mrow[jt] = mn;
        float ps = 0.f;
#pragma unroll
        for (int it = 0; it < 2; ++it)
#pragma unroll
            for (int e = 0; e < 4; ++e) { const float pe = __expf(s[it][jt][e] - mn); s[it][jt][e] = pe; ps += pe; }
        ps += shx(ps, 16, lane); ps += shx(ps, 32, lane);
        lrow[jt] = lrow[jt] * alpha + ps;
#pragma unroll
        for (int it = 0; it < 4; ++it) accO[it][jt] = accO[it][jt] * alpha;
        v4u w; w.x = pg8::pk_bf16(s[0][jt][0], s[0][jt][1]); w.y = pg8::pk_bf16(s[0][jt][2], s[0][jt][3]); w.z = pg8::pk_bf16(s[1][jt][0], s[1][jt][1]); w.w = pg8::pk_bf16(s[1][jt][2], s[1][jt][3]);
        pf[jt] = __builtin_bit_cast(bf16x8, w);
    }
#pragma unroll
    for (int it = 0; it < 4; ++it)
#pragma unroll
        for (int jt = 0; jt < 2; ++jt) accO[it][jt] = __builtin_amdgcn_mfma_f32_16x16x32_bf16(T.vf[it], pf[jt], accO[it][jt], 0, 0, 0);
}
__device__ __forceinline__ void attn_unit(Ctx& F, int l, int unit) {
    const int lane = F.lane, r = lane & 15, q = lane >> 4;
    const bf16* P = (const bf16*)(F.ws + WS_ACT); bf16* Y = (bf16*)F.out;
    const bool is_meta = unit >= NB * 6 * 128;
    int b = 0, hq, t0 = 0;
    if (is_meta) hq = unit - NB * 6 * 128; else { b = unit / 768; const int rem = unit % 768; hq = rem >> 7; t0 = (rem & 127) * 32; }
    const int kvh = hq / 3; const float sink = F.in[11][l * 6 + hq];
    const int qrow0 = is_meta ? METAROW : b * SEQ + t0;
    const int kcol = P_BK + kvh * 64, vcol = P_BV + kvh * 64;
    int first = is_meta ? 5 : (t0 >= 128 ? 0 : (128 - t0) / 32);
    AtTile cur, nxt;
    if (first < 5) attn_load(cur, P, b * SEQ + t0 - 128 + 32 * first, b * SEQ + t0 - 128 + 32 * first + 16, kcol, vcol, r, q); else attn_load(cur, P, METAROW, METAROW, kcol, vcol, r, q);
    bf16x8 qf[2][2];
#pragma unroll
    for (int jt = 0; jt < 2; ++jt)
#pragma unroll
        for (int kk = 0; kk < 2; ++kk) qf[jt][kk] = *(const bf16x8*)(P + (size_t)(qrow0 + 16 * jt + r) * LDP + P_BQ + hq * 64 + 32 * kk + 8 * q);
    f32x4 accO[4][2];
#pragma unroll
    for (int it = 0; it < 4; ++it) { accO[it][0] = (f32x4){0.f, 0.f, 0.f, 0.f}; accO[it][1] = (f32x4){0.f, 0.f, 0.f, 0.f}; }
    float mrow[2], lrow[2];
#pragma unroll
    for (int jt = 0; jt < 2; ++jt) { mrow[jt] = sink; lrow[jt] = 1.0f; }
    for (int idx = first; idx < 6; ++idx) {
        if (idx < 4) attn_load(nxt, P, b * SEQ + t0 - 96 + 32 * idx, b * SEQ + t0 - 96 + 32 * idx + 16, kcol, vcol, r, q); else if (idx == 4) attn_load(nxt, P, METAROW, METAROW, kcol, vcol, r, q);
        attn_compute(cur, qf, accO, mrow, lrow, idx < 5 ? 0 : (is_meta ? 2 : 1), 128 - 32 * idx, r, q);
        cur = nxt;
    }
#pragma unroll
    for (int jt = 0; jt < 2; ++jt) {
        if (is_meta && jt > 0) continue;
        const float inv = 1.0f / lrow[jt]; const size_t row = (size_t)(qrow0 + 16 * jt + r);
#pragma unroll
        for (int it = 0; it < 4; ++it) { const f32x4 o = accO[it][jt]; v2u w; w.x = pg8::pk_bf16(o[0] * inv, o[1] * inv); w.y = pg8::pk_bf16(o[2] * inv, o[3] * inv);
            *(v2u*)(Y + row * D + 384 + hq * 64 + 16 * it + 4 * q) = w; }
    }
}

__device__ __forceinline__ void conv_phase(Ctx& F, int l) {
    const bf16* P = (const bf16*)(F.ws + WS_ACT); bf16* Y = (bf16*)F.out;
    LAS float* GL = (LAS float*)F.lds;
    LAS float* OT = GL + 64 * 256;
    const int tid = F.tid, lane = F.lane, wave = F.wave, ch = tid & 255, half = tid >> 8;
    float wt[31];
#pragma unroll
    for (int w = 0; w < 31; ++w) wt[w] = F.in[12][(size_t)(l * 31 + w) * 256 + ch];
    const float bias = F.in[13][l * 256 + ch];
    const f32x4 lg4 = *(const f32x4*)(F.in[14] + l * 256 + 4 * lane), lb4 = *(const f32x4*)(F.in[15] + l * 256 + 4 * lane);
    const int bidc = F.gw / NWAVES;
    for (int uu = bidc; uu < CV_UNITS - 1 + F.G; uu += F.G) {
        int u = uu; if (uu >= CV_UNITS - 1) { if (bidc != F.G - 1) break; u = CV_UNITS - 1; }
        const bool is_meta = (u == CV_UNITS - 1); const int b = is_meta ? 0 : (u >> 7), t0 = is_meta ? 0 : (u & 127) * 32;
        v2u araw[8], graw[8];
#pragma unroll
        for (int ii = 0; ii < 8; ++ii) { const int i = wave + 8 * ii; int row;
            if (is_meta) { const int pos = i - 30; row = (pos >= 0 && pos < NMETA) ? METAROW + pos : -1; }
            else { const int idx = t0 - 30 + i; row = idx >= 0 ? b * SEQ + idx : (idx >= -NMETA ? METAROW + idx + NMETA : -1); }
            const size_t ro = (size_t)(row >= 0 ? row : METAROW) * LDP + P_CU + 4 * lane;
            araw[ii] = *(const v2u*)(P + ro); graw[ii] = *(const v2u*)(P + ro + 256);
            if (row < 0) araw[ii] = (v2u){0u, 0u}; }
#pragma unroll
        for (int ii = 0; ii < 8; ++ii) { const int i = wave + 8 * ii; const v2u a = araw[ii], g = graw[ii]; f32x4 gl;
            gl[0] = bf2f(a.x & 0xffffu) * sigm(bf2f(g.x & 0xffffu)); gl[1] = bf2f(a.x >> 16) * sigm(bf2f(g.x >> 16));
            gl[2] = bf2f(a.y & 0xffffu) * sigm(bf2f(g.y & 0xffffu)); gl[3] = bf2f(a.y >> 16) * sigm(bf2f(g.y >> 16));
            *(LAS f32x4*)(GL + i * 256 + 4 * lane) = gl; }
        __syncthreads();
        float gw_[46], o[16];
#pragma unroll
        for (int i = 0; i < 46; ++i) gw_[i] = GL[(half * 16 + i) * 256 + ch];
#pragma unroll
        for (int jj = 0; jj < 16; ++jj) { float a = bias;
#pragma unroll
            for (int w = 0; w < 31; ++w) a += gw_[jj + w] * wt[w];
            o[jj] = a; }
#pragma unroll
        for (int jj = 0; jj < 16; ++jj) OT[(half * 16 + jj) * 256 + ch] = o[jj];
        __syncthreads();
#pragma unroll
        for (int k = 0; k < 4; ++k) { const int tok = 4 * wave + k; const f32x4 v = *(const LAS f32x4*)(OT + tok * 256 + 4 * lane);
            const float s1 = wave_sum((v[0] + v[1]) + (v[2] + v[3]), lane), s2 = wave_sum((v[0] * v[0] + v[1] * v[1]) + (v[2] * v[2] + v[3] * v[3]), lane);
            const float mean = s1 * (1.0f / 256.0f), var = fmaxf(s2 * (1.0f / 256.0f) - mean * mean, 0.f), rstd = rsqrtf(var + EPS);
            int row; if (is_meta) row = tok < NMETA ? METAROW + tok : -1; else row = b * SEQ + t0 + tok;
            if (row >= 0) { v2u w; w.x = pg8::pk_bf16(pg8::silu_f((v[0] - mean) * rstd * lg4[0] + lb4[0]), pg8::silu_f((v[1] - mean) * rstd * lg4[1] + lb4[1]));
                w.y = pg8::pk_bf16(pg8::silu_f((v[2] - mean) * rstd * lg4[2] + lb4[2]), pg8::silu_f((v[3] - mean) * rstd * lg4[3] + lb4[3]));
                *(v2u*)(Y + (size_t)row * D + 768 + 4 * lane) = w; } }
    }
    __syncthreads();
}

#define XB_TMO      128
#define XB_XCNT(j)  (256  + 64 * (j))
#define XB_XSUB(j)  (1280 + 64 * (j))
#define XB_XGEN(j)  (2304 + 64 * (j))
#define XB_TOP      3328
#define XB_TOPGEN   3392
#define XCD_BAR_WORDS 3456
#define XB_SPIN_CAP (1u << 18)

__device__ __forceinline__ unsigned xb_ld(unsigned* p)              { return __hip_atomic_load(p, __ATOMIC_RELAXED, __HIP_MEMORY_SCOPE_AGENT); }
__device__ __forceinline__ unsigned xb_add(unsigned* p, unsigned v) { return __hip_atomic_fetch_add(p, v, __ATOMIC_RELAXED, __HIP_MEMORY_SCOPE_AGENT); }
__device__ __forceinline__ unsigned xb_xcc_id() { return (unsigned)__builtin_amdgcn_s_getreg((3 << 11) | 20) & 0xFu; }
#define XB_SPIN(cond, bar) do { unsigned _sp = 0; while (cond) { __builtin_amdgcn_s_sleep(1); \
    if ((++_sp & 255u) == 0u) { if (xb_ld(&(bar)[XB_TMO])) break; if (_sp > XB_SPIN_CAP) { atomicAdd(&(bar)[XB_TMO], 1u); break; } } } } while (0)

struct XcdBarrier {
    unsigned* bar; unsigned x;
    volatile LAS unsigned* st;
};

__device__ __forceinline__ XcdBarrier xcd_barrier_post(unsigned* bar, volatile LAS unsigned* st, int tid) {
    XcdBarrier b; b.bar = bar; b.x = xb_xcc_id(); b.st = st;
    if (tid == 0) (void)xb_add(&bar[XB_XCNT(b.x)], 1u);
    return b;
}
__device__ __forceinline__ void xcd_barrier_complete(unsigned* bar, unsigned x, unsigned& nloc, unsigned& nx) {
    const unsigned G = gridDim.x * gridDim.y * gridDim.z;
    unsigned sum, cnt, mine, sp = 0u;
    for (;;) {
        sum = 0u; cnt = 0u; mine = 0u;
#pragma unroll
        for (unsigned j = 0; j < 16; ++j) { const unsigned c = xb_ld(&bar[XB_XCNT(j)]); sum += c; cnt += (c > 0u) ? 1u : 0u; mine = (j == x) ? c : mine; }
        if (sum == G) break;
        __builtin_amdgcn_s_sleep(1);
        if ((++sp & 255u) == 0u) { if (xb_ld(&bar[XB_TMO])) break; if (sp > XB_SPIN_CAP) { atomicAdd(&bar[XB_TMO], 1u); break; } }
    }
    nloc = mine > 0u ? mine : 1u; nx = cnt > 0u ? cnt : 1u;
}

__device__ __forceinline__ void xcd_barrier(const XcdBarrier& b, int tid) {
    asm volatile("s_waitcnt vmcnt(0)" ::: "memory");
    __syncthreads();
    if (tid == 0) {
        unsigned* bar = b.bar;
        __builtin_amdgcn_s_waitcnt(0);
        unsigned nloc = b.st[0], nx = b.st[1];
        if (nloc == 0u) { xcd_barrier_complete(bar, b.x, nloc, nx); b.st[0] = nloc; b.st[1] = nx; }
        const unsigned old = xb_add(&bar[XB_XSUB(b.x)], 1u);
        const unsigned gen = old / nloc;
        if (old + 1u == (gen + 1u) * nloc) {
            __builtin_amdgcn_fence(__ATOMIC_RELEASE, "agent");
            asm volatile("s_waitcnt vmcnt(0)" ::: "memory");
            const unsigned og = xb_add(&bar[XB_TOP], 1u);
            const unsigned tg = og / nx;
            if (og + 1u == (tg + 1u) * nx) xb_add(&bar[XB_TOPGEN], 1u);
            else XB_SPIN(xb_ld(&bar[XB_TOPGEN]) == tg, bar);
            __builtin_amdgcn_fence(__ATOMIC_ACQUIRE, "agent");
            xb_add(&bar[XB_XGEN(b.x)], 1u);
            asm volatile("s_waitcnt vmcnt(0)" ::: "memory");
        } else {
            XB_SPIN(xb_ld(&bar[XB_XGEN(b.x)]) == gen, bar);
            __builtin_amdgcn_fence(__ATOMIC_ACQUIRE, "agent");
            asm volatile("s_waitcnt vmcnt(0)" ::: "memory");
        }
    }
    __syncthreads();
}

constexpr int N_PC = 2 + 9 * DEPTH;
#ifndef PHMASK
#define PHMASK 0xffff
#endif
#define PHON(k) ((PHMASK >> (k)) & 1)
__global__ void __launch_bounds__(NTHREADS, 2) fwd_kernel(Args args) {
    extern __shared__ __attribute__((aligned(16))) unsigned char lds_raw[];
    volatile LAS unsigned* bst = (volatile LAS unsigned*)((LAS unsigned char*)lds_raw + BAR_LDS_OFF);
    if (threadIdx.x == 0) { bst[0] = 0u; bst[1] = 0u; }
    __syncthreads();
    XcdBarrier gbar = xcd_barrier_post((unsigned*)(args.ws + WS_CTL), bst, (int)threadIdx.x);
    const int wave_s = __builtin_amdgcn_readfirstlane((int)threadIdx.x >> 6);
    for (int pc = args.pc_lo; pc < args.pc_hi; ++pc) {
        int lane_; asm volatile("v_mbcnt_lo_u32_b32 %0, -1, 0\n\tv_mbcnt_hi_u32_b32 %0, -1, %0" : "=v"(lane_));
        int tid_ = wave_s * 64 + lane_, pcv = pc, bid_ = blockIdx.x, grd_ = gridDim.x; asm volatile("" : "+v"(tid_)); asm volatile("" : "+s"(pcv), "+s"(bid_), "+s"(grd_));
        Ctx F;
        ArgsP ap = (ArgsP)__builtin_amdgcn_kernarg_segment_ptr(); asm volatile("" : "+s"(ap));
        F.in.ap = ap; F.out = ap->out; F.ws = ap->ws; F.lds = (LAS unsigned char*)lds_raw;
        F.tid = tid_; F.lane = F.tid & 63; F.wave = __builtin_amdgcn_readfirstlane(F.tid >> 6); F.G = grd_;
        F.gw = bid_ * NWAVES + F.wave; F.NGW = F.G * NWAVES;
        bf16* HB = (bf16*)(F.ws + WS_XN); bf16* YB = (bf16*)F.out; bf16* ACT = (bf16*)(F.ws + WS_ACT); float* HM = (float*)(F.ws + WS_HM); float* RSQ = (float*)(F.ws + WS_RSQ);
        const int l = pcv == 0 ? 0 : (pcv - 1) / 9, s = pcv == 0 ? -1 : (pcv == N_PC - 1 ? 9 : (pcv - 1) % 9);
        const unsigned char* wl = F.ws + WS_W + (size_t)l * WL_STRIDE;
        if (s == -1) { if (PHON(0)) prologue(F); }
        else if (s == 0 || s == 7) {
            const bf16* wgu = (const bf16*)(wl + (s == 0 ? WL_GU1 : WL_GU2));
            if (PHON(2)) skinny_gemm<0, 4, true>(F, nullptr, 0, wgu, FF / 16, ACT, FF, HM, 0.f);
            pg8::Gemm g{HB, wgu, MMAIN, 2 * FF, D}; pg8::StaticOrder S; S.init(MMAIN, 2 * FF, F.G, bid_);
            if (PHON(2)) build_rinv_table(F, S, RSQ);
            pg8::EpiSwiGLU E{ACT, FF, (const LAS float*)(F.lds + RTAB_OFF)};
            if (PHON(2)) pg8::gemm_phase<pg8::EpiSwiGLU, pg8::StaticOrder, true, true, true>(F.lds, g, S, E, F.tid);
        } else if (s == 1 || s == 6 || s == 8) {
            const bool isout = (s == 6);
            const bf16* wd = (const bf16*)(wl + (s == 1 ? WL_D1 : (s == 6 ? WL_OUT : WL_D2)));
            if (PHON(3)) { if (isout) skinny_gemm<1, 4, false>(F, YB + (size_t)METAROW * D, D, wd, D / 16, nullptr, 0, HM, 1.0f); else skinny_gemm<1, 11, false>(F, ACT + (size_t)METAROW * FF, FF, wd, D / 16, nullptr, 0, HM, 0.5f); }
            pg8::Gemm g{isout ? YB : ACT, wd, MMAIN, D, isout ? D : FF}; pg8::StaticOrder S; S.init(MMAIN, D, F.G, bid_);
            pg8::EpiResid E{(l == 0 && s == 1) ? F.in[0] : nullptr, HB, RSQ, isout ? 1.0f : 0.5f};
            if (PHON(3)) pg8::gemm_phase<pg8::EpiResid, pg8::StaticOrder, true, true, false>(F.lds, g, S, E, F.tid);
        } else if (s == 2) {
            if (PHON(4)) skinny_gemm<2, 4, true>(F, nullptr, 0, (const bf16*)(wl + WL_IN), INW / 16, ACT, LDP, HM, 0.f);
            pg8::Gemm g{HB, (const bf16*)(wl + WL_IN), MMAIN, LDP, D}; pg8::StaticOrder S; S.init(MMAIN, LDP, F.G, bid_);
            if (PHON(4)) build_rinv_table(F, S, RSQ);
            pg8::EpiStoreBf16 E{ACT, LDP, (const LAS float*)(F.lds + RTAB_OFF)};
            if (PHON(4)) pg8::gemm_phase<pg8::EpiStoreBf16, pg8::StaticOrder, true, true, true>(F.lds, g, S, E, F.tid);
        } else if (s == 3) {
#define M1_ATTN() do { for (int u = F.gw; u < AT_UNITS - 6; u += F.NGW) attn_unit(F, l, u); \
                const int mi = F.NGW - 1 - F.gw; if (mi < 8 && (mi & 7) < 4) attn_unit(F, l, AT_UNITS - 6 + mi); else if (mi >= 8 && mi < 16 && (mi & 7) < 2) attn_unit(F, l, AT_UNITS - 2 + (mi & 7)); } while (0)
            if (PHON(5) && F.wave < 4) M1_ATTN();
            if (PHON(6)) for (int k = F.wave; k * F.G + (F.gw / NWAVES) < HG_UNITS; k += NWAVES) hgrn_p1_unit(F, l, k * F.G + (F.gw / NWAVES));
            if (PHON(5) && F.wave >= 4) M1_ATTN();
#undef M1_ATTN
        } else if (s == 4) { if (PHON(7)) conv_phase(F, l); if (PHON(8)) hgrn_scan(F); }
        else if (s == 5) { if (PHON(9)) for (int k = F.wave; k * F.G + (F.gw / NWAVES) < HG_UNITS; k += NWAVES) hgrn_p3_unit(F, l, k * F.G + (F.gw / NWAVES)); }
        else { if (PHON(10)) final_phase(F); }
        if (pc + 1 < args.pc_hi) { if (args.pc_lo < 0) cg::this_grid().sync(); else xcd_barrier(gbar, F.tid); }
    }
}

#ifndef MK_PER_PHASE
#define MK_PER_PHASE 0
#endif
extern "C" void kernel_launch(void* const* d_in, const int* in_sizes, int n_in, void* d_out, int out_size, void* d_ws, size_t ws_size, hipStream_t stream) {
    static int grid = 0;
    if (grid == 0) {
        if (n_in != 21 || in_sizes[0] != MMAIN * D || out_size != MMAIN * D || ws_size < WS_END) { fprintf(stderr, "kernel_launch: unexpected shapes (n_in %d, in0 %d, out %d, ws %zu); nothing launched\n", n_in, n_in > 0 ? in_sizes[0] : -1, out_size, ws_size); grid = -1; return; }
        int dev = 0, cus = 0, per_cu = 0;
        if (hipGetDevice(&dev) != hipSuccess || hipDeviceGetAttribute(&cus, hipDeviceAttributeMultiprocessorCount, dev) != hipSuccess) { grid = -1; return; }
        if (hipFuncSetAttribute((const void*)fwd_kernel, hipFuncAttributeMaxDynamicSharedMemorySize, LDS_BYTES) != hipSuccess) { fprintf(stderr, "kernel_launch: hipFuncSetAttribute failed\n"); grid = -1; return; }
        if (hipOccupancyMaxActiveBlocksPerMultiprocessor(&per_cu, (const void*)fwd_kernel, NTHREADS, LDS_BYTES) != hipSuccess || per_cu < 1) { fprintf(stderr, "kernel_launch: occupancy query says %d\n", per_cu); per_cu = 1; }
        (void)hipGetLastError();
        grid = cus;
    }
    if (grid < 0) return;
    if (hipMemsetAsync((char*)d_ws + WS_CTL, 0, 16384, stream) != hipSuccess) { fprintf(stderr, "kernel_launch: hipMemsetAsync failed\n"); return; }
    Args a{};
    for (int i = 0; i < 21; ++i) a.in[i] = (const float*)d_in[i];
    a.out = (float*)d_out; a.ws = (unsigned char*)d_ws;
#if MK_PER_PHASE
    for (int pc = 0; pc < N_PC; ++pc) { a.pc_lo = pc; a.pc_hi = pc + 1; hipLaunchKernelGGL(fwd_kernel, dim3(grid), dim3(NTHREADS), LDS_BYTES, stream, a); }
#else
    a.pc_lo = 0; a.pc_hi = N_PC;
    void* kargs[] = {&a};
    hipError_t e = hipLaunchCooperativeKernel((const void*)fwd_kernel, dim3(grid), dim3(NTHREADS), kargs, LDS_BYTES, stream);
    if (e != hipSuccess) fprintf(stderr, "kernel_launch: cooperative launch failed: %s (grid %d)\n", hipGetErrorString(e), grid);
#endif
}
```

```cpp
#include <hip/hip_runtime.h>
#include <hip/hip_cooperative_groups.h>
#include <cstdio>
#include <cstdint>
namespace cg = cooperative_groups;

namespace pg8 {
#define PG8_LAS __attribute__((address_space(3)))
typedef unsigned short bf16_t;
typedef short bf16x8 __attribute__((ext_vector_type(8)));
typedef float f32x4 __attribute__((ext_vector_type(4)));
typedef unsigned u32x4 __attribute__((ext_vector_type(4)));
constexpr int BM = 256, BK = 64, HALF = 128, HTB = HALF * BK * 2  , STAGE_BYTES = 8 * HTB, NXCD = 8, WGM = 8;

__host__ __device__ __forceinline__ int lds_byte(int r, int c) { const int st = (r >> 4) * 2 + (c >> 5), rr = r & 15, cc = c & 31, ob = rr * 64 + cc * 2; return st * 1024 + (ob ^ (((ob >> 9) & 1) << 5)); }
__host__ __device__ __forceinline__ void stage_rc(int b, int& R, int& C) { const int st = b / 1024, sb = b % 1024, swz = sb ^ (((sb >> 9) & 1) << 5); R = (st >> 1) * 16 + swz / 64; C = (st & 1) * 32 + (swz % 64) / 2; }
__host__ __device__ __forceinline__ int perm32(int rho) { const int n = rho >> 4, i = rho & 15; return 8 * (i >> 2) + 4 * n + (i & 3); }

struct Unit { int pm, pn, idx; };
struct Gemm { const bf16_t* A; const bf16_t* Bt; int M, N, K; };

struct StaticOrder {
    int nM, nN, nwg, G, c;
    __host__ __device__ void init(int M, int N, int G_, int c_) { nM = M / BM; nN = N / BM; nwg = nM * nN; G = G_; c = c_; }
    __host__ __device__ bool next(int i, Unit& u) const {
        const long L = (long)i * G + c; if (L >= nwg) return false;
        int wgid = (int)L; { const int q = nwg / NXCD, r = nwg % NXCD, xcd = wgid % NXCD, off = wgid / NXCD; wgid = (xcd < r ? xcd * (q + 1) : r * (q + 1) + (xcd - r) * q) + off; }
        const int nig = WGM * nN, gid = wgid / nig, fm = gid * WGM, gsz = (nM - fm) < WGM ? (nM - fm) : WGM;
        u.pm = fm + ((wgid % nig) % gsz); u.pn = (wgid % nig) / gsz; u.idx = i; return true;
    }
    __device__ __forceinline__ void a_ready(const Unit&) const {}
    __device__ __forceinline__ void done(const Unit&) const {}
};

__device__ __forceinline__ unsigned cvt_pk_bf16(float lo, float hi) { unsigned r; asm volatile("v_cvt_pk_bf16_f32 %0, %1, %2" : "=v"(r) : "v"(lo), "v"(hi)); return r; }
typedef float f32x2 __attribute__((ext_vector_type(2)));
typedef __bf16 bf16x2_t __attribute__((ext_vector_type(2)));
typedef unsigned u32x2 __attribute__((ext_vector_type(2)));
typedef _Float16 f16x8 __attribute__((ext_vector_type(8)));
typedef _Float16 f16x4 __attribute__((ext_vector_type(4)));
typedef _Float16 f16x2 __attribute__((ext_vector_type(2)));
__device__ __forceinline__ unsigned pk_f16(float lo, float hi) { f32x2 v = {lo, hi}; f16x2 h = __builtin_convertvector(v, f16x2); return __builtin_bit_cast(unsigned, h); }
__device__ __forceinline__ unsigned pk_bf16(float lo, float hi) { f32x2 v = {lo, hi}; bf16x2_t b = __builtin_convertvector(v, bf16x2_t); return __builtin_bit_cast(unsigned, b); }
__device__ __forceinline__ float silu_f(float x) { return x * __builtin_amdgcn_rcpf(1.0f + __expf(-x)); }

__device__ __forceinline__ float shx_(float v, int o, int lane) { return __builtin_bit_cast(float, __builtin_amdgcn_ds_bpermute((lane ^ o) << 2, __builtin_bit_cast(int, v))); }
#define PG8_ROW_RINV(rinv, tab, u, wr, fr) do { _Pragma("unroll") for (int ai = 0; ai < 2; ++ai) _Pragma("unroll") for (int m = 0; m < 4; ++m) rinv[ai][m] = (tab)[(u).idx * 256 + ai * HALF + (wr) * 64 + m * 16 + (fr)]; } while (0)
struct EpiSwiGLU {
    static constexpr bool PERM = true, AFTER_DRAIN = false;
    bf16_t* O; int ldo; const PG8_LAS float* tab;
    __device__ __forceinline__ void operator()(const f32x4 (&acc)[2][2][4][2], const Unit& u, int wr, int wc, int fr, int fq) const {
        const int row0 = u.pm * BM + wr * 64 + fr; const int col0 = u.pn * 128 + wc * 32 + 8 * fq;
        float rinv[2][4]; PG8_ROW_RINV(rinv, tab, u, wr, fr);
#pragma unroll
        for (int ai = 0; ai < 2; ++ai)
#pragma unroll
            for (int m = 0; m < 4; ++m) { const float ri = rinv[ai][m];
                float g[8], up[8], e[8];
#pragma unroll
                for (int i = 0; i < 4; ++i) { g[i] = acc[ai][0][m][0][i] * ri; g[4 + i] = acc[ai][0][m][1][i] * ri; up[i] = acc[ai][1][m][0][i] * ri; up[4 + i] = acc[ai][1][m][1][i] * ri; }
#pragma unroll
                for (int i = 0; i < 8; ++i) e[i] = __builtin_amdgcn_exp2f(g[i] * -1.4426950408889634f);
#pragma unroll
                for (int i = 0; i < 8; ++i) e[i] = __builtin_amdgcn_rcpf(1.0f + e[i]);
#pragma unroll
                for (int i = 0; i < 8; ++i) g[i] = (g[i] * up[i]) * e[i];
                u32x4 w; w.x = pk_bf16(g[0], g[1]); w.y = pk_bf16(g[2], g[3]); w.z = pk_bf16(g[4], g[5]); w.w = pk_bf16(g[6], g[7]);
                *(u32x4*)(O + (size_t)(row0 + ai * HALF + m * 16) * ldo + col0) = w; }
    }
};
struct EpiStoreBf16 {
    static constexpr bool PERM = true, AFTER_DRAIN = false;
    bf16_t* O; int ldo; const PG8_LAS float* tab;
    __device__ __forceinline__ void operator()(const f32x4 (&acc)[2][2][4][2], const Unit& u, int wr, int wc, int fr, int fq) const {
        const int row0 = u.pm * BM + wr * 64 + fr; const int col0 = u.pn * BM + wc * 32 + 8 * fq;
        float rinv[2][4]; PG8_ROW_RINV(rinv, tab, u, wr, fr);
#pragma unroll
        for (int ai = 0; ai < 2; ++ai)
#pragma unroll
            for (int m = 0; m < 4; ++m) { bf16_t* rowp = O + (size_t)(row0 + ai * HALF + m * 16) * ldo + col0;
#pragma unroll
                for (int bj = 0; bj < 2; ++bj) { const f32x4 v0 = acc[ai][bj][m][0] * rinv[ai][m], v1 = acc[ai][bj][m][1] * rinv[ai][m];
                    u32x4 w; w.x = pk_bf16(v0[0], v0[1]); w.y = pk_bf16(v0[2], v0[3]); w.z = pk_bf16(v1[0], v1[1]); w.w = pk_bf16(v1[2], v1[3]);
                    *(u32x4*)(rowp + bj * HALF) = w; } }
    }
};
struct EpiResid {
    static constexpr bool PERM = true, AFTER_DRAIN = false;
    const float* in32; unsigned short* hb; float* rowsq; float scale;
    __device__ __forceinline__ void operator()(const f32x4 (&acc)[2][2][4][2], const Unit& u, int wr, int wc, int fr, int fq) const {
        const int lane = fq * 16 + fr;
        const int row0 = u.pm * BM + wr * 64 + fr; const int col0 = u.pn * BM + wc * 32 + 8 * fq;
        if (in32) {
#pragma unroll
            for (int ai = 0; ai < 2; ++ai)
#pragma unroll
              for (int mp = 0; mp < 2; ++mp) { f32x4 b0[2][2], b1[2][2];
#pragma unroll
                for (int mm = 0; mm < 2; ++mm)
#pragma unroll
                    for (int bj = 0; bj < 2; ++bj) { const float* ip = in32 + (size_t)(row0 + ai * HALF + (2 * mp + mm) * 16) * 1024 + col0 + bj * HALF; b0[mm][bj] = *(const f32x4*)ip; b1[mm][bj] = *(const f32x4*)(ip + 4); }
#pragma unroll
                for (int mm = 0; mm < 2; ++mm) { const int m = 2 * mp + mm; const int row = row0 + ai * HALF + m * 16; const size_t off = (size_t)row * 1024 + col0; float ss = 0.f;
#pragma unroll
                    for (int bj = 0; bj < 2; ++bj) { const f32x4 o0 = b0[mm][bj] + acc[ai][bj][m][0] * scale, o1 = b1[mm][bj] + acc[ai][bj][m][1] * scale;
                        ss += ((o0[0] * o0[0] + o0[1] * o0[1]) + (o0[2] * o0[2] + o0[3] * o0[3])) + ((o1[0] * o1[0] + o1[1] * o1[1]) + (o1[2] * o1[2] + o1[3] * o1[3]));
                        u32x4 w; w.x = pk_f16(o0[0], o0[1]); w.y = pk_f16(o0[2], o0[3]); w.z = pk_f16(o1[0], o1[1]); w.w = pk_f16(o1[2], o1[3]);
                        *(u32x4*)(hb + off + bj * HALF) = w; }
                    ss += shx_(ss, 16, lane); ss += shx_(ss, 32, lane);
                    if (fq == 0) rowsq[(size_t)row * 16 + u.pn * 4 + wc] = ss; } }
        } else {
#pragma unroll
            for (int ai = 0; ai < 2; ++ai) { f16x8 hv[4][2];
#pragma unroll
                for (int m = 0; m < 4; ++m)
#pragma unroll
                    for (int bj = 0; bj < 2; ++bj) hv[m][bj] = *(const f16x8*)(hb + (size_t)(row0 + ai * HALF + m * 16) * 1024 + col0 + bj * HALF);
#pragma unroll
                for (int m = 0; m < 4; ++m) { const int row = row0 + ai * HALF + m * 16; const size_t off = (size_t)row * 1024 + col0; float ss = 0.f;
#pragma unroll
                    for (int bj = 0; bj < 2; ++bj) { const f16x8 h = hv[m][bj];
                        const f32x4 o0 = (f32x4){(float)h[0], (float)h[1], (float)h[2], (float)h[3]} + acc[ai][bj][m][0] * scale, o1 = (f32x4){(float)h[4], (float)h[5], (float)h[6], (float)h[7]} + acc[ai][bj][m][1] * scale;
                        ss += ((o0[0] * o0[0] + o0[1] * o0[1]) + (o0[2] * o0[2] + o0[3] * o0[3])) + ((o1[0] * o1[0] + o1[1] * o1[1]) + (o1[2] * o1[2] + o1[3] * o1[3]));
                        u32x4 w; w.x = pk_f16(o0[0], o0[1]); w.y = pk_f16(o0[2], o0[3]); w.z = pk_f16(o1[0], o1[1]); w.w = pk_f16(o1[2], o1[3]);
                        *(u32x4*)(hb + off + bj * HALF) = w; }
                    ss += shx_(ss, 16, lane); ss += shx_(ss, 32, lane);
                    if (fq == 0) rowsq[(size_t)row * 16 + u.pn * 4 + wc] = ss; } }
        }
    }
};

template <class Epi, class Sched, bool ALIGN_EPI = false, bool SP2 = false, bool F16 = false>
__device__ __forceinline__ void gemm_phase(PG8_LAS unsigned char* lds, const Gemm g, const Sched& S, const Epi& E, int tid_in) {
    int tid_l = tid_in; asm volatile("" : "+v"(tid_l));
    const int tid = tid_l, wid = __builtin_amdgcn_readfirstlane(tid >> 6), lane = tid & 63, wr = wid >> 2, wc = wid & 3, fr = lane & 15, fq = lane >> 4;
    const int K = g.K, nt = K / BK;
    unsigned voffA[2], voffB[2];
#pragma unroll
    for (int i = 0; i < 2; ++i) { int R, C; stage_rc(tid * 16 + i * 8192, R, C); const int Rb = Epi::PERM ? ((R & ~31) + perm32(R & 31)) : R;
        voffA[i] = (unsigned)(R * K + C) * 2u; voffB[i] = (unsigned)(Rb * K + C) * 2u; }
    const size_t kstep = (size_t)(BK * 2);
    const size_t hstep = (size_t)HALF * K * 2;
    const size_t tstep = 2 * hstep;
    const unsigned ldsw = (unsigned)wid * 1024u;
    const int aoff = lds_byte(wr * 64 + fr, fq * 8), boff = lds_byte(wc * 32 + fr, fq * 8);
#define PG8_SA(b, h) (((b) * 2 + (h)) * HTB)
#define PG8_SB(b, h) ((4 + (b) * 2 + (h)) * HTB)
#define PG8_STAGE(bufoff, gbase, voff) do { _Pragma("unroll") for (int _i = 0; _i < 2; ++_i) \
        __builtin_amdgcn_global_load_lds((const unsigned*)((const char*)(gbase) + (voff)[_i]), (PG8_LAS unsigned*)(lds + (bufoff) + ldsw + _i * 8192), 16, 0, 0); } while (0)
#define PG8_LDA(dst, b, h) do { _Pragma("unroll") for (int m = 0; m < 4; ++m) _Pragma("unroll") for (int k = 0; k < 2; ++k) dst[m][k] = *(const PG8_LAS bf16x8*)(lds + PG8_SA(b, h) + aoff + m * 2048 + k * 1024); } while (0)
#define PG8_LDB(dst, b, h) do { _Pragma("unroll") for (int n = 0; n < 2; ++n) _Pragma("unroll") for (int k = 0; k < 2; ++k) dst[n][k] = *(const PG8_LAS bf16x8*)(lds + PG8_SB(b, h) + boff + n * 2048 + k * 1024); } while (0)
#define PG8_MMA(ai, bj, At, Bt) do { __builtin_amdgcn_s_setprio(1); _Pragma("unroll") for (int m = 0; m < 4; ++m) _Pragma("unroll") for (int n = 0; n < 2; ++n) _Pragma("unroll") for (int k = 0; k < 2; ++k) \
        acc[ai][bj][m][n] = F16 ? __builtin_amdgcn_mfma_f32_16x16x32_f16(__builtin_bit_cast(f16x8, Bt[n][k]), __builtin_bit_cast(f16x8, At[m][k]), acc[ai][bj][m][n], 0, 0, 0) \
                                : __builtin_amdgcn_mfma_f32_16x16x32_bf16(Bt[n][k], At[m][k], acc[ai][bj][m][n], 0, 0, 0); __builtin_amdgcn_s_setprio(0); } while (0)
#define PG8_WAIT_V(n) asm volatile("s_waitcnt vmcnt(" #n ")" ::: "memory")
#define PG8_WAIT_L(n) asm volatile("s_waitcnt lgkmcnt(" #n ")" ::: "memory")
#define PG8_BAR __builtin_amdgcn_s_barrier()
#define PG8_SCHED __builtin_amdgcn_sched_barrier(0)
    Unit cur, nxt; int ui = 0;
    if (!S.next(0, cur)) return;
    f32x4 acc[2][2][4][2];
#pragma unroll
    for (int a = 0; a < 2; ++a)
#pragma unroll
        for (int b = 0; b < 2; ++b)
#pragma unroll
            for (int m = 0; m < 4; ++m)
#pragma unroll
                for (int n = 0; n < 2; ++n) acc[a][b][m][n] = (f32x4){0.f, 0.f, 0.f, 0.f};
    bf16x8 At[4][2], B0[2][2], B1[2][2];
    const char* cA = (const char*)g.A + (size_t)cur.pm * tstep; const char* cB = (const char*)g.Bt + (size_t)cur.pn * tstep;
    S.a_ready(cur);
    if constexpr (SP2) {
        PG8_STAGE(PG8_SB(0, 0), cB, voffB); PG8_STAGE(PG8_SB(0, 1), cB + hstep, voffB); PG8_STAGE(PG8_SA(0, 0), cA, voffA); PG8_STAGE(PG8_SA(0, 1), cA + hstep, voffA);
        if (wr == 1) PG8_BAR;
        PG8_WAIT_V(2); PG8_BAR;
        PG8_STAGE(PG8_SB(1, 0), cB + kstep, voffB); PG8_STAGE(PG8_SA(1, 0), cA + kstep, voffA); PG8_STAGE(PG8_SB(1, 1), cB + hstep + kstep, voffB);
        PG8_WAIT_V(6); PG8_BAR;
    } else {
        PG8_STAGE(PG8_SB(0, 0), cB, voffB); PG8_STAGE(PG8_SA(0, 0), cA, voffA); PG8_STAGE(PG8_SB(0, 1), cB + hstep, voffB); PG8_STAGE(PG8_SA(0, 1), cA + hstep, voffA);
        if (wr == 1) PG8_BAR;
        PG8_WAIT_V(4); PG8_BAR;
        PG8_STAGE(PG8_SB(1, 0), cB + kstep, voffB); PG8_STAGE(PG8_SA(1, 0), cA + kstep, voffA); PG8_STAGE(PG8_SB(1, 1), cB + hstep + kstep, voffB);
        PG8_WAIT_V(6); PG8_BAR;
    }
    for (;;) {
        const bool has_next = S.next(ui + 1, nxt);
        const char* nA = has_next ? (const char*)g.A + (size_t)nxt.pm * tstep : cA; const char* nB = has_next ? (const char*)g.Bt + (size_t)nxt.pn * tstep : cB;
        for (int t = 0; t < nt; t += 2) {
            const bool last = (t == nt - 2);
            const char* a1 = cA + (size_t)(t + 1) * kstep;
            const char* a2 = last ? nA : cA + (size_t)(t + 2) * kstep; const char* b2 = last ? nB : cB + (size_t)(t + 2) * kstep;
            const char* a3 = a2 + kstep; const char* b3 = b2 + kstep;
            if (last && has_next) S.a_ready(nxt);
            if constexpr (SP2) {
            PG8_LDB(B0, 0, 0); PG8_LDB(B1, 0, 1); PG8_SCHED; PG8_LDA(At, 0, 0); PG8_STAGE(PG8_SA(1, 1), a1 + hstep, voffA);
            PG8_WAIT_V(8); PG8_WAIT_L(0); PG8_BAR; PG8_MMA(0, 0, At, B0); PG8_MMA(0, 1, At, B1); PG8_BAR; PG8_SCHED;
            PG8_LDA(At, 0, 1); PG8_STAGE(PG8_SB(0, 0), b2, voffB); PG8_STAGE(PG8_SB(0, 1), b2 + hstep, voffB); PG8_STAGE(PG8_SA(0, 0), a2, voffA);
            PG8_WAIT_V(8); PG8_WAIT_L(0); PG8_BAR; PG8_MMA(1, 0, At, B0); PG8_MMA(1, 1, At, B1); PG8_BAR; PG8_SCHED;
            PG8_LDB(B0, 1, 0); PG8_LDB(B1, 1, 1); PG8_SCHED; PG8_LDA(At, 1, 0); PG8_STAGE(PG8_SA(0, 1), a2 + hstep, voffA);
            PG8_WAIT_V(8); PG8_WAIT_L(0); PG8_BAR; PG8_MMA(0, 0, At, B0); PG8_MMA(0, 1, At, B1); PG8_BAR; PG8_SCHED;
            PG8_LDA(At, 1, 1); PG8_STAGE(PG8_SB(1, 0), b3, voffB); PG8_STAGE(PG8_SB(1, 1), b3 + hstep, voffB); PG8_STAGE(PG8_SA(1, 0), a3, voffA);
            PG8_WAIT_V(8); PG8_WAIT_L(0); PG8_BAR; PG8_MMA(1, 0, At, B0); PG8_MMA(1, 1, At, B1); PG8_BAR; PG8_SCHED;
            } else {
            PG8_LDB(B0, 0, 0); PG8_SCHED; PG8_LDA(At, 0, 0); PG8_STAGE(PG8_SA(1, 1), a1 + hstep, voffA);
            PG8_WAIT_L(8); PG8_BAR; PG8_WAIT_L(0); PG8_MMA(0, 0, At, B0); PG8_BAR; PG8_SCHED;
            PG8_LDB(B1, 0, 1); PG8_STAGE(PG8_SB(0, 0), b2, voffB);
            PG8_BAR; PG8_WAIT_L(0); PG8_MMA(0, 1, At, B1); PG8_BAR;
            PG8_LDA(At, 0, 1); PG8_STAGE(PG8_SA(0, 0), a2, voffA);
            PG8_BAR; PG8_WAIT_L(0); PG8_MMA(1, 0, At, B0); PG8_BAR; PG8_SCHED;
            PG8_STAGE(PG8_SB(0, 1), b2 + hstep, voffB);
            PG8_WAIT_V(6); PG8_BAR; PG8_MMA(1, 1, At, B1); PG8_BAR;
            PG8_LDB(B0, 1, 0); PG8_SCHED; PG8_LDA(At, 1, 0); PG8_STAGE(PG8_SA(0, 1), a2 + hstep, voffA);
            PG8_WAIT_L(8); PG8_BAR; PG8_WAIT_L(0); PG8_MMA(0, 0, At, B0); PG8_BAR; PG8_SCHED;
            PG8_LDB(B1, 1, 1); PG8_STAGE(PG8_SB(1, 0), b3, voffB);
            PG8_BAR; PG8_WAIT_L(0); PG8_MMA(0, 1, At, B1); PG8_BAR;
            PG8_LDA(At, 1, 1); PG8_STAGE(PG8_SA(1, 0), a3, voffA);
            PG8_BAR; PG8_WAIT_L(0); PG8_MMA(1, 0, At, B0); PG8_BAR; PG8_SCHED;
            PG8_STAGE(PG8_SB(1, 1), b3 + hstep, voffB);
            PG8_WAIT_V(6); PG8_BAR; PG8_MMA(1, 1, At, B1); PG8_BAR;
            }
        }
        if constexpr (ALIGN_EPI) { if (wr == 0) PG8_BAR; }
        if constexpr (!Epi::AFTER_DRAIN) { E(acc, cur, wr, wc, fr, fq); S.done(cur); }
        if (!has_next) break;
#pragma unroll
        for (int a = 0; a < 2; ++a)
#pragma unroll
            for (int b = 0; b < 2; ++b)
#pragma unroll
                for (int m = 0; m < 4; ++m)
#pragma unroll
                    for (int n = 0; n < 2; ++n) acc[a][b][m][n] = (f32x4){0.f, 0.f, 0.f, 0.f};
        cur = nxt; cA = nA; cB = nB; ++ui;
        if constexpr (ALIGN_EPI) { if (wr == 1) PG8_BAR; }
    }
    PG8_WAIT_V(0);
    if constexpr (!ALIGN_EPI) { if (wr == 0) PG8_BAR; }
    PG8_BAR;
    if constexpr (Epi::AFTER_DRAIN) { E.fused(acc, cur, wr, wc, fr, fq, lds, wid, lane); S.done(cur); }
#undef PG8_SA
#undef PG8_SB
#undef PG8_STAGE
#undef PG8_LDA
#undef PG8_LDB
#undef PG8_MMA
#undef PG8_WAIT_V
#undef PG8_WAIT_L
#undef PG8_BAR
#undef PG8_SCHED
}
}

#define LAS __attribute__((address_space(3)))
typedef unsigned short bf16;
typedef unsigned v4u __attribute__((ext_vector_type(4)));
typedef unsigned v2u __attribute__((ext_vector_type(2)));
typedef float f32x4 __attribute__((ext_vector_type(4)));
typedef short bf16x8 __attribute__((ext_vector_type(8)));

constexpr int NWAVES = 8, NTHREADS = 512;
constexpr int D = 1024, FF = 2816, NB = 8, SEQ = 4096, NMETA = 16, DEPTH = 4;
constexpr int MMAIN = NB * SEQ;
constexpr int METAROW = MMAIN;
constexpr int MR = MMAIN + 256;
constexpr int INW = 2688, LDP = 2816;
constexpr int P_AQ = 0, P_AF = 384, P_AI = 768, P_AG = 1152, P_BQ = 1536, P_BK = 1920, P_BV = 2048, P_CU = 2176;
constexpr float EPS = 1e-6f;
constexpr int HG_NC = 65;
constexpr int HG_UNITS = NB * 6 * HG_NC;
constexpr int AT_UNITS = NB * 6 * 128 + 6;
constexpr int CV_UNITS = NB * 128 + 1;

constexpr size_t MiB = 1u << 20;
constexpr size_t WS_CTL = 0, CTL_ZERO_BYTES = 1 * MiB;
constexpr size_t WS_HM = 1 * MiB;
constexpr size_t WS_W = 2 * MiB;
constexpr size_t WL_GU1 = 0, WL_D1 = 11 * MiB, WL_IN = WL_D1 + 5632 * 1024, WL_OUT = 22 * MiB, WL_GU2 = 24 * MiB, WL_D2 = 35 * MiB, WL_STRIDE = 40 * MiB + 512 * 1024;
constexpr size_t WS_XN = 164 * MiB;
constexpr size_t WS_ACT = 229 * MiB;
constexpr size_t WS_DS = 407 * MiB;
constexpr size_t WS_ST = 456 * MiB;
constexpr size_t WS_DEC = 481 * MiB;
constexpr size_t WS_RSQ = 482 * MiB;
constexpr size_t WS_END = 484 * MiB;
static_assert(WS_W + 4 * WL_STRIDE <= WS_XN && WS_XN + (size_t)MR * D * 2 <= WS_ACT && WS_ACT + (size_t)MR * LDP * 2 <= WS_DS && WS_DS + (size_t)HG_UNITS * 4096 * 4 <= WS_ST && WS_ST + (size_t)HG_UNITS * 4096 * 2 <= WS_DEC && WS_DEC + (size_t)HG_UNITS * 64 * 4 <= WS_RSQ && WS_RSQ + (size_t)MMAIN * 64 <= WS_END, "ws map");
static_assert(WL_IN + (size_t)LDP * 1024 * 2 <= WL_OUT && WL_D2 + (size_t)1024 * FF * 2 <= WL_STRIDE, "weight map");

constexpr int TLD = 72;
constexpr int TILE_BYTES = 64 * TLD * 2;
constexpr int WAVE_LDS = 2 * TILE_BYTES + 512;
constexpr int LDS_BYTES = 155648;
constexpr int BAR_LDS_OFF = LDS_BYTES - 16;
static_assert(NWAVES * WAVE_LDS <= BAR_LDS_OFF && pg8::STAGE_BYTES <= BAR_LDS_OFF, "LDS map");

#define LDS_WAIT() asm volatile("s_waitcnt lgkmcnt(0)" ::: "memory")
__device__ __forceinline__ unsigned f2bf(float f) { unsigned u = __builtin_bit_cast(unsigned, f); return (u + 0x7fffu + ((u >> 16) & 1u)) >> 16; }
__device__ __forceinline__ unsigned pk2(float lo, float hi) { return f2bf(lo) | (f2bf(hi) << 16); }
__device__ __forceinline__ float bf2f(unsigned u) { return __builtin_bit_cast(float, u << 16); }
__device__ __forceinline__ float sigm(float z) { return __builtin_amdgcn_rcpf(1.0f + __expf(-z)); }
__device__ __forceinline__ unsigned bf1(float x) { return pg8::pk_bf16(x, 0.f) & 0xffffu; }
constexpr float L2E = 1.4426950408889634f;
__device__ __forceinline__ unsigned f2h(float f) { return pg8::pk_f16(f, 0.f) & 0xffffu; }
__device__ __forceinline__ unsigned pk2h(float lo, float hi) { return pg8::pk_f16(lo, hi); }
#define HG_GATE16(T, j0) float z2[16], a1[16], lf[16]; { float e_[16]; \
        _Pragma("unroll") for (int i = 0; i < 16; ++i) z2[i] = bf2f((T)[((j0) + i) * TLD + lane]) * L2E; \
        _Pragma("unroll") for (int i = 0; i < 16; ++i) e_[i] = __builtin_amdgcn_exp2f(-z2[i]); \
        _Pragma("unroll") for (int i = 0; i < 16; ++i) a1[i] = __builtin_amdgcn_logf(1.0f + e_[i]); \
        _Pragma("unroll") for (int i = 0; i < 16; ++i) lf[i] = __builtin_amdgcn_logf(1.0f + lb * e_[i]) - a1[i]; }
#define HG_GATE(zbits, z2, a1, lf2) const float z2 = bf2f(zbits) * L2E; const float E_ = __builtin_amdgcn_exp2f(-z2); const float a1 = __builtin_amdgcn_logf(1.0f + E_); \
        const float lf2 = (lb > 0.f ? __builtin_amdgcn_logf(1.0f + lb * E_) : 0.f) - a1;
__device__ __forceinline__ float shx(float v, int o, int lane) { return __builtin_bit_cast(float, __builtin_amdgcn_ds_bpermute((lane ^ o) << 2, __builtin_bit_cast(int, v))); }
__device__ __forceinline__ float wave_sum(float v, int lane) {
#pragma unroll
    for (int o = 1; o < 64; o <<= 1) v += shx(v, o, lane);
    return v;
}

struct Args { const float* in[21]; float* out; unsigned char* ws; int pc_lo, pc_hi; };
typedef const __attribute__((address_space(4))) Args* ArgsP;
struct InView { ArgsP ap; __device__ __forceinline__ const float* operator[](int i) const { return ap->in[i]; } };
struct Ctx {
    InView in; float* out; unsigned char* ws;
    LAS unsigned char* lds;
    int tid, lane, wave, G, gw, NGW;
};

__device__ __forceinline__ void transpose_item(const float* W, int K, int N, const float* gain, bf16* WT, int mode, bool f16, LAS float* scr, int item, int lane) {
    const int nblk = N / 32, kb = item / nblk, nb = item % nblk, k0 = 64 * kb, n0 = 32 * nb;
    f32x4 v[8];
#pragma unroll
    for (int i = 0; i < 8; ++i) v[i] = *(const f32x4*)(W + (size_t)(k0 + 8 * i + (lane >> 3)) * N + n0 + 4 * (lane & 7));
#pragma unroll
    for (int i = 0; i < 8; ++i) { const int kk = 8 * i + (lane >> 3); const float g = gain ? gain[k0 + kk] : 1.0f; LAS float* d = scr + kk * 33 + 4 * (lane & 7);
        d[0] = v[i][0] * g; d[1] = v[i][1] * g; d[2] = v[i][2] * g; d[3] = v[i][3] * g; }
    LDS_WAIT();
    const int c = lane & 7;
#pragma unroll
    for (int j = 0; j < 4; ++j) { const int nl = (lane >> 3) + 8 * j; const LAS float* s = scr + (8 * c) * 33 + nl; const int n = n0 + nl;
        const int dr = mode == 0 ? n : ((n >> 7) * 256 + (n & 127) + (mode == 2 ? 128 : 0));
        v4u o; if (f16) { o.x = pk2h(s[0 * 33], s[1 * 33]); o.y = pk2h(s[2 * 33], s[3 * 33]); o.z = pk2h(s[4 * 33], s[5 * 33]); o.w = pk2h(s[6 * 33], s[7 * 33]); }
        else { o.x = pk2(s[0 * 33], s[1 * 33]); o.y = pk2(s[2 * 33], s[3 * 33]); o.z = pk2(s[4 * 33], s[5 * 33]); o.w = pk2(s[6 * 33], s[7 * 33]); }
        *(v4u*)(WT + (size_t)dr * K + k0 + 8 * c) = o; }
    LDS_WAIT();
}
__device__ __forceinline__ void prologue(Ctx& F) {
    LAS float* scr = (LAS float*)(F.lds + F.wave * WAVE_LDS);
    constexpr int I_G = 16 * 88, I_D = 44 * 32, I_IN = 16 * 84, I_OUT = 16 * 32, I_LAYER = 6 * 1408 + I_IN + I_OUT;
    static_assert(I_G == 1408 && I_D == 1408, "items");
    for (int it = F.gw; it < DEPTH * I_LAYER; it += F.NGW) {
        const int l = it / I_LAYER; int r = it % I_LAYER;
        bf16* wl = (bf16*)(F.ws + WS_W + (size_t)l * WL_STRIDE);
        const size_t og = (size_t)l * D * FF, od = (size_t)l * FF * D;
        if (r < I_G) { transpose_item(F.in[3] + og, D, FF, F.in[2] + l * D, (bf16*)((unsigned char*)wl + WL_GU1), 1, true, scr, r, F.lane); continue; } r -= I_G;
        if (r < I_G) { transpose_item(F.in[4] + og, D, FF, F.in[2] + l * D, (bf16*)((unsigned char*)wl + WL_GU1), 2, true, scr, r, F.lane); continue; } r -= I_G;
        if (r < I_D) { transpose_item(F.in[5] + od, FF, D, nullptr, (bf16*)((unsigned char*)wl + WL_D1), 0, false, scr, r, F.lane); continue; } r -= I_D;
        if (r < I_IN) { transpose_item(F.in[7] + (size_t)l * D * INW, D, INW, F.in[6] + l * D, (bf16*)((unsigned char*)wl + WL_IN), 0, true, scr, r, F.lane); continue; } r -= I_IN;
        if (r < I_OUT) { transpose_item(F.in[8] + (size_t)l * D * D, D, D, nullptr, (bf16*)((unsigned char*)wl + WL_OUT), 0, false, scr, r, F.lane); continue; } r -= I_OUT;
        if (r < I_G) { transpose_item(F.in[17] + og, D, FF, F.in[16] + l * D, (bf16*)((unsigned char*)wl + WL_GU2), 1, true, scr, r, F.lane); continue; } r -= I_G;
        if (r < I_G) { transpose_item(F.in[18] + og, D, FF, F.in[16] + l * D, (bf16*)((unsigned char*)wl + WL_GU2), 2, true, scr, r, F.lane); continue; } r -= I_G;
        transpose_item(F.in[19] + od, FF, D, nullptr, (bf16*)((unsigned char*)wl + WL_D2), 0, false, scr, r, F.lane);
    }
    {
        bf16* xn = (bf16*)(F.ws + WS_XN); float* rsq = (float*)(F.ws + WS_RSQ); const float* x = F.in[0];
        for (int row = 2 * F.gw; row < MMAIN; row += 2 * F.NGW) {
            const f32x4* xr = (const f32x4*)(x + (size_t)row * D) + F.lane; f32x4 v[8]; float s0 = 0.f, s1 = 0.f;
#pragma unroll
            for (int j = 0; j < 8; ++j) v[j] = xr[64 * j];
#pragma unroll
            for (int j = 0; j < 4; ++j) { s0 += (v[j].x * v[j].x + v[j].y * v[j].y) + (v[j].z * v[j].z + v[j].w * v[j].w); s1 += (v[4 + j].x * v[4 + j].x + v[4 + j].y * v[4 + j].y) + (v[4 + j].z * v[4 + j].z + v[4 + j].w * v[4 + j].w); }
            s0 = wave_sum(s0, F.lane); s1 = wave_sum(s1, F.lane);
            v2u* o8 = (v2u*)(xn + (size_t)row * D) + F.lane;
#pragma unroll
            for (int j = 0; j < 8; ++j) { v2u w; w.x = pk2h(v[j].x, v[j].y); w.y = pk2h(v[j].z, v[j].w); o8[64 * j] = w; }
            if (F.lane < 32) rsq[(size_t)row * 16 + F.lane] = F.lane == 0 ? s0 : (F.lane == 16 ? s1 : 0.f);
        }
    }
    const int gt = F.gw * 64 + F.lane, NGT = F.NGW * 64;
    for (int i = gt; i < DEPTH * 128 * 128; i += NGT) { const int l = i / (128 * 128), e = i % (128 * 128);
        *(v4u*)(F.ws + WS_W + (size_t)l * WL_STRIDE + WL_IN + (size_t)INW * 1024 * 2 + (size_t)e * 16) = (v4u){0u, 0u, 0u, 0u}; }
    for (int i = gt; i < 256 * 256; i += NGT) { const int row = i >> 8, c4 = (i & 255) * 4;
        f32x4 v = (f32x4){0.f, 0.f, 0.f, 0.f}; if (row < NMETA) v = *(const f32x4*)(F.in[1] + row * D + c4);
        *(f32x4*)((float*)(F.ws + WS_HM) + row * D + c4) = v; }
}

__device__ __forceinline__ void norm_phase(Ctx& F, const float* main_src) {
    const float* hm = (const float*)(F.ws + WS_HM); bf16* xn = (bf16*)(F.ws + WS_XN);
    for (int row = F.gw; row < MMAIN + NMETA; row += F.NGW) {
        const float* src = row < MMAIN ? main_src + (size_t)row * D : hm + (size_t)(row - MMAIN) * D;
        const f32x4* xr = (const f32x4*)src + F.lane;
        f32x4 v[4]; float s = 0.f;
#pragma unroll
        for (int j = 0; j < 4; ++j) { v[j] = xr[64 * j]; s += (v[j].x * v[j].x + v[j].y * v[j].y) + (v[j].z * v[j].z + v[j].w * v[j].w); }
        const float rinv = rsqrtf(wave_sum(s, F.lane) * (1.f / D) + EPS);
        v2u* o8 = (v2u*)(xn + (size_t)row * D) + F.lane;
#pragma unroll
        for (int j = 0; j < 4; ++j) { v2u w; w.x = pg8::pk_bf16(v[j].x * rinv, v[j].y * rinv); w.y = pg8::pk_bf16(v[j].z * rinv, v[j].w * rinv); o8[64 * j] = w; }
    }
}
__device__ __forceinline__ void final_phase(Ctx& F) {
    const float* gn = F.in[20]; const unsigned short* hb = (const unsigned short*)(F.ws + WS_XN);
    for (int row = F.gw; row < MMAIN; row += F.NGW) {
        const pg8::f16x4* hr = (const pg8::f16x4*)(hb + (size_t)row * D) + F.lane;
        f32x4 v[4]; float s = 0.f;
#pragma unroll
        for (int j = 0; j < 4; ++j) { const pg8::f16x4 h = hr[64 * j]; v[j] = (f32x4){(float)h[0], (float)h[1], (float)h[2], (float)h[3]}; s += (v[j].x * v[j].x + v[j].y * v[j].y) + (v[j].z * v[j].z + v[j].w * v[j].w); }
        const float rinv = rsqrtf(wave_sum(s, F.lane) * (1.f / D) + EPS);
        f32x4* xr = (f32x4*)(F.out + (size_t)row * D) + F.lane;
#pragma unroll
        for (int j = 0; j < 4; ++j) { const f32x4 g = *((const f32x4*)gn + F.lane + 64 * j); xr[64 * j] = v[j] * rinv * g; }
    }
}

__device__ __forceinline__ bf16x8 lds_frag(const LAS bf16* T, int tile, int kk, int r, int q) { return *(const LAS bf16x8*)(T + (16 * tile + r) * TLD + 32 * kk + 8 * q); }
__device__ __forceinline__ void wave_mma64(const LAS bf16* X, const LAS bf16* Y, f32x4 (&acc)[4][4], int r, int q) {
#pragma unroll
    for (int kk = 0; kk < 2; ++kk) {
        bf16x8 xf[4], yf[4];
#pragma unroll
        for (int i = 0; i < 4; ++i) { xf[i] = lds_frag(X, i, kk, r, q); yf[i] = lds_frag(Y, i, kk, r, q); }
#pragma unroll
        for (int it = 0; it < 4; ++it)
#pragma unroll
            for (int jt = 0; jt < 4; ++jt) acc[it][jt] = __builtin_amdgcn_mfma_f32_16x16x32_bf16(xf[it], yf[jt], acc[it][jt], 0, 0, 0);
    }
}
#define ZERO_ACC(a) do { _Pragma("unroll") for (int _i = 0; _i < 4; ++_i) _Pragma("unroll") for (int _j = 0; _j < 4; ++_j) a[_i][_j] = (f32x4){0.f, 0.f, 0.f, 0.f}; } while (0)


template <int KIND, int KSTEPS, bool AF32>
__device__ __forceinline__ void skinny_gemm(Ctx& F, const bf16* A, int lda, const bf16* Bt, int nslab, bf16* O, int ldo, float* hm, float scale) {
    constexpr int K = KSTEPS * 32 * 8, NBT = KIND == 0 ? 2 : 1;
    const int lane = F.lane, r = lane & 15, q = lane >> 4, w = F.wave, tid = F.tid;
    LAS float* part = (LAS float*)F.lds;
    LAS float* partsq = part + 8 * NBT * 256;
    for (int slab = F.gw / NWAVES; slab < nslab; slab += F.G) {
        const int brow0 = KIND == 0 ? ((slab * 16) >> 7) * 256 + ((slab * 16) & 127) : slab * 16;
        bf16x8 af[KSTEPS], bfr[NBT][KSTEPS];
#pragma unroll
        for (int t = 0; t < NBT; ++t) { const bf16* bp = Bt + (size_t)(brow0 + 128 * t + r) * K + w * (K / 8) + 8 * q;
#pragma unroll
            for (int kk = 0; kk < KSTEPS; ++kk) bfr[t][kk] = *(const bf16x8*)(bp + 32 * kk); }
        if (AF32) { const float* ap = hm + (size_t)r * D + w * (K / 8) + 8 * q; float ssq = 0.f;
#pragma unroll
            for (int kk = 0; kk < KSTEPS; ++kk) { const f32x4 x0 = *(const f32x4*)(ap + 32 * kk), x1 = *(const f32x4*)(ap + 32 * kk + 4);
                ssq += ((x0[0] * x0[0] + x0[1] * x0[1]) + (x0[2] * x0[2] + x0[3] * x0[3])) + ((x1[0] * x1[0] + x1[1] * x1[1]) + (x1[2] * x1[2] + x1[3] * x1[3]));
                v4u pk; pk.x = pk2h(x0[0], x0[1]); pk.y = pk2h(x0[2], x0[3]); pk.z = pk2h(x1[0], x1[1]); pk.w = pk2h(x1[2], x1[3]); af[kk] = __builtin_bit_cast(bf16x8, pk); }
            ssq += shx(ssq, 16, lane); ssq += shx(ssq, 32, lane);
            if (q == 0) partsq[w * 16 + r] = ssq;
        } else { const bf16* ap = A + (size_t)r * lda + w * (K / 8) + 8 * q;
#pragma unroll
            for (int kk = 0; kk < KSTEPS; ++kk) af[kk] = *(const bf16x8*)(ap + 32 * kk); }
#pragma unroll
        for (int t = 0; t < NBT; ++t) { f32x4 acc = (f32x4){0.f, 0.f, 0.f, 0.f};
#pragma unroll
            for (int kk = 0; kk < KSTEPS; ++kk) acc = AF32 ? __builtin_amdgcn_mfma_f32_16x16x32_f16(__builtin_bit_cast(pg8::f16x8, bfr[t][kk]), __builtin_bit_cast(pg8::f16x8, af[kk]), acc, 0, 0, 0)
                                                           : __builtin_amdgcn_mfma_f32_16x16x32_bf16(bfr[t][kk], af[kk], acc, 0, 0, 0);
#pragma unroll
            for (int e = 0; e < 4; ++e) part[(w * NBT + t) * 256 + (4 * q + e) * 16 + r] = acc[e]; }
        __syncthreads();
        if (tid < 256) { const int tok = tid >> 4, n = tid & 15; float s = 0.f, s2 = 0.f, sq = 0.f;
#pragma unroll
            for (int ww = 0; ww < 8; ++ww) { s += part[(ww * NBT) * 256 + n * 16 + tok]; if (KIND == 0) s2 += part[(ww * NBT + 1) * 256 + n * 16 + tok]; if (AF32) sq += partsq[ww * 16 + tok]; }
            if (AF32) { const float rinv = rsqrtf(sq * (1.0f / D) + EPS); s *= rinv; s2 *= rinv; }
            if (KIND == 0) O[(size_t)(METAROW + tok) * ldo + slab * 16 + n] = (bf16)f2bf(pg8::silu_f(s) * s2);
            else if (KIND == 1) hm[tok * D + slab * 16 + n] += scale * s;
            else O[(size_t)(METAROW + tok) * ldo + slab * 16 + n] = (bf16)f2bf(s); }
        __syncthreads();
    }
}

constexpr int RTAB_OFF = pg8::STAGE_BYTES, RTAB_UNITS = 12;
static_assert(RTAB_OFF + RTAB_UNITS * 256 * 4 <= BAR_LDS_OFF, "rinv table");
__device__ __forceinline__ void build_rinv_table(Ctx& F, const pg8::StaticOrder& S, const float* rowsq) {
    LAS float* tab = (LAS float*)(F.lds + RTAB_OFF);
    const int rl = F.tid >> 1, h = F.tid & 1;
    f32x4 a[RTAB_UNITS], b[RTAB_UNITS]; bool ok[RTAB_UNITS];
#pragma unroll
    for (int i = 0; i < RTAB_UNITS; ++i) { pg8::Unit u; ok[i] = S.next(i, u);
        if (ok[i]) { const f32x4* rp = (const f32x4*)(rowsq + (size_t)(u.pm * 256 + rl) * 16 + h * 8); a[i] = rp[0]; b[i] = rp[1]; } }
#pragma unroll
    for (int i = 0; i < RTAB_UNITS; ++i) if (ok[i]) { float s = ((a[i][0] + a[i][1]) + (a[i][2] + a[i][3])) + ((b[i][0] + b[i][1]) + (b[i][2] + b[i][3]));
        s += shx(s, 1, F.lane);
        if (h == 0) tab[i * 256 + rl] = rsqrtf(s * (1.0f / D) + EPS); }
    __syncthreads();
}

__device__ __forceinline__ float lb_of(const float* lg, int l, int ch) {
    const float x0 = lg[ch], x1 = lg[384 + ch], x2 = lg[768 + ch], x3 = lg[1152 + ch];
    const float m = fmaxf(fmaxf(x0, x1), fmaxf(x2, x3));
    const float e0 = __expf(x0 - m), e1 = __expf(x1 - m), e2 = __expf(x2 - m), e3 = __expf(x3 - m);
    float c = 0.f; if (l >= 1) c += e1; if (l >= 2) c += e2; if (l >= 3) c += e3;
    return c / (e0 + e1 + e2 + e3);
}
__device__ __forceinline__ int hg_row(int b, int c, int j) { return c == 0 ? (j < 48 ? -1 : METAROW + j - 48) : b * SEQ + (c - 1) * 64 + j; }

#define HG_LOAD_TILE(dst, col0) do { _Pragma("unroll") for (int _i = 0; _i < 8; ++_i) { const int _row = hg_row(b, c, (lane >> 3) + 8 * _i); \
        dst[_i] = *(const v4u*)(P + (size_t)(_row >= 0 ? _row : METAROW) * LDP + (col0) + hd * 64 + 8 * (lane & 7)); if (_row < 0) dst[_i] = (v4u){0u, 0u, 0u, 0u}; } } while (0)
#define HG_STORE_TILE(T, src) do { _Pragma("unroll") for (int _i = 0; _i < 8; ++_i) *(LAS v4u*)((T) + ((lane >> 3) + 8 * _i) * TLD + 8 * (lane & 7)) = src[_i]; } while (0)
#define HG_STORE_TILE_T(T, src) do { _Pragma("unroll") for (int _i = 0; _i < 8; ++_i) { const int _t = (lane >> 3) + 8 * _i; LAS bf16* _d = (T) + (8 * (lane & 7)) * TLD + _t; \
        _d[0 * TLD] = (bf16)(src[_i].x & 0xffffu); _d[1 * TLD] = (bf16)(src[_i].x >> 16); _d[2 * TLD] = (bf16)(src[_i].y & 0xffffu); _d[3 * TLD] = (bf16)(src[_i].y >> 16); \
        _d[4 * TLD] = (bf16)(src[_i].z & 0xffffu); _d[5 * TLD] = (bf16)(src[_i].z >> 16); _d[6 * TLD] = (bf16)(src[_i].w & 0xffffu); _d[7 * TLD] = (bf16)(src[_i].w >> 16); } } while (0)

__device__ __forceinline__ void hgrn_p1_unit(Ctx& F, int l, int unit) {
    const int lane = F.lane, r = lane & 15, q = lane >> 4;
    const int bh = unit / HG_NC, c = unit % HG_NC, b = bh / 6, hd = bh % 6, ch = hd * 64 + lane;
    const bf16* P = (const bf16*)(F.ws + WS_ACT);
    LAS bf16* T0 = (LAS bf16*)(F.lds + F.wave * WAVE_LDS); LAS bf16* T1 = T0 + 64 * TLD;
    v4u zraw[8], vraw[8];
    HG_LOAD_TILE(zraw, P_AF); HG_LOAD_TILE(vraw, P_AI);
    const float lb = lb_of(F.in[9], l, ch), oml = 1.0f - lb;
    HG_STORE_TILE(T1, zraw);
    LDS_WAIT();
    const int jlo = c == 0 ? 48 : 0;
    const float lom2 = __builtin_amdgcn_logf(oml);
    float G = 0.f;
    for (int j0 = jlo; j0 < 64; j0 += 16) { HG_GATE16(T1, j0);
#pragma unroll
        for (int i = 0; i < 16; ++i) G += lf[i]; }
    const float Glast = G; G = 0.f;
    for (int j = 0; j < jlo; j += 8) *(LAS v4u*)(T0 + lane * TLD + j) = (v4u){0u, 0u, 0u, 0u};
    for (int j0 = jlo; j0 < 64; j0 += 16) { HG_GATE16(T1, j0); float kx[16];
#pragma unroll
        for (int i = 0; i < 16; ++i) { G += lf[i]; kx[i] = (lom2 - z2[i] - a1[i]) + (Glast - G); }
#pragma unroll
        for (int i = 0; i < 16; ++i) kx[i] = __builtin_amdgcn_exp2f(kx[i]);
        v4u w0, w1;
        w0.x = pg8::pk_bf16(kx[0], kx[1]); w0.y = pg8::pk_bf16(kx[2], kx[3]); w0.z = pg8::pk_bf16(kx[4], kx[5]); w0.w = pg8::pk_bf16(kx[6], kx[7]);
        w1.x = pg8::pk_bf16(kx[8], kx[9]); w1.y = pg8::pk_bf16(kx[10], kx[11]); w1.z = pg8::pk_bf16(kx[12], kx[13]); w1.w = pg8::pk_bf16(kx[14], kx[15]);
        *(LAS v4u*)(T0 + lane * TLD + j0) = w0; *(LAS v4u*)(T0 + lane * TLD + j0 + 8) = w1; }
    ((float*)(F.ws + WS_DEC))[(size_t)unit * 64 + lane] = __builtin_amdgcn_exp2f(Glast);
    LDS_WAIT();
    HG_STORE_TILE_T(T1, vraw);
    LDS_WAIT();
    f32x4 acc[4][4]; ZERO_ACC(acc);
    wave_mma64(T1, T0, acc, r, q);
    float* ds = (float*)(F.ws + WS_DS) + (size_t)unit * 4096;
#pragma unroll
    for (int it = 0; it < 4; ++it)
#pragma unroll
        for (int jt = 0; jt < 4; ++jt)
#pragma unroll
            for (int e = 0; e < 4; ++e) ds[(16 * it + 4 * q + e) * 64 + 16 * jt + r] = acc[it][jt][e];
    LDS_WAIT();
}
__device__ __forceinline__ void hgrn_scan(Ctx& F) {
    typedef float f32x2v __attribute__((ext_vector_type(2)));
    const float* __restrict__ ds = (const float*)(F.ws + WS_DS); const float* __restrict__ dec = (const float*)(F.ws + WS_DEC); bf16* __restrict__ st = (bf16*)(F.ws + WS_ST);
    const int gt = F.gw * 64 + F.lane, NGT = F.NGW * 64;
    for (int idx = gt; idx < NB * 6 * 2048; idx += NGT) {
        const int bh = idx >> 11, e = (idx & 2047) * 2, dk = e & 63; float r0 = 0.f, r1 = 0.f;
        const size_t u0 = (size_t)bh * HG_NC;
#pragma unroll
        for (int c0 = 0; c0 < HG_NC; c0 += 33) {
            f32x2v d[33], x[33];
#pragma unroll
            for (int j = 0; j < 33; ++j) if (c0 + j < HG_NC) { d[j] = *(const f32x2v*)(dec + (u0 + c0 + j) * 64 + dk); x[j] = *(const f32x2v*)(ds + (u0 + c0 + j) * 4096 + e); }
#pragma unroll
            for (int j = 0; j < 33; ++j) if (c0 + j < HG_NC) { *(unsigned*)(st + (u0 + c0 + j) * 4096 + e) = pk2(r0, r1); r0 = r0 * d[j].x + x[j].x; r1 = r1 * d[j].y + x[j].y; }
        }
    }
}
__device__ __forceinline__ void hgrn_p3_unit(Ctx& F, int l, int unit) {
    const int lane = F.lane, r = lane & 15, q = lane >> 4;
    const int bh = unit / HG_NC, c = unit % HG_NC, b = bh / 6, hd = bh % 6, ch = hd * 64 + lane;
    if (c == 0 && b > 0) return;
    const bf16* P = (const bf16*)(F.ws + WS_ACT); bf16* Y = (bf16*)F.out;
    LAS bf16* T0 = (LAS bf16*)(F.lds + F.wave * WAVE_LDS); LAS bf16* T1 = T0 + 64 * TLD; LAS float* EG = (LAS float*)(T1 + 64 * TLD);
    {
        v4u zraw[8], qraw[8];
        HG_LOAD_TILE(zraw, P_AF); HG_LOAD_TILE(qraw, P_AQ);
        HG_STORE_TILE(T1, zraw); HG_STORE_TILE(T0, qraw);
    }
    const float lb = lb_of(F.in[9], l, ch), oml = 1.0f - lb;
    LDS_WAIT();
    const int jlo = c == 0 ? 48 : 0;
    const float lom2 = __builtin_amdgcn_logf(oml);
    float G = 0.f;
    for (int j0 = jlo; j0 < 32; j0 += 16) { HG_GATE16(T1, j0);
#pragma unroll
        for (int i = 0; i < 16; ++i) G += lf[i]; }
    const float Gm = G; G = 0.f;
    for (int j0 = jlo; j0 < 64; j0 += 16) { HG_GATE16(T1, j0); float qx[16], kx[16], qv[16];
#pragma unroll
        for (int i = 0; i < 16; ++i) qv[i] = bf2f(T0[(j0 + i) * TLD + lane]);
#pragma unroll
        for (int i = 0; i < 16; ++i) { G += lf[i]; qx[i] = G - Gm; kx[i] = (lom2 - z2[i] - a1[i]) + (Gm - G); }
#pragma unroll
        for (int i = 0; i < 16; ++i) { qx[i] = __builtin_amdgcn_exp2f(qx[i]); kx[i] = __builtin_amdgcn_exp2f(kx[i]); }
#pragma unroll
        for (int i = 0; i < 16; ++i) { T0[(j0 + i) * TLD + lane] = (bf16)bf1(qv[i] * qx[i]); T1[(j0 + i) * TLD + lane] = (bf16)bf1(kx[i]); } }
    EG[lane] = __builtin_amdgcn_exp2f(Gm);
    LDS_WAIT();
    f32x4 accA[4][4], accO[4][4]; ZERO_ACC(accA); ZERO_ACC(accO);
    wave_mma64(T1, T0, accA, r, q);
    {
        const bf16* st = (const bf16*)(F.ws + WS_ST) + (size_t)unit * 4096;
#pragma unroll
        for (int kk = 0; kk < 2; ++kk) {
            bf16x8 yf[4]; float eg[8]; v4u raw[4];
#pragma unroll
            for (int it = 0; it < 4; ++it) raw[it] = *(const v4u*)(st + (16 * it + r) * 64 + 32 * kk + 8 * q);
#pragma unroll
            for (int i = 0; i < 4; ++i) yf[i] = lds_frag(T0, i, kk, r, q);
#pragma unroll
            for (int j = 0; j < 8; ++j) eg[j] = EG[32 * kk + 8 * q + j];
#pragma unroll
            for (int it = 0; it < 4; ++it) {
                v4u sc;
                sc.x = pk2(bf2f(raw[it].x & 0xffffu) * eg[0], bf2f(raw[it].x >> 16) * eg[1]); sc.y = pk2(bf2f(raw[it].y & 0xffffu) * eg[2], bf2f(raw[it].y >> 16) * eg[3]);
                sc.z = pk2(bf2f(raw[it].z & 0xffffu) * eg[4], bf2f(raw[it].z >> 16) * eg[5]); sc.w = pk2(bf2f(raw[it].w & 0xffffu) * eg[6], bf2f(raw[it].w >> 16) * eg[7]);
                const bf16x8 xf = __builtin_bit_cast(bf16x8, sc);
#pragma unroll
                for (int jt = 0; jt < 4; ++jt) accO[it][jt] = __builtin_amdgcn_mfma_f32_16x16x32_bf16(xf, yf[jt], accO[it][jt], 0, 0, 0);
            }
        }
    }
    v4u vraw[8];
    HG_LOAD_TILE(vraw, P_AI);
    LDS_WAIT();
#pragma unroll
    for (int it = 0; it < 4; ++it)
#pragma unroll
        for (int jt = 0; jt < 4; ++jt) { const int t = 16 * jt + r, s0 = 16 * it + 4 * q; const f32x4 a = accA[it][jt];
            v2u w; w.x = pk2(s0 + 0 <= t ? a[0] : 0.f, s0 + 1 <= t ? a[1] : 0.f); w.y = pk2(s0 + 2 <= t ? a[2] : 0.f, s0 + 3 <= t ? a[3] : 0.f);
            *(LAS v2u*)(T0 + t * TLD + s0) = w; }
    HG_STORE_TILE_T(T1, vraw);
    LDS_WAIT();
    wave_mma64(T1, T0, accO, r, q);
    const float* og = F.in[10] + l * 64;
    v2u graw[4][4]; f32x4 gn[4];
#pragma unroll
    for (int it = 0; it < 4; ++it) gn[it] = *(const f32x4*)(og + 16 * it + 4 * q);
#pragma unroll
    for (int jt = 0; jt < 4; ++jt) { const int row = hg_row(b, c, 16 * jt + r);
#pragma unroll
        for (int it = 0; it < 4; ++it) graw[jt][it] = *(const v2u*)(P + (size_t)(row >= 0 ? row : METAROW) * LDP + P_AG + hd * 64 + 16 * it + 4 * q); }
#pragma unroll
    for (int jt = 0; jt < 4; ++jt) {
        const int t = 16 * jt + r, row = hg_row(b, c, t);
        float ss = 0.f;
#pragma unroll
        for (int it = 0; it < 4; ++it) { const f32x4 o = accO[it][jt]; ss += (o[0] * o[0] + o[1] * o[1]) + (o[2] * o[2] + o[3] * o[3]); }
        ss += shx(ss, 16, lane); ss += shx(ss, 32, lane);
        const float rinv = rsqrtf(ss * (1.0f / 64.0f) + EPS);
        if (row >= 0) {
#pragma unroll
            for (int it = 0; it < 4; ++it) { const int dv0 = 16 * it + 4 * q; const f32x4 o = accO[it][jt]; const v2u gr = graw[jt][it];
                const float g0 = bf2f(gr.x & 0xffffu), g1 = bf2f(gr.x >> 16), g2 = bf2f(gr.y & 0xffffu), g3 = bf2f(gr.y >> 16);
                v2u w; w.x = pg8::pk_bf16(o[0] * rinv * gn[it][0] * pg8::silu_f(g0), o[1] * rinv * gn[it][1] * pg8::silu_f(g1)); w.y = pg8::pk_bf16(o[2] * rinv * gn[it][2] * pg8::silu_f(g2), o[3] * rinv * gn[it][3] * pg8::silu_f(g3));
                *(v2u*)(Y + (size_t)row * D + hd * 64 + dv0) = w; }
        }
    }
    LDS_WAIT();
}

struct AtTile { bf16x8 kf[2][2]; bf16x8 vf[4]; };
__device__ __forceinline__ void attn_load(AtTile& T, const bf16* P, int krow_a, int krow_b, int kcol, int vcol, int r, int q) {
#pragma unroll
    for (int kk = 0; kk < 2; ++kk) { T.kf[0][kk] = *(const bf16x8*)(P + (size_t)(krow_a + r) * LDP + kcol + 32 * kk + 8 * q); T.kf[1][kk] = *(const bf16x8*)(P + (size_t)(krow_b + r) * LDP + kcol + 32 * kk + 8 * q); }
#pragma unroll
    for (int it = 0; it < 4; ++it) { const bf16* va = P + (size_t)(krow_a + 4 * q) * LDP + vcol + 16 * it + r; const bf16* vb = P + (size_t)(krow_b + 4 * q) * LDP + vcol + 16 * it + r;
#pragma unroll
        for (int j = 0; j < 4; ++j) { T.vf[it][j] = (short)va[(size_t)j * LDP]; T.vf[it][4 + j] = (short)vb[(size_t)j * LDP]; } }
}
constexpr float ATT_C2 = 0.125f * 1.4426950408889634f, ATT_THR = 11.5f;
__device__ __forceinline__ void attn_compute(const AtTile& T, const bf16x8 (&qf)[2][2], f32x4 (&accO)[4][2], float (&mrow)[2], float (&lrow)[2], int mode, int dpos, int r, int q) {
    const int lane = 16 * q + r;
    f32x4 s[2][2];
#pragma unroll
    for (int it = 0; it < 2; ++it)
#pragma unroll
        for (int jt = 0; jt < 2; ++jt) { s[it][jt] = (f32x4){0.f, 0.f, 0.f, 0.f};
#pragma unroll
            for (int kk = 0; kk < 2; ++kk) s[it][jt] = __builtin_amdgcn_mfma_f32_16x16x32_bf16(T.kf[it][kk], qf[jt][kk], s[it][jt], 0, 0, 0); }
    const float NEG = -INFINITY;
#pragma unroll
    for (int it = 0; it < 2; ++it)
#pragma unroll
        for (int jt = 0; jt < 2; ++jt) s[it][jt] = s[it][jt] * ATT_C2;
    if (mode != 0 || dpos < 32 || dpos > 96) {
#pragma unroll
        for (int jt = 0; jt < 2; ++jt)
#pragma unroll
            for (int it = 0; it < 2; ++it)
#pragma unroll
                for (int e = 0; e < 4; ++e) { const int key = 16 * it + 4 * q + e, t = 16 * jt + r; bool valid;
                    if (mode == 0) { const int dd = dpos + t - key; valid = dd >= 0 && dd < 128; } else if (mode == 1) valid = key < 16; else valid = key <= t && key < 16;
                    if (!valid) s[it][jt][e] = NEG; }
    }
    float mx[2];
#pragma unroll
    for (int jt = 0; jt < 2; ++jt) { float m = fmaxf(fmaxf(fmaxf(s[0][jt][0], s[0][jt][1]), fmaxf(s[0][jt][2], s[0][jt][3])), fmaxf(fmaxf(s[1][jt][0], s[1][jt][1]), fmaxf(s[1][jt][2], s[1][jt][3])));
        m = fmaxf(m, shx(m, 16, lane)); mx[jt] = fmaxf(m, shx(m, 32, lane)); }
    if (__builtin_amdgcn_ballot_w64(mx[0] > mrow[0] + ATT_THR || mx[1] > mrow[1] + ATT_THR) != 0ull) {
#pragma unroll
        for (int jt = 0; jt < 2; ++jt) { const float mn = fmaxf(mrow[jt], mx[jt]), alpha = __builtin_amdgcn_exp2f(mrow[jt] - mn); mrow[jt] = mn; lrow[jt] *= alpha;
#pragma unroll
            for (int it = 0; it < 4; ++it) accO[it][jt] = accO[it][jt] * alpha; }
    }
    bf16x8 pf[2];
#pragma unroll
    for (int jt = 0; jt < 2; ++jt) { const float mn = mrow[jt]; float ps = 0.f;
#pragma unroll
        for (int it = 0; it < 2; ++it)
#pragma unroll
            for (int e = 0; e < 4; ++e) { const float pe = __builtin_amdgcn_exp2f(s[it][jt][e] - mn); s[it][jt][e] = pe; ps += pe; }
        ps += shx(ps, 16, lane); ps += shx(ps, 32, lane);
        lrow[jt] += ps;
        v4u w; w.x = pg8::pk_bf16(s[0][jt][0], s[0][jt][1]); w.y = pg8::pk_bf16(s[0][jt][2], s[0][jt][3]); w.z = pg8::pk_bf16(s[1][jt][0], s[1][jt][1]); w.w = pg8::pk_bf16(s[1][jt][2], s[1][jt][3]);
        pf[jt] = __builtin_bit_cast(bf16x8, w);
    }
#pragma unroll
    for (int it = 0; it < 4; ++it)
#pragma unroll
        for (int jt = 0; jt < 2; ++jt) accO[it][jt] = __builtin_amdgcn_mfma_f32_16x16x32_bf16(T.vf[it], pf[jt], accO[it][jt], 0, 0, 0);
}
__device__ __forceinline__ void attn_unit(Ctx& F, int l, int unit) {
    const int lane = F.lane, r = lane & 15, q = lane >> 4;
    const bf16* P = (const bf16*)(F.ws + WS_ACT); bf16* Y = (bf16*)F.out;
    const bool is_meta = unit >= NB * 6 * 128;
    int b = 0, hq, t0 = 0;
    if (is_meta) hq = unit - NB * 6 * 128; else { b = unit / 768; const int rem = unit % 768; hq = rem >> 7; t0 = (rem & 127) * 32; }
    const int kvh = hq / 3; const float sink = F.in[11][l * 6 + hq];
    const int qrow0 = is_meta ? METAROW : b * SEQ + t0;
    const int kcol = P_BK + kvh * 64, vcol = P_BV + kvh * 64;
    int first = is_meta ? 5 : (t0 >= 128 ? 0 : (128 - t0) / 32);
    AtTile cur, nxt;
    if (first < 5) attn_load(cur, P, b * SEQ + t0 - 128 + 32 * first, b * SEQ + t0 - 128 + 32 * first + 16, kcol, vcol, r, q); else attn_load(cur, P, METAROW, METAROW, kcol, vcol, r, q);
    bf16x8 qf[2][2];
#pragma unroll
    for (int jt = 0; jt < 2; ++jt)
#pragma unroll
        for (int kk = 0; kk < 2; ++kk) qf[jt][kk] = *(const bf16x8*)(P + (size_t)(qrow0 + 16 * jt + r) * LDP + P_BQ + hq * 64 + 32 * kk + 8 * q);
    f32x4 accO[4][2];
#pragma unroll
    for (int it = 0; it < 4; ++it) { accO[it][0] = (f32x4){0.f, 0.f, 0.f, 0.f}; accO[it][1] = (f32x4){0.f, 0.f, 0.f, 0.f}; }
    float mrow[2], lrow[2];
#pragma unroll
    for (int jt = 0; jt < 2; ++jt) { mrow[jt] = sink * L2E; lrow[jt] = 1.0f; }
    for (int idx = first; idx < 6; ++idx) {
        if (idx < 4) attn_load(nxt, P, b * SEQ + t0 - 96 + 32 * idx, b * SEQ + t0 - 96 + 32 * idx + 16, kcol, vcol, r, q); else if (idx == 4) attn_load(nxt, P, METAROW, METAROW, kcol, vcol, r, q);
        attn_compute(cur, qf, accO, mrow, lrow, idx < 5 ? 0 : (is_meta ? 2 : 1), 128 - 32 * idx, r, q);
        cur = nxt;
    }
#pragma unroll
    for (int jt = 0; jt < 2; ++jt) {
        if (is_meta && jt > 0) continue;
        const float inv = 1.0f / lrow[jt]; const size_t row = (size_t)(qrow0 + 16 * jt + r);
#pragma unroll
        for (int it = 0; it < 4; ++it) { const f32x4 o = accO[it][jt]; v2u w; w.x = pg8::pk_bf16(o[0] * inv, o[1] * inv); w.y = pg8::pk_bf16(o[2] * inv, o[3] * inv);
            *(v2u*)(Y + row * D + 384 + hq * 64 + 16 * it + 4 * q) = w; }
    }
}

__device__ __forceinline__ void conv_phase(Ctx& F, int l) {
    const bf16* P = (const bf16*)(F.ws + WS_ACT); bf16* Y = (bf16*)F.out;
    LAS float* GL = (LAS float*)F.lds;
    LAS float* OT = GL + 64 * 256;
    const int tid = F.tid, lane = F.lane, wave = F.wave, ch = tid & 255, half = tid >> 8;
    float wt[31];
#pragma unroll
    for (int w = 0; w < 31; ++w) wt[w] = F.in[12][(size_t)(l * 31 + w) * 256 + ch];
    const float bias = F.in[13][l * 256 + ch];
    const f32x4 lg4 = *(const f32x4*)(F.in[14] + l * 256 + 4 * lane), lb4 = *(const f32x4*)(F.in[15] + l * 256 + 4 * lane);
    const int bidc = F.gw / NWAVES;
    for (int uu = bidc; uu < CV_UNITS - 1 + F.G; uu += F.G) {
        int u = uu; if (uu >= CV_UNITS - 1) { if (bidc != F.G - 1) break; u = CV_UNITS - 1; }
        const bool is_meta = (u == CV_UNITS - 1); const int b = is_meta ? 0 : (u >> 7), t0 = is_meta ? 0 : (u & 127) * 32;
        v2u araw[8], graw[8];
#pragma unroll
        for (int ii = 0; ii < 8; ++ii) { const int i = wave + 8 * ii; int row;
            if (is_meta) { const int pos = i - 30; row = (pos >= 0 && pos < NMETA) ? METAROW + pos : -1; }
            else { const int idx = t0 - 30 + i; row = idx >= 0 ? b * SEQ + idx : (idx >= -NMETA ? METAROW + idx + NMETA : -1); }
            const size_t ro = (size_t)(row >= 0 ? row : METAROW) * LDP + P_CU + 4 * lane;
            araw[ii] = *(const v2u*)(P + ro); graw[ii] = *(const v2u*)(P + ro + 256);
            if (row < 0) araw[ii] = (v2u){0u, 0u}; }
#pragma unroll
        for (int ii = 0; ii < 8; ++ii) { const int i = wave + 8 * ii; const v2u a = araw[ii], g = graw[ii]; f32x4 gl;
            gl[0] = bf2f(a.x & 0xffffu) * sigm(bf2f(g.x & 0xffffu)); gl[1] = bf2f(a.x >> 16) * sigm(bf2f(g.x >> 16));
            gl[2] = bf2f(a.y & 0xffffu) * sigm(bf2f(g.y & 0xffffu)); gl[3] = bf2f(a.y >> 16) * sigm(bf2f(g.y >> 16));
            *(LAS f32x4*)(GL + i * 256 + 4 * lane) = gl; }
        __syncthreads();
        float gw_[46], o[16];
#pragma unroll
        for (int i = 0; i < 46; ++i) gw_[i] = GL[(half * 16 + i) * 256 + ch];
#pragma unroll
        for (int jj = 0; jj < 16; ++jj) { float a = bias;
#pragma unroll
            for (int w = 0; w < 31; ++w) a += gw_[jj + w] * wt[w];
            o[jj] = a; }
#pragma unroll
        for (int jj = 0; jj < 16; ++jj) OT[(half * 16 + jj) * 256 + ch] = o[jj];
        __syncthreads();
#pragma unroll
        for (int k = 0; k < 4; ++k) { const int tok = 4 * wave + k; const f32x4 v = *(const LAS f32x4*)(OT + tok * 256 + 4 * lane);
            const float s1 = wave_sum((v[0] + v[1]) + (v[2] + v[3]), lane), s2 = wave_sum((v[0] * v[0] + v[1] * v[1]) + (v[2] * v[2] + v[3] * v[3]), lane);
            const float mean = s1 * (1.0f / 256.0f), var = fmaxf(s2 * (1.0f / 256.0f) - mean * mean, 0.f), rstd = rsqrtf(var + EPS);
            int row; if (is_meta) row = tok < NMETA ? METAROW + tok : -1; else row = b * SEQ + t0 + tok;
            if (row >= 0) { v2u w; w.x = pg8::pk_bf16(pg8::silu_f((v[0] - mean) * rstd * lg4[0] + lb4[0]), pg8::silu_f((v[1] - mean) * rstd * lg4[1] + lb4[1]));
                w.y = pg8::pk_bf16(pg8::silu_f((v[2] - mean) * rstd * lg4[2] + lb4[2]), pg8::silu_f((v[3] - mean) * rstd * lg4[3] + lb4[3]));
                *(v2u*)(Y + (size_t)row * D + 768 + 4 * lane) = w; } }
    }
    __syncthreads();
}

#define XB_TMO      128
#define XB_XCNT(j)  (256  + 64 * (j))
#define XB_XSUB(j)  (1280 + 64 * (j))
#define XB_XGEN(j)  (2304 + 64 * (j))
#define XB_TOP      3328
#define XB_TOPGEN   3392
#define XCD_BAR_WORDS 3456
#define XB_SPIN_CAP (1u << 18)

__device__ __forceinline__ unsigned xb_ld(unsigned* p)              { return __hip_atomic_load(p, __ATOMIC_RELAXED, __HIP_MEMORY_SCOPE_AGENT); }
__device__ __forceinline__ unsigned xb_add(unsigned* p, unsigned v) { return __hip_atomic_fetch_add(p, v, __ATOMIC_RELAXED, __HIP_MEMORY_SCOPE_AGENT); }
__device__ __forceinline__ unsigned xb_xcc_id() { return (unsigned)__builtin_amdgcn_s_getreg((3 << 11) | 20) & 0xFu; }
#define XB_SPIN(cond, bar) do { unsigned _sp = 0; while (cond) { __builtin_amdgcn_s_sleep(1); \
    if ((++_sp & 255u) == 0u) { if (xb_ld(&(bar)[XB_TMO])) break; if (_sp > XB_SPIN_CAP) { atomicAdd(&(bar)[XB_TMO], 1u); break; } } } } while (0)

struct XcdBarrier {
    unsigned* bar; unsigned x;
    volatile LAS unsigned* st;
};

__device__ __forceinline__ XcdBarrier xcd_barrier_post(unsigned* bar, volatile LAS unsigned* st, int tid) {
    XcdBarrier b; b.bar = bar; b.x = xb_xcc_id(); b.st = st;
    if (tid == 0) (void)xb_add(&bar[XB_XCNT(b.x)], 1u);
    return b;
}
__device__ __forceinline__ void xcd_barrier_complete(unsigned* bar, unsigned x, unsigned& nloc, unsigned& nx) {
    const unsigned G = gridDim.x * gridDim.y * gridDim.z;
    unsigned sum, cnt, mine, sp = 0u;
    for (;;) {
        sum = 0u; cnt = 0u; mine = 0u;
#pragma unroll
        for (unsigned j = 0; j < 16; ++j) { const unsigned c = xb_ld(&bar[XB_XCNT(j)]); sum += c; cnt += (c > 0u) ? 1u : 0u; mine = (j == x) ? c : mine; }
        if (sum == G) break;
        __builtin_amdgcn_s_sleep(1);
        if ((++sp & 255u) == 0u) { if (xb_ld(&bar[XB_TMO])) break; if (sp > XB_SPIN_CAP) { atomicAdd(&bar[XB_TMO], 1u); break; } }
    }
    nloc = mine > 0u ? mine : 1u; nx = cnt > 0u ? cnt : 1u;
}

__device__ __forceinline__ void xcd_barrier(const XcdBarrier& b, int tid) {
    asm volatile("s_waitcnt vmcnt(0)" ::: "memory");
    __syncthreads();
    if (tid == 0) {
        unsigned* bar = b.bar;
        __builtin_amdgcn_s_waitcnt(0);
        unsigned nloc = b.st[0], nx = b.st[1];
        if (nloc == 0u) { xcd_barrier_complete(bar, b.x, nloc, nx); b.st[0] = nloc; b.st[1] = nx; }
        const unsigned old = xb_add(&bar[XB_XSUB(b.x)], 1u);
        const unsigned gen = old / nloc;
        if (old + 1u == (gen + 1u) * nloc) {
            __builtin_amdgcn_fence(__ATOMIC_RELEASE, "agent");
            asm volatile("s_waitcnt vmcnt(0)" ::: "memory");
            const unsigned og = xb_add(&bar[XB_TOP], 1u);
            const unsigned tg = og / nx;
            if (og + 1u == (tg + 1u) * nx) xb_add(&bar[XB_TOPGEN], 1u);
            else XB_SPIN(xb_ld(&bar[XB_TOPGEN]) == tg, bar);
            __builtin_amdgcn_fence(__ATOMIC_ACQUIRE, "agent");
            xb_add(&bar[XB_XGEN(b.x)], 1u);
            asm volatile("s_waitcnt vmcnt(0)" ::: "memory");
        } else {
            XB_SPIN(xb_ld(&bar[XB_XGEN(b.x)]) == gen, bar);
            __builtin_amdgcn_fence(__ATOMIC_ACQUIRE, "agent");
            asm volatile("s_waitcnt vmcnt(0)" ::: "memory");
        }
    }
    __syncthreads();
}

constexpr int N_PC = 2 + 9 * DEPTH;
#ifndef PHMASK
#define PHMASK 0xffff
#endif
#define PHON(k) ((PHMASK >> (k)) & 1)
__global__ void __launch_bounds__(NTHREADS, 2) fwd_kernel(Args args) {
    extern __shared__ __attribute__((aligned(16))) unsigned char lds_raw[];
    volatile LAS unsigned* bst = (volatile LAS unsigned*)((LAS unsigned char*)lds_raw + BAR_LDS_OFF);
    if (threadIdx.x == 0) { bst[0] = 0u; bst[1] = 0u; }
    __syncthreads();
    XcdBarrier gbar = xcd_barrier_post((unsigned*)(args.ws + WS_CTL), bst, (int)threadIdx.x);
    const int wave_s = __builtin_amdgcn_readfirstlane((int)threadIdx.x >> 6);
    for (int pc = args.pc_lo; pc < args.pc_hi; ++pc) {
        int lane_; asm volatile("v_mbcnt_lo_u32_b32 %0, -1, 0\n\tv_mbcnt_hi_u32_b32 %0, -1, %0" : "=v"(lane_));
        int tid_ = wave_s * 64 + lane_, pcv = pc, bid_ = blockIdx.x, grd_ = gridDim.x; asm volatile("" : "+v"(tid_)); asm volatile("" : "+s"(pcv), "+s"(bid_), "+s"(grd_));
        Ctx F;
        ArgsP ap = (ArgsP)__builtin_amdgcn_kernarg_segment_ptr(); asm volatile("" : "+s"(ap));
        F.in.ap = ap; F.out = ap->out; F.ws = ap->ws; F.lds = (LAS unsigned char*)lds_raw;
        F.tid = tid_; F.lane = F.tid & 63; F.wave = __builtin_amdgcn_readfirstlane(F.tid >> 6); F.G = grd_;
        F.gw = bid_ * NWAVES + F.wave; F.NGW = F.G * NWAVES;
        bf16* HB = (bf16*)(F.ws + WS_XN); bf16* YB = (bf16*)F.out; bf16* ACT = (bf16*)(F.ws + WS_ACT); float* HM = (float*)(F.ws + WS_HM); float* RSQ = (float*)(F.ws + WS_RSQ);
        const int l = pcv == 0 ? 0 : (pcv - 1) / 9, s = pcv == 0 ? -1 : (pcv == N_PC - 1 ? 9 : (pcv - 1) % 9);
        const unsigned char* wl = F.ws + WS_W + (size_t)l * WL_STRIDE;
        if (s == -1) { if (PHON(0)) prologue(F); }
        else if (s == 0 || s == 7) {
            const bf16* wgu = (const bf16*)(wl + (s == 0 ? WL_GU1 : WL_GU2));
            if (PHON(2)) skinny_gemm<0, 4, true>(F, nullptr, 0, wgu, FF / 16, ACT, FF, HM, 0.f);
            pg8::Gemm g{HB, wgu, MMAIN, 2 * FF, D}; pg8::StaticOrder S; S.init(MMAIN, 2 * FF, F.G, bid_);
            if (PHON(2)) build_rinv_table(F, S, RSQ);
            pg8::EpiSwiGLU E{ACT, FF, (const LAS float*)(F.lds + RTAB_OFF)};
            if (PHON(2)) pg8::gemm_phase<pg8::EpiSwiGLU, pg8::StaticOrder, true, true, true>(F.lds, g, S, E, F.tid);
        } else if (s == 1 || s == 6 || s == 8) {
            const bool isout = (s == 6);
            const bf16* wd = (const bf16*)(wl + (s == 1 ? WL_D1 : (s == 6 ? WL_OUT : WL_D2)));
            if (PHON(3)) { if (isout) skinny_gemm<1, 4, false>(F, YB + (size_t)METAROW * D, D, wd, D / 16, nullptr, 0, HM, 1.0f); else skinny_gemm<1, 11, false>(F, ACT + (size_t)METAROW * FF, FF, wd, D / 16, nullptr, 0, HM, 0.5f); }
            pg8::Gemm g{isout ? YB : ACT, wd, MMAIN, D, isout ? D : FF}; pg8::StaticOrder S; S.init(MMAIN, D, F.G, bid_);
            pg8::EpiResid E{(l == 0 && s == 1) ? F.in[0] : nullptr, HB, RSQ, isout ? 1.0f : 0.5f};
            if (PHON(3)) pg8::gemm_phase<pg8::EpiResid, pg8::StaticOrder, true, true, false>(F.lds, g, S, E, F.tid);
        } else if (s == 2) {
            if (PHON(4)) skinny_gemm<2, 4, true>(F, nullptr, 0, (const bf16*)(wl + WL_IN), INW / 16, ACT, LDP, HM, 0.f);
            pg8::Gemm g{HB, (const bf16*)(wl + WL_IN), MMAIN, LDP, D}; pg8::StaticOrder S; S.init(MMAIN, LDP, F.G, bid_);
            if (PHON(4)) build_rinv_table(F, S, RSQ);
            pg8::EpiStoreBf16 E{ACT, LDP, (const LAS float*)(F.lds + RTAB_OFF)};
            if (PHON(4)) pg8::gemm_phase<pg8::EpiStoreBf16, pg8::StaticOrder, true, true, true>(F.lds, g, S, E, F.tid);
        } else if (s == 3) {
#define M1_ATTN() do { for (int u = F.gw; u < AT_UNITS - 6; u += F.NGW) attn_unit(F, l, u); \
                const int mi = F.NGW - 1 - F.gw; if (mi < 8 && (mi & 7) < 4) attn_unit(F, l, AT_UNITS - 6 + mi); else if (mi >= 8 && mi < 16 && (mi & 7) < 2) attn_unit(F, l, AT_UNITS - 2 + (mi & 7)); } while (0)
            if (PHON(5) && F.wave < 4) M1_ATTN();
            if (PHON(6)) for (int k = F.wave; k * F.G + (F.gw / NWAVES) < HG_UNITS; k += NWAVES) hgrn_p1_unit(F, l, k * F.G + (F.gw / NWAVES));
            if (PHON(5) && F.wave >= 4) M1_ATTN();
#undef M1_ATTN
        } else if (s == 4) { if (PHON(7)) conv_phase(F, l); if (PHON(8)) hgrn_scan(F); }
        else if (s == 5) { if (PHON(9)) for (int k = F.wave; k * F.G + (F.gw / NWAVES) < HG_UNITS; k += NWAVES) hgrn_p3_unit(F, l, k * F.G + (F.gw / NWAVES)); }
        else { if (PHON(10)) final_phase(F); }
        if (pc + 1 < args.pc_hi) { if (args.pc_lo < 0) cg::this_grid().sync(); else xcd_barrier(gbar, F.tid); }
    }
}

#ifndef MK_PER_PHASE
#define MK_PER_PHASE 0
#endif
extern "C" void kernel_launch(void* const* d_in, const int* in_sizes, int n_in, void* d_out, int out_size, void* d_ws, size_t ws_size, hipStream_t stream) {
    static int grid = 0;
    if (grid == 0) {
        if (n_in != 21 || in_sizes[0] != MMAIN * D || out_size != MMAIN * D || ws_size < WS_END) { fprintf(stderr, "kernel_launch: unexpected shapes (n_in %d, in0 %d, out %d, ws %zu); nothing launched\n", n_in, n_in > 0 ? in_sizes[0] : -1, out_size, ws_size); grid = -1; return; }
        int dev = 0, cus = 0, per_cu = 0;
        if (hipGetDevice(&dev) != hipSuccess || hipDeviceGetAttribute(&cus, hipDeviceAttributeMultiprocessorCount, dev) != hipSuccess) { grid = -1; return; }
        if (hipFuncSetAttribute((const void*)fwd_kernel, hipFuncAttributeMaxDynamicSharedMemorySize, LDS_BYTES) != hipSuccess) { fprintf(stderr, "kernel_launch: hipFuncSetAttribute failed\n"); grid = -1; return; }
        if (hipOccupancyMaxActiveBlocksPerMultiprocessor(&per_cu, (const void*)fwd_kernel, NTHREADS, LDS_BYTES) != hipSuccess || per_cu < 1) { fprintf(stderr, "kernel_launch: occupancy query says %d\n", per_cu); per_cu = 1; }
        (void)hipGetLastError();
        grid = cus;
    }
    if (grid < 0) return;
    if (hipMemsetAsync((char*)d_ws + WS_CTL, 0, 16384, stream) != hipSuccess) { fprintf(stderr, "kernel_launch: hipMemsetAsync failed\n"); return; }
    Args a{};
    for (int i = 0; i < 21; ++i) a.in[i] = (const float*)d_in[i];
    a.out = (float*)d_out; a.ws = (unsigned char*)d_ws;
#if MK_PER_PHASE
    for (int pc = 0; pc < N_PC; ++pc) { a.pc_lo = pc; a.pc_hi = pc + 1; hipLaunchKernelGGL(fwd_kernel, dim3(grid), dim3(NTHREADS), LDS_BYTES, stream, a); }
#else
    a.pc_lo = 0; a.pc_hi = N_PC;
    void* kargs[] = {&a};
    hipError_t e = hipLaunchCooperativeKernel((const void*)fwd_kernel, dim3(grid), dim3(NTHREADS), kargs, LDS_BYTES, stream);
    if (e != hipSuccess) fprintf(stderr, "kernel_launch: cooperative launch failed: %s (grid %d)\n", hipGetErrorString(e), grid);
#endif
}
```

```cpp
#include <hip/hip_runtime.h>
#include <hip/hip_cooperative_groups.h>
#include <cstdio>
#include <cstdint>
namespace cg = cooperative_groups;

namespace pg8 {
#define PG8_LAS __attribute__((address_space(3)))
typedef unsigned short bf16_t;
typedef short bf16x8 __attribute__((ext_vector_type(8)));
typedef float f32x4 __attribute__((ext_vector_type(4)));
typedef unsigned u32x4 __attribute__((ext_vector_type(4)));
constexpr int BM = 256, BK = 64, HALF = 128, HTB = HALF * BK * 2  , STAGE_BYTES = 8 * HTB, NXCD = 8, WGM = 8;

__host__ __device__ __forceinline__ int lds_byte(int r, int c) { const int st = (r >> 4) * 2 + (c >> 5), rr = r & 15, cc = c & 31, ob = rr * 64 + cc * 2; return st * 1024 + (ob ^ (((ob >> 9) & 1) << 5)); }
__host__ __device__ __forceinline__ void stage_rc(int b, int& R, int& C) { const int st = b / 1024, sb = b % 1024, swz = sb ^ (((sb >> 9) & 1) << 5); R = (st >> 1) * 16 + swz / 64; C = (st & 1) * 32 + (swz % 64) / 2; }
__host__ __device__ __forceinline__ int perm32(int rho) { const int n = rho >> 4, i = rho & 15; return 8 * (i >> 2) + 4 * n + (i & 3); }

struct Unit { int pm, pn, idx; };
struct Gemm { const bf16_t* A; const bf16_t* Bt; int M, N, K; };

struct StaticOrder {
    int nM, nN, nwg, G, c;
    __host__ __device__ void init(int M, int N, int G_, int c_) { nM = M / BM; nN = N / BM; nwg = nM * nN; G = G_; c = c_; }
    __host__ __device__ bool next(int i, Unit& u) const {
        const long L = (long)i * G + c; if (L >= nwg) return false;
        int wgid = (int)L; { const int q = nwg / NXCD, r = nwg % NXCD, xcd = wgid % NXCD, off = wgid / NXCD; wgid = (xcd < r ? xcd * (q + 1) : r * (q + 1) + (xcd - r) * q) + off; }
        const int nig = WGM * nN, gid = wgid / nig, fm = gid * WGM, gsz = (nM - fm) < WGM ? (nM - fm) : WGM;
        u.pm = fm + ((wgid % nig) % gsz); u.pn = (wgid % nig) / gsz; u.idx = i; return true;
    }
    __device__ __forceinline__ void a_ready(const Unit&) const {}
    __device__ __forceinline__ void done(const Unit&) const {}
};

__device__ __forceinline__ unsigned cvt_pk_bf16(float lo, float hi) { unsigned r; asm volatile("v_cvt_pk_bf16_f32 %0, %1, %2" : "=v"(r) : "v"(lo), "v"(hi)); return r; }
typedef float f32x2 __attribute__((ext_vector_type(2)));
typedef __bf16 bf16x2_t __attribute__((ext_vector_type(2)));
typedef unsigned u32x2 __attribute__((ext_vector_type(2)));
typedef _Float16 f16x8 __attribute__((ext_vector_type(8)));
typedef _Float16 f16x4 __attribute__((ext_vector_type(4)));
typedef _Float16 f16x2 __attribute__((ext_vector_type(2)));
__device__ __forceinline__ unsigned pk_f16(float lo, float hi) { f32x2 v = {lo, hi}; f16x2 h = __builtin_convertvector(v, f16x2); return __builtin_bit_cast(unsigned, h); }
__device__ __forceinline__ unsigned pk_bf16(float lo, float hi) { f32x2 v = {lo, hi}; bf16x2_t b = __builtin_convertvector(v, bf16x2_t); return __builtin_bit_cast(unsigned, b); }
__device__ __forceinline__ float silu_f(float x) { return x * __builtin_amdgcn_rcpf(1.0f + __expf(-x)); }

__device__ __forceinline__ float shx_(float v, int o, int lane) { return __builtin_bit_cast(float, __builtin_amdgcn_ds_bpermute((lane ^ o) << 2, __builtin_bit_cast(int, v))); }
#define PG8_ROW_RINV(rinv, tab, u, wr, fr) do { _Pragma("unroll") for (int ai = 0; ai < 2; ++ai) _Pragma("unroll") for (int m = 0; m < 4; ++m) rinv[ai][m] = (tab)[(u).idx * 256 + ai * HALF + (wr) * 64 + m * 16 + (fr)]; } while (0)
struct EpiSwiGLU {
    static constexpr bool PERM = true, AFTER_DRAIN = false;
    bf16_t* O; int ldo; const PG8_LAS float* tab;
    __device__ __forceinline__ void operator()(const f32x4 (&acc)[2][2][4][2], const Unit& u, int wr, int wc, int fr, int fq) const {
        const int row0 = u.pm * BM + wr * 64 + fr; const int col0 = u.pn * 128 + wc * 32 + 8 * fq;
        float rinv[2][4]; PG8_ROW_RINV(rinv, tab, u, wr, fr);
#pragma unroll
        for (int ai = 0; ai < 2; ++ai)
#pragma unroll
            for (int m = 0; m < 4; ++m) { const float ri = rinv[ai][m];
                float g[8], up[8], e[8];
#pragma unroll
                for (int i = 0; i < 4; ++i) { g[i] = acc[ai][0][m][0][i] * ri; g[4 + i] = acc[ai][0][m][1][i] * ri; up[i] = acc[ai][1][m][0][i] * ri; up[4 + i] = acc[ai][1][m][1][i] * ri; }
#pragma unroll
                for (int i = 0; i < 8; ++i) e[i] = __builtin_amdgcn_exp2f(g[i] * -1.4426950408889634f);
#pragma unroll
                for (int i = 0; i < 8; ++i) e[i] = __builtin_amdgcn_rcpf(1.0f + e[i]);
#pragma unroll
                for (int i = 0; i < 8; ++i) g[i] = (g[i] * up[i]) * e[i];
                u32x4 w; w.x = pk_bf16(g[0], g[1]); w.y = pk_bf16(g[2], g[3]); w.z = pk_bf16(g[4], g[5]); w.w = pk_bf16(g[6], g[7]);
                *(u32x4*)(O + (size_t)(row0 + ai * HALF + m * 16) * ldo + col0) = w; }
    }
};
struct EpiStoreBf16 {
    static constexpr bool PERM = true, AFTER_DRAIN = false;
    bf16_t* O; int ldo; const PG8_LAS float* tab;
    __device__ __forceinline__ void operator()(const f32x4 (&acc)[2][2][4][2], const Unit& u, int wr, int wc, int fr, int fq) const {
        const int row0 = u.pm * BM + wr * 64 + fr; const int col0 = u.pn * BM + wc * 32 + 8 * fq;
        float rinv[2][4]; PG8_ROW_RINV(rinv, tab, u, wr, fr);
#pragma unroll
        for (int ai = 0; ai < 2; ++ai)
#pragma unroll
            for (int m = 0; m < 4; ++m) { bf16_t* rowp = O + (size_t)(row0 + ai * HALF + m * 16) * ldo + col0;
#pragma unroll
                for (int bj = 0; bj < 2; ++bj) { const f32x4 v0 = acc[ai][bj][m][0] * rinv[ai][m], v1 = acc[ai][bj][m][1] * rinv[ai][m];
                    u32x4 w; w.x = pk_bf16(v0[0], v0[1]); w.y = pk_bf16(v0[2], v0[3]); w.z = pk_bf16(v1[0], v1[1]); w.w = pk_bf16(v1[2], v1[3]);
                    *(u32x4*)(rowp + bj * HALF) = w; } }
    }
};
struct EpiResid {
    static constexpr bool PERM = true, AFTER_DRAIN = false;
    const float* in32; unsigned short* hb; float* rowsq; float scale;
    __device__ __forceinline__ void operator()(const f32x4 (&acc)[2][2][4][2], const Unit& u, int wr, int wc, int fr, int fq) const {
        const int lane = fq * 16 + fr;
        const int row0 = u.pm * BM + wr * 64 + fr; const int col0 = u.pn * BM + wc * 32 + 8 * fq;
        if (in32) {
#pragma unroll
            for (int ai = 0; ai < 2; ++ai)
#pragma unroll
              for (int mp = 0; mp < 2; ++mp) { f32x4 b0[2][2], b1[2][2];
#pragma unroll
                for (int mm = 0; mm < 2; ++mm)
#pragma unroll
                    for (int bj = 0; bj < 2; ++bj) { const float* ip = in32 + (size_t)(row0 + ai * HALF + (2 * mp + mm) * 16) * 1024 + col0 + bj * HALF; b0[mm][bj] = *(const f32x4*)ip; b1[mm][bj] = *(const f32x4*)(ip + 4); }
#pragma unroll
                for (int mm = 0; mm < 2; ++mm) { const int m = 2 * mp + mm; const int row = row0 + ai * HALF + m * 16; const size_t off = (size_t)row * 1024 + col0; float ss = 0.f;
#pragma unroll
                    for (int bj = 0; bj < 2; ++bj) { const f32x4 o0 = b0[mm][bj] + acc[ai][bj][m][0] * scale, o1 = b1[mm][bj] + acc[ai][bj][m][1] * scale;
                        ss += ((o0[0] * o0[0] + o0[1] * o0[1]) + (o0[2] * o0[2] + o0[3] * o0[3])) + ((o1[0] * o1[0] + o1[1] * o1[1]) + (o1[2] * o1[2] + o1[3] * o1[3]));
                        u32x4 w; w.x = pk_f16(o0[0], o0[1]); w.y = pk_f16(o0[2], o0[3]); w.z = pk_f16(o1[0], o1[1]); w.w = pk_f16(o1[2], o1[3]);
                        *(u32x4*)(hb + off + bj * HALF) = w; }
                    ss += shx_(ss, 16, lane); ss += shx_(ss, 32, lane);
                    if (fq == 0) rowsq[(size_t)row * 16 + u.pn * 4 + wc] = ss; } }
        } else {
#pragma unroll
            for (int ai = 0; ai < 2; ++ai) { f16x8 hv[4][2];
#pragma unroll
                for (int m = 0; m < 4; ++m)
#pragma unroll
                    for (int bj = 0; bj < 2; ++bj) hv[m][bj] = *(const f16x8*)(hb + (size_t)(row0 + ai * HALF + m * 16) * 1024 + col0 + bj * HALF);
#pragma unroll
                for (int m = 0; m < 4; ++m) { const int row = row0 + ai * HALF + m * 16; const size_t off = (size_t)row * 1024 + col0; float ss = 0.f;
#pragma unroll
                    for (int bj = 0; bj < 2; ++bj) { const f16x8 h = hv[m][bj];
                        const f32x4 o0 = (f32x4){(float)h[0], (float)h[1], (float)h[2], (float)h[3]} + acc[ai][bj][m][0] * scale, o1 = (f32x4){(float)h[4], (float)h[5], (float)h[6], (float)h[7]} + acc[ai][bj][m][1] * scale;
                        ss += ((o0[0] * o0[0] + o0[1] * o0[1]) + (o0[2] * o0[2] + o0[3] * o0[3])) + ((o1[0] * o1[0] + o1[1] * o1[1]) + (o1[2] * o1[2] + o1[3] * o1[3]));
                        u32x4 w; w.x = pk_f16(o0[0], o0[1]); w.y = pk_f16(o0[2], o0[3]); w.z = pk_f16(o1[0], o1[1]); w.w = pk_f16(o1[2], o1[3]);
                        *(u32x4*)(hb + off + bj * HALF) = w; }
                    ss += shx_(ss, 16, lane); ss += shx_(ss, 32, lane);
                    if (fq == 0) rowsq[(size_t)row * 16 + u.pn * 4 + wc] = ss; } }
        }
    }
};

template <class Epi, class Sched, bool ALIGN_EPI = false, bool SP2 = false, bool F16 = false>
__device__ __forceinline__ void gemm_phase(PG8_LAS unsigned char* lds, const Gemm g, const Sched& S, const Epi& E, int tid_in) {
    int tid_l = tid_in; asm volatile("" : "+v"(tid_l));
    const int tid = tid_l, wid = __builtin_amdgcn_readfirstlane(tid >> 6), lane = tid & 63, wr = wid >> 2, wc = wid & 3, fr = lane & 15, fq = lane >> 4;
    const int K = g.K, nt = K / BK;
    unsigned voffA[2], voffB[2];
#pragma unroll
    for (int i = 0; i < 2; ++i) { int R, C; stage_rc(tid * 16 + i * 8192, R, C); const int Rb = Epi::PERM ? ((R & ~31) + perm32(R & 31)) : R;
        voffA[i] = (unsigned)(R * K + C) * 2u; voffB[i] = (unsigned)(Rb * K + C) * 2u; }
    const size_t kstep = (size_t)(BK * 2);
    const size_t hstep = (size_t)HALF * K * 2;
    const size_t tstep = 2 * hstep;
    const unsigned ldsw = (unsigned)wid * 1024u;
    const int aoff = lds_byte(wr * 64 + fr, fq * 8), boff = lds_byte(wc * 32 + fr, fq * 8);
#define PG8_SA(b, h) (((b) * 2 + (h)) * HTB)
#define PG8_SB(b, h) ((4 + (b) * 2 + (h)) * HTB)
#define PG8_STAGE(bufoff, gbase, voff) do { _Pragma("unroll") for (int _i = 0; _i < 2; ++_i) \
        __builtin_amdgcn_global_load_lds((const unsigned*)((const char*)(gbase) + (voff)[_i]), (PG8_LAS unsigned*)(lds + (bufoff) + ldsw + _i * 8192), 16, 0, 0); } while (0)
#define PG8_LDA(dst, b, h) do { _Pragma("unroll") for (int m = 0; m < 4; ++m) _Pragma("unroll") for (int k = 0; k < 2; ++k) dst[m][k] = *(const PG8_LAS bf16x8*)(lds + PG8_SA(b, h) + aoff + m * 2048 + k * 1024); } while (0)
#define PG8_LDB(dst, b, h) do { _Pragma("unroll") for (int n = 0; n < 2; ++n) _Pragma("unroll") for (int k = 0; k < 2; ++k) dst[n][k] = *(const PG8_LAS bf16x8*)(lds + PG8_SB(b, h) + boff + n * 2048 + k * 1024); } while (0)
#define PG8_MMA(ai, bj, At, Bt) do { __builtin_amdgcn_s_setprio(1); _Pragma("unroll") for (int m = 0; m < 4; ++m) _Pragma("unroll") for (int n = 0; n < 2; ++n) _Pragma("unroll") for (int k = 0; k < 2; ++k) \
        acc[ai][bj][m][n] = F16 ? __builtin_amdgcn_mfma_f32_16x16x32_f16(__builtin_bit_cast(f16x8, Bt[n][k]), __builtin_bit_cast(f16x8, At[m][k]), acc[ai][bj][m][n], 0, 0, 0) \
                                : __builtin_amdgcn_mfma_f32_16x16x32_bf16(Bt[n][k], At[m][k], acc[ai][bj][m][n], 0, 0, 0); __builtin_amdgcn_s_setprio(0); } while (0)
#define PG8_WAIT_V(n) asm volatile("s_waitcnt vmcnt(" #n ")" ::: "memory")
#define PG8_WAIT_L(n) asm volatile("s_waitcnt lgkmcnt(" #n ")" ::: "memory")
#define PG8_BAR __builtin_amdgcn_s_barrier()
#define PG8_SCHED __builtin_amdgcn_sched_barrier(0)
    Unit cur, nxt; int ui = 0;
    if (!S.next(0, cur)) return;
    f32x4 acc[2][2][4][2];
#pragma unroll
    for (int a = 0; a < 2; ++a)
#pragma unroll
        for (int b = 0; b < 2; ++b)
#pragma unroll
            for (int m = 0; m < 4; ++m)
#pragma unroll
                for (int n = 0; n < 2; ++n) acc[a][b][m][n] = (f32x4){0.f, 0.f, 0.f, 0.f};
    bf16x8 At[4][2], B0[2][2], B1[2][2];
    const char* cA = (const char*)g.A + (size_t)cur.pm * tstep; const char* cB = (const char*)g.Bt + (size_t)cur.pn * tstep;
    S.a_ready(cur);
    if constexpr (SP2) {
        PG8_STAGE(PG8_SB(0, 0), cB, voffB); PG8_STAGE(PG8_SB(0, 1), cB + hstep, voffB); PG8_STAGE(PG8_SA(0, 0), cA, voffA); PG8_STAGE(PG8_SA(0, 1), cA + hstep, voffA);
        if (wr == 1) PG8_BAR;
        PG8_WAIT_V(2); PG8_BAR;
        PG8_STAGE(PG8_SB(1, 0), cB + kstep, voffB); PG8_STAGE(PG8_SA(1, 0), cA + kstep, voffA); PG8_STAGE(PG8_SB(1, 1), cB + hstep + kstep, voffB);
        PG8_WAIT_V(6); PG8_BAR;
    } else {
        PG8_STAGE(PG8_SB(0, 0), cB, voffB); PG8_STAGE(PG8_SA(0, 0), cA, voffA); PG8_STAGE(PG8_SB(0, 1), cB + hstep, voffB); PG8_STAGE(PG8_SA(0, 1), cA + hstep, voffA);
        if (wr == 1) PG8_BAR;
        PG8_WAIT_V(4); PG8_BAR;
        PG8_STAGE(PG8_SB(1, 0), cB + kstep, voffB); PG8_STAGE(PG8_SA(1, 0), cA + kstep, voffA); PG8_STAGE(PG8_SB(1, 1), cB + hstep + kstep, voffB);
        PG8_WAIT_V(6); PG8_BAR;
    }
    for (;;) {
        const bool has_next = S.next(ui + 1, nxt);
        const char* nA = has_next ? (const char*)g.A + (size_t)nxt.pm * tstep : cA; const char* nB = has_next ? (const char*)g.Bt + (size_t)nxt.pn * tstep : cB;
        for (int t = 0; t < nt; t += 2) {
            const bool last = (t == nt - 2);
            const char* a1 = cA + (size_t)(t + 1) * kstep;
            const char* a2 = last ? nA : cA + (size_t)(t + 2) * kstep; const char* b2 = last ? nB : cB + (size_t)(t + 2) * kstep;
            const char* a3 = a2 + kstep; const char* b3 = b2 + kstep;
            if (last && has_next) S.a_ready(nxt);
            if constexpr (SP2) {
            PG8_LDB(B0, 0, 0); PG8_LDB(B1, 0, 1); PG8_SCHED; PG8_LDA(At, 0, 0); PG8_STAGE(PG8_SA(1, 1), a1 + hstep, voffA);
            PG8_WAIT_V(8); PG8_WAIT_L(0); PG8_BAR; PG8_MMA(0, 0, At, B0); PG8_MMA(0, 1, At, B1); PG8_BAR; PG8_SCHED;
            PG8_LDA(At, 0, 1); PG8_STAGE(PG8_SB(0, 0), b2, voffB); PG8_STAGE(PG8_SB(0, 1), b2 + hstep, voffB); PG8_STAGE(PG8_SA(0, 0), a2, voffA);
            PG8_WAIT_V(8); PG8_WAIT_L(0); PG8_BAR; PG8_MMA(1, 0, At, B0); PG8_MMA(1, 1, At, B1); PG8_BAR; PG8_SCHED;
            PG8_LDB(B0, 1, 0); PG8_LDB(B1, 1, 1); PG8_SCHED; PG8_LDA(At, 1, 0); PG8_STAGE(PG8_SA(0, 1), a2 + hstep, voffA);
            PG8_WAIT_V(8); PG8_WAIT_L(0); PG8_BAR; PG8_MMA(0, 0, At, B0); PG8_MMA(0, 1, At, B1); PG8_BAR; PG8_SCHED;
            PG8_LDA(At, 1, 1); PG8_STAGE(PG8_SB(1, 0), b3, voffB); PG8_STAGE(PG8_SB(1, 1), b3 + hstep, voffB); PG8_STAGE(PG8_SA(1, 0), a3, voffA);
            PG8_WAIT_V(8); PG8_WAIT_L(0); PG8_BAR; PG8_MMA(1, 0, At, B0); PG8_MMA(1, 1, At, B1); PG8_BAR; PG8_SCHED;
            } else {
            PG8_LDB(B0, 0, 0); PG8_SCHED; PG8_LDA(At, 0, 0); PG8_STAGE(PG8_SA(1, 1), a1 + hstep, voffA);
            PG8_WAIT_L(8); PG8_BAR; PG8_WAIT_L(0); PG8_MMA(0, 0, At, B0); PG8_BAR; PG8_SCHED;
            PG8_LDB(B1, 0, 1); PG8_STAGE(PG8_SB(0, 0), b2, voffB);
            PG8_BAR; PG8_WAIT_L(0); PG8_MMA(0, 1, At, B1); PG8_BAR;
            PG8_LDA(At, 0, 1); PG8_STAGE(PG8_SA(0, 0), a2, voffA);
            PG8_BAR; PG8_WAIT_L(0); PG8_MMA(1, 0, At, B0); PG8_BAR; PG8_SCHED;
            PG8_STAGE(PG8_SB(0, 1), b2 + hstep, voffB);
            PG8_WAIT_V(6); PG8_BAR; PG8_MMA(1, 1, At, B1); PG8_BAR;
            PG8_LDB(B0, 1, 0); PG8_SCHED; PG8_LDA(At, 1, 0); PG8_STAGE(PG8_SA(0, 1), a2 + hstep, voffA);
            PG8_WAIT_L(8); PG8_BAR; PG8_WAIT_L(0); PG8_MMA(0, 0, At, B0); PG8_BAR; PG8_SCHED;
            PG8_LDB(B1, 1, 1); PG8_STAGE(PG8_SB(1, 0), b3, voffB);
            PG8_BAR; PG8_WAIT_L(0); PG8_MMA(0, 1, At, B1); PG8_BAR;
            PG8_LDA(At, 1, 1); PG8_STAGE(PG8_SA(1, 0), a3, voffA);
            PG8_BAR; PG8_WAIT_L(0); PG8_MMA(1, 0, At, B0); PG8_BAR; PG8_SCHED;
            PG8_STAGE(PG8_SB(1, 1), b3 + hstep, voffB);
            PG8_WAIT_V(6); PG8_BAR; PG8_MMA(1, 1, At, B1); PG8_BAR;
            }
        }
        if constexpr (ALIGN_EPI) { if (wr == 0) PG8_BAR; }
        if constexpr (!Epi::AFTER_DRAIN) { E(acc, cur, wr, wc, fr, fq); S.done(cur); }
        if (!has_next) break;
#pragma unroll
        for (int a = 0; a < 2; ++a)
#pragma unroll
            for (int b = 0; b < 2; ++b)
#pragma unroll
                for (int m = 0; m < 4; ++m)
#pragma unroll
                    for (int n = 0; n < 2; ++n) acc[a][b][m][n] = (f32x4){0.f, 0.f, 0.f, 0.f};
        cur = nxt; cA = nA; cB = nB; ++ui;
        if constexpr (ALIGN_EPI) { if (wr == 1) PG8_BAR; }
    }
    PG8_WAIT_V(0);
    if constexpr (!ALIGN_EPI) { if (wr == 0) PG8_BAR; }
    PG8_BAR;
    if constexpr (Epi::AFTER_DRAIN) { E.fused(acc, cur, wr, wc, fr, fq, lds, wid, lane); S.done(cur); }
#undef PG8_SA
#undef PG8_SB
#undef PG8_STAGE
#undef PG8_LDA
#undef PG8_LDB
#undef PG8_MMA
#undef PG8_WAIT_V
#undef PG8_WAIT_L
#undef PG8_BAR
#undef PG8_SCHED
}
}

#define LAS __attribute__((address_space(3)))
typedef unsigned short bf16;
typedef unsigned v4u __attribute__((ext_vector_type(4)));
typedef unsigned v2u __attribute__((ext_vector_type(2)));
typedef float f32x4 __attribute__((ext_vector_type(4)));
typedef short bf16x8 __attribute__((ext_vector_type(8)));

constexpr int NWAVES = 8, NTHREADS = 512;
constexpr int D = 1024, FF = 2816, NB = 8, SEQ = 4096, NMETA = 16, DEPTH = 4;
constexpr int MMAIN = NB * SEQ;
constexpr int METAROW = MMAIN;
constexpr int MR = MMAIN + 256;
constexpr int INW = 2688, LDP = 2816;
constexpr int P_AQ = 0, P_AF = 384, P_AI = 768, P_AG = 1152, P_BQ = 1536, P_BK = 1920, P_BV = 2048, P_CU = 2176;
constexpr float EPS = 1e-6f;
constexpr int HG_NC = 65;
constexpr int HG_UNITS = NB * 6 * HG_NC;
constexpr int AT_UNITS = NB * 6 * 128 + 6;
constexpr int CV_UNITS = NB * 128 + 1;

constexpr size_t MiB = 1u << 20;
constexpr size_t WS_CTL = 0, CTL_ZERO_BYTES = 1 * MiB;
constexpr size_t WS_HM = 1 * MiB;
constexpr size_t WS_W = 2 * MiB;
constexpr size_t WL_GU1 = 0, WL_D1 = 11 * MiB, WL_IN = WL_D1 + 5632 * 1024, WL_OUT = 22 * MiB, WL_GU2 = 24 * MiB, WL_D2 = 35 * MiB, WL_STRIDE = 40 * MiB + 512 * 1024;
constexpr size_t WS_XN = 164 * MiB;
constexpr size_t WS_ACT = 229 * MiB;
constexpr size_t WS_DS = 407 * MiB;
constexpr size_t WS_ST = 456 * MiB;
constexpr size_t WS_DEC = 481 * MiB;
constexpr size_t WS_RSQ = 482 * MiB;
constexpr size_t WS_END = 484 * MiB;
static_assert(WS_W + 4 * WL_STRIDE <= WS_XN && WS_XN + (size_t)MR * D * 2 <= WS_ACT && WS_ACT + (size_t)MR * LDP * 2 <= WS_DS && WS_DS + (size_t)HG_UNITS * 4096 * 4 <= WS_ST && WS_ST + (size_t)HG_UNITS * 4096 * 2 <= WS_DEC && WS_DEC + (size_t)HG_UNITS * 64 * 4 <= WS_RSQ && WS_RSQ + (size_t)MMAIN * 64 <= WS_END, "ws map");
static_assert(WL_IN + (size_t)LDP * 1024 * 2 <= WL_OUT && WL_D2 + (size_t)1024 * FF * 2 <= WL_STRIDE, "weight map");

constexpr int TLD = 72;
constexpr int TILE_BYTES = 64 * TLD * 2;
constexpr int WAVE_LDS = 2 * TILE_BYTES + 512;
constexpr int LDS_BYTES = 155648;
constexpr int BAR_LDS_OFF = LDS_BYTES - 16;
static_assert(NWAVES * WAVE_LDS <= BAR_LDS_OFF && pg8::STAGE_BYTES <= BAR_LDS_OFF, "LDS map");

#define LDS_WAIT() asm volatile("s_waitcnt lgkmcnt(0)" ::: "memory")
__device__ __forceinline__ unsigned f2bf(float f) { unsigned u = __builtin_bit_cast(unsigned, f); return (u + 0x7fffu + ((u >> 16) & 1u)) >> 16; }
__device__ __forceinline__ unsigned pk2(float lo, float hi) { return f2bf(lo) | (f2bf(hi) << 16); }
__device__ __forceinline__ float bf2f(unsigned u) { return __builtin_bit_cast(float, u << 16); }
__device__ __forceinline__ float sigm(float z) { return __builtin_amdgcn_rcpf(1.0f + __expf(-z)); }
__device__ __forceinline__ unsigned bf1(float x) { return pg8::pk_bf16(x, 0.f) & 0xffffu; }
constexpr float L2E = 1.4426950408889634f;
__device__ __forceinline__ unsigned f2h(float f) { return pg8::pk_f16(f, 0.f) & 0xffffu; }
__device__ __forceinline__ unsigned pk2h(float lo, float hi) { return pg8::pk_f16(lo, hi); }
#define HG_GATE16(T, j0) float z2[16], a1[16], lf[16]; { float e_[16]; \
        _Pragma("unroll") for (int i = 0; i < 16; ++i) z2[i] = bf2f((T)[((j0) + i) * TLD + lane]) * L2E; \
        _Pragma("unroll") for (int i = 0; i < 16; ++i) e_[i] = __builtin_amdgcn_exp2f(-z2[i]); \
        _Pragma("unroll") for (int i = 0; i < 16; ++i) a1[i] = __builtin_amdgcn_logf(1.0f + e_[i]); \
        _Pragma("unroll") for (int i = 0; i < 16; ++i) lf[i] = __builtin_amdgcn_logf(1.0f + lb * e_[i]) - a1[i]; }
#define HG_GATE(zbits, z2, a1, lf2) const float z2 = bf2f(zbits) * L2E; const float E_ = __builtin_amdgcn_exp2f(-z2); const float a1 = __builtin_amdgcn_logf(1.0f + E_); \
        const float lf2 = (lb > 0.f ? __builtin_amdgcn_logf(1.0f + lb * E_) : 0.f) - a1;
__device__ __forceinline__ float shx(float v, int o, int lane) { return __builtin_bit_cast(float, __builtin_amdgcn_ds_bpermute((lane ^ o) << 2, __builtin_bit_cast(int, v))); }
__device__ __forceinline__ float wave_sum(float v, int lane) {
#pragma unroll
    for (int o = 1; o < 64; o <<= 1) v += shx(v, o, lane);
    return v;
}

struct Args { const float* in[21]; float* out; unsigned char* ws; int pc_lo, pc_hi; };
typedef const __attribute__((address_space(4))) Args* ArgsP;
struct InView { ArgsP ap; __device__ __forceinline__ const float* operator[](int i) const { return ap->in[i]; } };
struct Ctx {
    InView in; float* out; unsigned char* ws;
    LAS unsigned char* lds;
    int tid, lane, wave, G, gw, NGW;
};

__device__ __forceinline__ void transpose_item(const float* W, int K, int N, const float* gain, bf16* WT, int mode, bool f16, LAS float* scr, int item, int lane) {
    const int nblk = N / 32, kb = item / nblk, nb = item % nblk, k0 = 64 * kb, n0 = 32 * nb;
    f32x4 v[8];
#pragma unroll
    for (int i = 0; i < 8; ++i) v[i] = *(const f32x4*)(W + (size_t)(k0 + 8 * i + (lane >> 3)) * N + n0 + 4 * (lane & 7));
#pragma unroll
    for (int i = 0; i < 8; ++i) { const int kk = 8 * i + (lane >> 3); const float g = gain ? gain[k0 + kk] : 1.0f; LAS float* d = scr + kk * 33 + 4 * (lane & 7);
        d[0] = v[i][0] * g; d[1] = v[i][1] * g; d[2] = v[i][2] * g; d[3] = v[i][3] * g; }
    LDS_WAIT();
    const int c = lane & 7;
#pragma unroll
    for (int j = 0; j < 4; ++j) { const int nl = (lane >> 3) + 8 * j; const LAS float* s = scr + (8 * c) * 33 + nl; const int n = n0 + nl;
        const int dr = mode == 0 ? n : ((n >> 7) * 256 + (n & 127) + (mode == 2 ? 128 : 0));
        v4u o; if (f16) { o.x = pk2h(s[0 * 33], s[1 * 33]); o.y = pk2h(s[2 * 33], s[3 * 33]); o.z = pk2h(s[4 * 33], s[5 * 33]); o.w = pk2h(s[6 * 33], s[7 * 33]); }
        else { o.x = pk2(s[0 * 33], s[1 * 33]); o.y = pk2(s[2 * 33], s[3 * 33]); o.z = pk2(s[4 * 33], s[5 * 33]); o.w = pk2(s[6 * 33], s[7 * 33]); }
        *(v4u*)(WT + (size_t)dr * K + k0 + 8 * c) = o; }
    LDS_WAIT();
}
__device__ __forceinline__ void prologue(Ctx& F) {
    LAS float* scr = (LAS float*)(F.lds + F.wave * WAVE_LDS);
    constexpr int I_G = 16 * 88, I_D = 44 * 32, I_IN = 16 * 84, I_OUT = 16 * 32, I_LAYER = 6 * 1408 + I_IN + I_OUT;
    static_assert(I_G == 1408 && I_D == 1408, "items");
    for (int it = F.gw; it < DEPTH * I_LAYER; it += F.NGW) {
        const int l = it / I_LAYER; int r = it % I_LAYER;
        bf16* wl = (bf16*)(F.ws + WS_W + (size_t)l * WL_STRIDE);
        const size_t og = (size_t)l * D * FF, od = (size_t)l * FF * D;
        if (r < I_G) { transpose_item(F.in[3] + og, D, FF, F.in[2] + l * D, (bf16*)((unsigned char*)wl + WL_GU1), 1, true, scr, r, F.lane); continue; } r -= I_G;
        if (r < I_G) { transpose_item(F.in[4] + og, D, FF, F.in[2] + l * D, (bf16*)((unsigned char*)wl + WL_GU1), 2, true, scr, r, F.lane); continue; } r -= I_G;
        if (r < I_D) { transpose_item(F.in[5] + od, FF, D, nullptr, (bf16*)((unsigned char*)wl + WL_D1), 0, false, scr, r, F.lane); continue; } r -= I_D;
        if (r < I_IN) { transpose_item(F.in[7] + (size_t)l * D * INW, D, INW, F.in[6] + l * D, (bf16*)((unsigned char*)wl + WL_IN), 0, true, scr, r, F.lane); continue; } r -= I_IN;
        if (r < I_OUT) { transpose_item(F.in[8] + (size_t)l * D * D, D, D, nullptr, (bf16*)((unsigned char*)wl + WL_OUT), 0, false, scr, r, F.lane); continue; } r -= I_OUT;
        if (r < I_G) { transpose_item(F.in[17] + og, D, FF, F.in[16] + l * D, (bf16*)((unsigned char*)wl + WL_GU2), 1, true, scr, r, F.lane); continue; } r -= I_G;
        if (r < I_G) { transpose_item(F.in[18] + og, D, FF, F.in[16] + l * D, (bf16*)((unsigned char*)wl + WL_GU2), 2, true, scr, r, F.lane); continue; } r -= I_G;
        transpose_item(F.in[19] + od, FF, D, nullptr, (bf16*)((unsigned char*)wl + WL_D2), 0, false, scr, r, F.lane);
    }
    {
        bf16* xn = (bf16*)(F.ws + WS_XN); float* rsq = (float*)(F.ws + WS_RSQ); const float* x = F.in[0];
        for (int row = 2 * F.gw; row < MMAIN; row += 2 * F.NGW) {
            const f32x4* xr = (const f32x4*)(x + (size_t)row * D) + F.lane; f32x4 v[8]; float s0 = 0.f, s1 = 0.f;
#pragma unroll
            for (int j = 0; j < 8; ++j) v[j] = xr[64 * j];
#pragma unroll
            for (int j = 0; j < 4; ++j) { s0 += (v[j].x * v[j].x + v[j].y * v[j].y) + (v[j].z * v[j].z + v[j].w * v[j].w); s1 += (v[4 + j].x * v[4 + j].x + v[4 + j].y * v[4 + j].y) + (v[4 + j].z * v[4 + j].z + v[4 + j].w * v[4 + j].w); }
            s0 = wave_sum(s0, F.lane); s1 = wave_sum(s1, F.lane);
            v2u* o8 = (v2u*)(xn + (size_t)row * D) + F.lane;
#pragma unroll
            for (int j = 0; j < 8; ++j) { v2u w; w.x = pk2h(v[j].x, v[j].y); w.y = pk2h(v[j].z, v[j].w); o8[64 * j] = w; }
            if (F.lane < 32) rsq[(size_t)row * 16 + F.lane] = F.lane == 0 ? s0 : (F.lane == 16 ? s1 : 0.f);
        }
    }
    const int gt = F.gw * 64 + F.lane, NGT = F.NGW * 64;
    for (int i = gt; i < DEPTH * 128 * 128; i += NGT) { const int l = i / (128 * 128), e = i % (128 * 128);
        *(v4u*)(F.ws + WS_W + (size_t)l * WL_STRIDE + WL_IN + (size_t)INW * 1024 * 2 + (size_t)e * 16) = (v4u){0u, 0u, 0u, 0u}; }
    for (int i = gt; i < 256 * 256; i += NGT) { const int row = i >> 8, c4 = (i & 255) * 4;
        f32x4 v = (f32x4){0.f, 0.f, 0.f, 0.f}; if (row < NMETA) v = *(const f32x4*)(F.in[1] + row * D + c4);
        *(f32x4*)((float*)(F.ws + WS_HM) + row * D + c4) = v; }
}

__device__ __forceinline__ void norm_phase(Ctx& F, const float* main_src) {
    const float* hm = (const float*)(F.ws + WS_HM); bf16* xn = (bf16*)(F.ws + WS_XN);
    for (int row = F.gw; row < MMAIN + NMETA; row += F.NGW) {
        const float* src = row < MMAIN ? main_src + (size_t)row * D : hm + (size_t)(row - MMAIN) * D;
        const f32x4* xr = (const f32x4*)src + F.lane;
        f32x4 v[4]; float s = 0.f;
#pragma unroll
        for (int j = 0; j < 4; ++j) { v[j] = xr[64 * j]; s += (v[j].x * v[j].x + v[j].y * v[j].y) + (v[j].z * v[j].z + v[j].w * v[j].w); }
        const float rinv = rsqrtf(wave_sum(s, F.lane) * (1.f / D) + EPS);
        v2u* o8 = (v2u*)(xn + (size_t)row * D) + F.lane;
#pragma unroll
        for (int j = 0; j < 4; ++j) { v2u w; w.x = pg8::pk_bf16(v[j].x * rinv, v[j].y * rinv); w.y = pg8::pk_bf16(v[j].z * rinv, v[j].w * rinv); o8[64 * j] = w; }
    }
}
__device__ __forceinline__ void final_phase(Ctx& F) {
    const float* gn = F.in[20]; const unsigned short* hb = (const unsigned short*)(F.ws + WS_XN);
    f32x4 g[4];
#pragma unroll
    for (int j = 0; j < 4; ++j) g[j] = *((const f32x4*)gn + F.lane + 64 * j);
    for (int row = 4 * F.gw; row < MMAIN; row += 4 * F.NGW) {
        pg8::f16x4 h[4][4];
#pragma unroll
        for (int rr = 0; rr < 4; ++rr)
#pragma unroll
            for (int j = 0; j < 4; ++j) h[rr][j] = ((const pg8::f16x4*)(hb + (size_t)(row + rr) * D) + F.lane)[64 * j];
#pragma unroll
        for (int rr = 0; rr < 4; ++rr) { f32x4 v[4]; float s = 0.f;
#pragma unroll
            for (int j = 0; j < 4; ++j) { v[j] = (f32x4){(float)h[rr][j][0], (float)h[rr][j][1], (float)h[rr][j][2], (float)h[rr][j][3]}; s += (v[j].x * v[j].x + v[j].y * v[j].y) + (v[j].z * v[j].z + v[j].w * v[j].w); }
            const float rinv = rsqrtf(wave_sum(s, F.lane) * (1.f / D) + EPS);
            f32x4* xr = (f32x4*)(F.out + (size_t)(row + rr) * D) + F.lane;
#pragma unroll
            for (int j = 0; j < 4; ++j) xr[64 * j] = v[j] * rinv * g[j]; }
    }
}

__device__ __forceinline__ bf16x8 lds_frag(const LAS bf16* T, int tile, int kk, int r, int q) { return *(const LAS bf16x8*)(T + (16 * tile + r) * TLD + 32 * kk + 8 * q); }
__device__ __forceinline__ void wave_mma64(const LAS bf16* X, const LAS bf16* Y, f32x4 (&acc)[4][4], int r, int q) {
#pragma unroll
    for (int kk = 0; kk < 2; ++kk) {
        bf16x8 xf[4], yf[4];
#pragma unroll
        for (int i = 0; i < 4; ++i) { xf[i] = lds_frag(X, i, kk, r, q); yf[i] = lds_frag(Y, i, kk, r, q); }
#pragma unroll
        for (int it = 0; it < 4; ++it)
#pragma unroll
            for (int jt = 0; jt < 4; ++jt) acc[it][jt] = __builtin_amdgcn_mfma_f32_16x16x32_bf16(xf[it], yf[jt], acc[it][jt], 0, 0, 0);
    }
}
#define ZERO_ACC(a) do { _Pragma("unroll") for (int _i = 0; _i < 4; ++_i) _Pragma("unroll") for (int _j = 0; _j < 4; ++_j) a[_i][_j] = (f32x4){0.f, 0.f, 0.f, 0.f}; } while (0)


template <int KIND, int KSTEPS, bool AF32>
__device__ __forceinline__ void skinny_gemm(Ctx& F, const bf16* A, int lda, const bf16* Bt, int nslab, bf16* O, int ldo, float* hm, float scale) {
    constexpr int K = KSTEPS * 32 * 8, NBT = KIND == 0 ? 2 : 1;
    const int lane = F.lane, r = lane & 15, q = lane >> 4, w = F.wave, tid = F.tid;
    LAS float* part = (LAS float*)F.lds;
    LAS float* partsq = part + 8 * NBT * 256;
    for (int slab = F.gw / NWAVES; slab < nslab; slab += F.G) {
        const int brow0 = KIND == 0 ? ((slab * 16) >> 7) * 256 + ((slab * 16) & 127) : slab * 16;
        bf16x8 af[KSTEPS], bfr[NBT][KSTEPS];
#pragma unroll
        for (int t = 0; t < NBT; ++t) { const bf16* bp = Bt + (size_t)(brow0 + 128 * t + r) * K + w * (K / 8) + 8 * q;
#pragma unroll
            for (int kk = 0; kk < KSTEPS; ++kk) bfr[t][kk] = *(const bf16x8*)(bp + 32 * kk); }
        if (AF32) { const float* ap = hm + (size_t)r * D + w * (K / 8) + 8 * q; float ssq = 0.f;
#pragma unroll
            for (int kk = 0; kk < KSTEPS; ++kk) { const f32x4 x0 = *(const f32x4*)(ap + 32 * kk), x1 = *(const f32x4*)(ap + 32 * kk + 4);
                ssq += ((x0[0] * x0[0] + x0[1] * x0[1]) + (x0[2] * x0[2] + x0[3] * x0[3])) + ((x1[0] * x1[0] + x1[1] * x1[1]) + (x1[2] * x1[2] + x1[3] * x1[3]));
                v4u pk; pk.x = pk2h(x0[0], x0[1]); pk.y = pk2h(x0[2], x0[3]); pk.z = pk2h(x1[0], x1[1]); pk.w = pk2h(x1[2], x1[3]); af[kk] = __builtin_bit_cast(bf16x8, pk); }
            ssq += shx(ssq, 16, lane); ssq += shx(ssq, 32, lane);
            if (q == 0) partsq[w * 16 + r] = ssq;
        } else { const bf16* ap = A + (size_t)r * lda + w * (K / 8) + 8 * q;
#pragma unroll
            for (int kk = 0; kk < KSTEPS; ++kk) af[kk] = *(const bf16x8*)(ap + 32 * kk); }
#pragma unroll
        for (int t = 0; t < NBT; ++t) { f32x4 acc = (f32x4){0.f, 0.f, 0.f, 0.f};
#pragma unroll
            for (int kk = 0; kk < KSTEPS; ++kk) acc = AF32 ? __builtin_amdgcn_mfma_f32_16x16x32_f16(__builtin_bit_cast(pg8::f16x8, bfr[t][kk]), __builtin_bit_cast(pg8::f16x8, af[kk]), acc, 0, 0, 0)
                                                           : __builtin_amdgcn_mfma_f32_16x16x32_bf16(bfr[t][kk], af[kk], acc, 0, 0, 0);
#pragma unroll
            for (int e = 0; e < 4; ++e) part[(w * NBT + t) * 256 + (4 * q + e) * 16 + r] = acc[e]; }
        __syncthreads();
        if (tid < 256) { const int tok = tid >> 4, n = tid & 15; float s = 0.f, s2 = 0.f, sq = 0.f;
#pragma unroll
            for (int ww = 0; ww < 8; ++ww) { s += part[(ww * NBT) * 256 + n * 16 + tok]; if (KIND == 0) s2 += part[(ww * NBT + 1) * 256 + n * 16 + tok]; if (AF32) sq += partsq[ww * 16 + tok]; }
            if (AF32) { const float rinv = rsqrtf(sq * (1.0f / D) + EPS); s *= rinv; s2 *= rinv; }
            if (KIND == 0) O[(size_t)(METAROW + tok) * ldo + slab * 16 + n] = (bf16)f2bf(pg8::silu_f(s) * s2);
            else if (KIND == 1) hm[tok * D + slab * 16 + n] += scale * s;
            else O[(size_t)(METAROW + tok) * ldo + slab * 16 + n] = (bf16)f2bf(s); }
        __syncthreads();
    }
}

constexpr int RTAB_OFF = pg8::STAGE_BYTES, RTAB_UNITS = 12;
static_assert(RTAB_OFF + RTAB_UNITS * 256 * 4 <= BAR_LDS_OFF, "rinv table");
__device__ __forceinline__ void build_rinv_table(Ctx& F, const pg8::StaticOrder& S, const float* rowsq) {
    LAS float* tab = (LAS float*)(F.lds + RTAB_OFF);
    const int rl = F.tid >> 1, h = F.tid & 1;
    f32x4 a[RTAB_UNITS], b[RTAB_UNITS]; bool ok[RTAB_UNITS];
#pragma unroll
    for (int i = 0; i < RTAB_UNITS; ++i) { pg8::Unit u; ok[i] = S.next(i, u);
        if (ok[i]) { const f32x4* rp = (const f32x4*)(rowsq + (size_t)(u.pm * 256 + rl) * 16 + h * 8); a[i] = rp[0]; b[i] = rp[1]; } }
#pragma unroll
    for (int i = 0; i < RTAB_UNITS; ++i) if (ok[i]) { float s = ((a[i][0] + a[i][1]) + (a[i][2] + a[i][3])) + ((b[i][0] + b[i][1]) + (b[i][2] + b[i][3]));
        s += shx(s, 1, F.lane);
        if (h == 0) tab[i * 256 + rl] = rsqrtf(s * (1.0f / D) + EPS); }
    __syncthreads();
}

__device__ __forceinline__ float lb_of(const float* lg, int l, int ch) {
    const float x0 = lg[ch], x1 = lg[384 + ch], x2 = lg[768 + ch], x3 = lg[1152 + ch];
    const float m = fmaxf(fmaxf(x0, x1), fmaxf(x2, x3));
    const float e0 = __expf(x0 - m), e1 = __expf(x1 - m), e2 = __expf(x2 - m), e3 = __expf(x3 - m);
    float c = 0.f; if (l >= 1) c += e1; if (l >= 2) c += e2; if (l >= 3) c += e3;
    return c / (e0 + e1 + e2 + e3);
}
__device__ __forceinline__ int hg_row(int b, int c, int j) { return c == 0 ? (j < 48 ? -1 : METAROW + j - 48) : b * SEQ + (c - 1) * 64 + j; }

#define HG_LOAD_TILE(dst, col0) do { _Pragma("unroll") for (int _i = 0; _i < 8; ++_i) { const int _row = hg_row(b, c, (lane >> 3) + 8 * _i); \
        dst[_i] = *(const v4u*)(P + (size_t)(_row >= 0 ? _row : METAROW) * LDP + (col0) + hd * 64 + 8 * (lane & 7)); if (_row < 0) dst[_i] = (v4u){0u, 0u, 0u, 0u}; } } while (0)
#define HG_STORE_TILE(T, src) do { _Pragma("unroll") for (int _i = 0; _i < 8; ++_i) *(LAS v4u*)((T) + ((lane >> 3) + 8 * _i) * TLD + 8 * (lane & 7)) = src[_i]; } while (0)
#define HG_STORE_TILE_T(T, src) do { _Pragma("unroll") for (int _i = 0; _i < 8; ++_i) { const int _t = (lane >> 3) + 8 * _i; LAS bf16* _d = (T) + (8 * (lane & 7)) * TLD + _t; \
        _d[0 * TLD] = (bf16)(src[_i].x & 0xffffu); _d[1 * TLD] = (bf16)(src[_i].x >> 16); _d[2 * TLD] = (bf16)(src[_i].y & 0xffffu); _d[3 * TLD] = (bf16)(src[_i].y >> 16); \
        _d[4 * TLD] = (bf16)(src[_i].z & 0xffffu); _d[5 * TLD] = (bf16)(src[_i].z >> 16); _d[6 * TLD] = (bf16)(src[_i].w & 0xffffu); _d[7 * TLD] = (bf16)(src[_i].w >> 16); } } while (0)

__device__ __forceinline__ void hgrn_p1_unit(Ctx& F, int l, int unit) {
    const int lane = F.lane, r = lane & 15, q = lane >> 4;
    const int bh = unit / HG_NC, c = unit % HG_NC, b = bh / 6, hd = bh % 6, ch = hd * 64 + lane;
    const bf16* P = (const bf16*)(F.ws + WS_ACT);
    LAS bf16* T0 = (LAS bf16*)(F.lds + F.wave * WAVE_LDS); LAS bf16* T1 = T0 + 64 * TLD;
    v4u zraw[8], vraw[8];
    HG_LOAD_TILE(zraw, P_AF); HG_LOAD_TILE(vraw, P_AI);
    const float lb = lb_of(F.in[9], l, ch), oml = 1.0f - lb;
    HG_STORE_TILE(T1, zraw);
    LDS_WAIT();
    const int jlo = c == 0 ? 48 : 0;
    const float lom2 = __builtin_amdgcn_logf(oml);
    float G = 0.f;
    for (int j0 = jlo; j0 < 64; j0 += 16) { HG_GATE16(T1, j0);
#pragma unroll
        for (int i = 0; i < 16; ++i) G += lf[i]; }
    const float Glast = G; G = 0.f;
    for (int j = 0; j < jlo; j += 8) *(LAS v4u*)(T0 + lane * TLD + j) = (v4u){0u, 0u, 0u, 0u};
    for (int j0 = jlo; j0 < 64; j0 += 16) { HG_GATE16(T1, j0); float kx[16];
#pragma unroll
        for (int i = 0; i < 16; ++i) { G += lf[i]; kx[i] = (lom2 - z2[i] - a1[i]) + (Glast - G); }
#pragma unroll
        for (int i = 0; i < 16; ++i) kx[i] = __builtin_amdgcn_exp2f(kx[i]);
        v4u w0, w1;
        w0.x = pg8::pk_bf16(kx[0], kx[1]); w0.y = pg8::pk_bf16(kx[2], kx[3]); w0.z = pg8::pk_bf16(kx[4], kx[5]); w0.w = pg8::pk_bf16(kx[6], kx[7]);
        w1.x = pg8::pk_bf16(kx[8], kx[9]); w1.y = pg8::pk_bf16(kx[10], kx[11]); w1.z = pg8::pk_bf16(kx[12], kx[13]); w1.w = pg8::pk_bf16(kx[14], kx[15]);
        *(LAS v4u*)(T0 + lane * TLD + j0) = w0; *(LAS v4u*)(T0 + lane * TLD + j0 + 8) = w1; }
    ((float*)(F.ws + WS_DEC))[(size_t)unit * 64 + lane] = __builtin_amdgcn_exp2f(Glast);
    LDS_WAIT();
    HG_STORE_TILE_T(T1, vraw);
    LDS_WAIT();
    f32x4 acc[4][4]; ZERO_ACC(acc);
    wave_mma64(T1, T0, acc, r, q);
    float* ds = (float*)(F.ws + WS_DS) + (size_t)unit * 4096;
#pragma unroll
    for (int it = 0; it < 4; ++it)
#pragma unroll
        for (int jt = 0; jt < 4; ++jt)
#pragma unroll
            for (int e = 0; e < 4; ++e) ds[(16 * it + 4 * q + e) * 64 + 16 * jt + r] = acc[it][jt][e];
    LDS_WAIT();
}
__device__ __forceinline__ void hgrn_scan(Ctx& F) {
    typedef float f32x2v __attribute__((ext_vector_type(2)));
    const float* __restrict__ ds = (const float*)(F.ws + WS_DS); const float* __restrict__ dec = (const float*)(F.ws + WS_DEC); bf16* __restrict__ st = (bf16*)(F.ws + WS_ST);
    const int gt = F.gw * 64 + F.lane, NGT = F.NGW * 64;
    for (int idx = gt; idx < NB * 6 * 2048; idx += NGT) {
        const int bh = idx >> 11, e = (idx & 2047) * 2, dk = e & 63; float r0 = 0.f, r1 = 0.f;
        const size_t u0 = (size_t)bh * HG_NC;
#pragma unroll
        for (int c0 = 0; c0 < HG_NC; c0 += 33) {
            f32x2v d[33], x[33];
#pragma unroll
            for (int j = 0; j < 33; ++j) if (c0 + j < HG_NC) { d[j] = *(const f32x2v*)(dec + (u0 + c0 + j) * 64 + dk); x[j] = *(const f32x2v*)(ds + (u0 + c0 + j) * 4096 + e); }
#pragma unroll
            for (int j = 0; j < 33; ++j) if (c0 + j < HG_NC) { *(unsigned*)(st + (u0 + c0 + j) * 4096 + e) = pk2(r0, r1); r0 = r0 * d[j].x + x[j].x; r1 = r1 * d[j].y + x[j].y; }
        }
    }
}
__device__ __forceinline__ void hgrn_p3_unit(Ctx& F, int l, int unit) {
    const int lane = F.lane, r = lane & 15, q = lane >> 4;
    const int bh = unit / HG_NC, c = unit % HG_NC, b = bh / 6, hd = bh % 6, ch = hd * 64 + lane;
    if (c == 0 && b > 0) return;
    const bf16* P = (const bf16*)(F.ws + WS_ACT); bf16* Y = (bf16*)F.out;
    LAS bf16* T0 = (LAS bf16*)(F.lds + F.wave * WAVE_LDS); LAS bf16* T1 = T0 + 64 * TLD; LAS float* EG = (LAS float*)(T1 + 64 * TLD);
    {
        v4u zraw[8], qraw[8];
        HG_LOAD_TILE(zraw, P_AF); HG_LOAD_TILE(qraw, P_AQ);
        HG_STORE_TILE(T1, zraw); HG_STORE_TILE(T0, qraw);
    }
    const float lb = lb_of(F.in[9], l, ch), oml = 1.0f - lb;
    LDS_WAIT();
    const int jlo = c == 0 ? 48 : 0;
    const float lom2 = __builtin_amdgcn_logf(oml);
    float G = 0.f;
    for (int j0 = jlo; j0 < 32; j0 += 16) { HG_GATE16(T1, j0);
#pragma unroll
        for (int i = 0; i < 16; ++i) G += lf[i]; }
    const float Gm = G; G = 0.f;
    for (int j0 = jlo; j0 < 64; j0 += 16) { HG_GATE16(T1, j0); float qx[16], kx[16], qv[16];
#pragma unroll
        for (int i = 0; i < 16; ++i) qv[i] = bf2f(T0[(j0 + i) * TLD + lane]);
#pragma unroll
        for (int i = 0; i < 16; ++i) { G += lf[i]; qx[i] = G - Gm; kx[i] = (lom2 - z2[i] - a1[i]) + (Gm - G); }
#pragma unroll
        for (int i = 0; i < 16; ++i) { qx[i] = __builtin_amdgcn_exp2f(qx[i]); kx[i] = __builtin_amdgcn_exp2f(kx[i]); }
#pragma unroll
        for (int i = 0; i < 16; ++i) { T0[(j0 + i) * TLD + lane] = (bf16)bf1(qv[i] * qx[i]); T1[(j0 + i) * TLD + lane] = (bf16)bf1(kx[i]); } }
    EG[lane] = __builtin_amdgcn_exp2f(Gm);
    LDS_WAIT();
    f32x4 accA[4][4], accO[4][4]; ZERO_ACC(accA); ZERO_ACC(accO);
    wave_mma64(T1, T0, accA, r, q);
    {
        const bf16* st = (const bf16*)(F.ws + WS_ST) + (size_t)unit * 4096;
#pragma unroll
        for (int kk = 0; kk < 2; ++kk) {
            bf16x8 yf[4]; float eg[8]; v4u raw[4];
#pragma unroll
            for (int it = 0; it < 4; ++it) raw[it] = *(const v4u*)(st + (16 * it + r) * 64 + 32 * kk + 8 * q);
#pragma unroll
            for (int i = 0; i < 4; ++i) yf[i] = lds_frag(T0, i, kk, r, q);
#pragma unroll
            for (int j = 0; j < 8; ++j) eg[j] = EG[32 * kk + 8 * q + j];
#pragma unroll
            for (int it = 0; it < 4; ++it) {
                v4u sc;
                sc.x = pk2(bf2f(raw[it].x & 0xffffu) * eg[0], bf2f(raw[it].x >> 16) * eg[1]); sc.y = pk2(bf2f(raw[it].y & 0xffffu) * eg[2], bf2f(raw[it].y >> 16) * eg[3]);
                sc.z = pk2(bf2f(raw[it].z & 0xffffu) * eg[4], bf2f(raw[it].z >> 16) * eg[5]); sc.w = pk2(bf2f(raw[it].w & 0xffffu) * eg[6], bf2f(raw[it].w >> 16) * eg[7]);
                const bf16x8 xf = __builtin_bit_cast(bf16x8, sc);
#pragma unroll
                for (int jt = 0; jt < 4; ++jt) accO[it][jt] = __builtin_amdgcn_mfma_f32_16x16x32_bf16(xf, yf[jt], accO[it][jt], 0, 0, 0);
            }
        }
    }
    v4u vraw[8];
    HG_LOAD_TILE(vraw, P_AI);
    LDS_WAIT();
#pragma unroll
    for (int it = 0; it < 4; ++it)
#pragma unroll
        for (int jt = 0; jt < 4; ++jt) { const int t = 16 * jt + r, s0 = 16 * it + 4 * q; const f32x4 a = accA[it][jt];
            v2u w; w.x = pk2(s0 + 0 <= t ? a[0] : 0.f, s0 + 1 <= t ? a[1] : 0.f); w.y = pk2(s0 + 2 <= t ? a[2] : 0.f, s0 + 3 <= t ? a[3] : 0.f);
            *(LAS v2u*)(T0 + t * TLD + s0) = w; }
    HG_STORE_TILE_T(T1, vraw);
    LDS_WAIT();
    wave_mma64(T1, T0, accO, r, q);
    const float* og = F.in[10] + l * 64;
    v2u graw[4][4]; f32x4 gn[4];
#pragma unroll
    for (int it = 0; it < 4; ++it) gn[it] = *(const f32x4*)(og + 16 * it + 4 * q);
#pragma unroll
    for (int jt = 0; jt < 4; ++jt) { const int row = hg_row(b, c, 16 * jt + r);
#pragma unroll
        for (int it = 0; it < 4; ++it) graw[jt][it] = *(const v2u*)(P + (size_t)(row >= 0 ? row : METAROW) * LDP + P_AG + hd * 64 + 16 * it + 4 * q); }
#pragma unroll
    for (int jt = 0; jt < 4; ++jt) {
        const int t = 16 * jt + r, row = hg_row(b, c, t);
        float ss = 0.f;
#pragma unroll
        for (int it = 0; it < 4; ++it) { const f32x4 o = accO[it][jt]; ss += (o[0] * o[0] + o[1] * o[1]) + (o[2] * o[2] + o[3] * o[3]); }
        ss += shx(ss, 16, lane); ss += shx(ss, 32, lane);
        const float rinv = rsqrtf(ss * (1.0f / 64.0f) + EPS);
        if (row >= 0) {
#pragma unroll
            for (int it = 0; it < 4; ++it) { const int dv0 = 16 * it + 4 * q; const f32x4 o = accO[it][jt]; const v2u gr = graw[jt][it];
                const float g0 = bf2f(gr.x & 0xffffu), g1 = bf2f(gr.x >> 16), g2 = bf2f(gr.y & 0xffffu), g3 = bf2f(gr.y >> 16);
                v2u w; w.x = pg8::pk_bf16(o[0] * rinv * gn[it][0] * pg8::silu_f(g0), o[1] * rinv * gn[it][1] * pg8::silu_f(g1)); w.y = pg8::pk_bf16(o[2] * rinv * gn[it][2] * pg8::silu_f(g2), o[3] * rinv * gn[it][3] * pg8::silu_f(g3));
                *(v2u*)(Y + (size_t)row * D + hd * 64 + dv0) = w; }
        }
    }
    LDS_WAIT();
}

struct AtTile { bf16x8 kf[2][2]; bf16x8 vf[4]; };
__device__ __forceinline__ void attn_load(AtTile& T, const bf16* P, int krow_a, int krow_b, int kcol, int vcol, int r, int q) {
#pragma unroll
    for (int kk = 0; kk < 2; ++kk) { T.kf[0][kk] = *(const bf16x8*)(P + (size_t)(krow_a + r) * LDP + kcol + 32 * kk + 8 * q); T.kf[1][kk] = *(const bf16x8*)(P + (size_t)(krow_b + r) * LDP + kcol + 32 * kk + 8 * q); }
#pragma unroll
    for (int it = 0; it < 4; ++it) { const bf16* va = P + (size_t)(krow_a + 4 * q) * LDP + vcol + 16 * it + r; const bf16* vb = P + (size_t)(krow_b + 4 * q) * LDP + vcol + 16 * it + r;
#pragma unroll
        for (int j = 0; j < 4; ++j) { T.vf[it][j] = (short)va[(size_t)j * LDP]; T.vf[it][4 + j] = (short)vb[(size_t)j * LDP]; } }
}
constexpr float ATT_C2 = 0.125f * 1.4426950408889634f, ATT_THR = 11.5f;
__device__ __forceinline__ void attn_compute(const AtTile& T, const bf16x8 (&qf)[2][2], f32x4 (&accO)[4][2], float (&mrow)[2], float (&lrow)[2], int mode, int dpos, int r, int q) {
    const int lane = 16 * q + r;
    f32x4 s[2][2];
#pragma unroll
    for (int it = 0; it < 2; ++it)
#pragma unroll
        for (int jt = 0; jt < 2; ++jt) { s[it][jt] = (f32x4){0.f, 0.f, 0.f, 0.f};
#pragma unroll
            for (int kk = 0; kk < 2; ++kk) s[it][jt] = __builtin_amdgcn_mfma_f32_16x16x32_bf16(T.kf[it][kk], qf[jt][kk], s[it][jt], 0, 0, 0); }
    const float NEG = -INFINITY;
#pragma unroll
    for (int it = 0; it < 2; ++it)
#pragma unroll
        for (int jt = 0; jt < 2; ++jt) s[it][jt] = s[it][jt] * ATT_C2;
    if (mode != 0 || dpos < 32 || dpos > 96) {
#pragma unroll
        for (int jt = 0; jt < 2; ++jt)
#pragma unroll
            for (int it = 0; it < 2; ++it)
#pragma unroll
                for (int e = 0; e < 4; ++e) { const int key = 16 * it + 4 * q + e, t = 16 * jt + r; bool valid;
                    if (mode == 0) { const int dd = dpos + t - key; valid = dd >= 0 && dd < 128; } else if (mode == 1) valid = key < 16; else valid = key <= t && key < 16;
                    if (!valid) s[it][jt][e] = NEG; }
    }
    float mx[2];
#pragma unroll
    for (int jt = 0; jt < 2; ++jt) { float m = fmaxf(fmaxf(fmaxf(s[0][jt][0], s[0][jt][1]), fmaxf(s[0][jt][2], s[0][jt][3])), fmaxf(fmaxf(s[1][jt][0], s[1][jt][1]), fmaxf(s[1][jt][2], s[1][jt][3])));
        m = fmaxf(m, shx(m, 16, lane)); mx[jt] = fmaxf(m, shx(m, 32, lane)); }
    if (__builtin_amdgcn_ballot_w64(mx[0] > mrow[0] + ATT_THR || mx[1] > mrow[1] + ATT_THR) != 0ull) {
#pragma unroll
        for (int jt = 0; jt < 2; ++jt) { const float mn = fmaxf(mrow[jt], mx[jt]), alpha = __builtin_amdgcn_exp2f(mrow[jt] - mn); mrow[jt] = mn; lrow[jt] *= alpha;
#pragma unroll
            for (int it = 0; it < 4; ++it) accO[it][jt] = accO[it][jt] * alpha; }
    }
    bf16x8 pf[2];
#pragma unroll
    for (int jt = 0; jt < 2; ++jt) { const float mn = mrow[jt]; float ps = 0.f;
#pragma unroll
        for (int it = 0; it < 2; ++it)
#pragma unroll
            for (int e = 0; e < 4; ++e) { const float pe = __builtin_amdgcn_exp2f(s[it][jt][e] - mn); s[it][jt][e] = pe; ps += pe; }
        ps += shx(ps, 16, lane); ps += shx(ps, 32, lane);
        lrow[jt] += ps;
        v4u w; w.x = pg8::pk_bf16(s[0][jt][0], s[0][jt][1]); w.y = pg8::pk_bf16(s[0][jt][2], s[0][jt][3]); w.z = pg8::pk_bf16(s[1][jt][0], s[1][jt][1]); w.w = pg8::pk_bf16(s[1][jt][2], s[1][jt][3]);
        pf[jt] = __builtin_bit_cast(bf16x8, w);
    }
#pragma unroll
    for (int it = 0; it < 4; ++it)
#pragma unroll
        for (int jt = 0; jt < 2; ++jt) accO[it][jt] = __builtin_amdgcn_mfma_f32_16x16x32_bf16(T.vf[it], pf[jt], accO[it][jt], 0, 0, 0);
}
__device__ __forceinline__ void attn_unit(Ctx& F, int l, int unit) {
    const int lane = F.lane, r = lane & 15, q = lane >> 4;
    const bf16* P = (const bf16*)(F.ws + WS_ACT); bf16* Y = (bf16*)F.out;
    const bool is_meta = unit >= NB * 6 * 128;
    int b = 0, hq, t0 = 0;
    if (is_meta) hq = unit - NB * 6 * 128; else { b = unit / 768; const int rem = unit % 768; hq = rem >> 7; t0 = (rem & 127) * 32; }
    const int kvh = hq / 3; const float sink = F.in[11][l * 6 + hq];
    const int qrow0 = is_meta ? METAROW : b * SEQ + t0;
    const int kcol = P_BK + kvh * 64, vcol = P_BV + kvh * 64;
    int first = is_meta ? 5 : (t0 >= 128 ? 0 : (128 - t0) / 32);
    AtTile cur, nxt;
    if (first < 5) attn_load(cur, P, b * SEQ + t0 - 128 + 32 * first, b * SEQ + t0 - 128 + 32 * first + 16, kcol, vcol, r, q); else attn_load(cur, P, METAROW, METAROW, kcol, vcol, r, q);
    bf16x8 qf[2][2];
#pragma unroll
    for (int jt = 0; jt < 2; ++jt)
#pragma unroll
        for (int kk = 0; kk < 2; ++kk) qf[jt][kk] = *(const bf16x8*)(P + (size_t)(qrow0 + 16 * jt + r) * LDP + P_BQ + hq * 64 + 32 * kk + 8 * q);
    f32x4 accO[4][2];
#pragma unroll
    for (int it = 0; it < 4; ++it) { accO[it][0] = (f32x4){0.f, 0.f, 0.f, 0.f}; accO[it][1] = (f32x4){0.f, 0.f, 0.f, 0.f}; }
    float mrow[2], lrow[2];
#pragma unroll
    for (int jt = 0; jt < 2; ++jt) { mrow[jt] = sink * L2E; lrow[jt] = 1.0f; }
    for (int idx = first; idx < 6; ++idx) {
        if (idx < 4) attn_load(nxt, P, b * SEQ + t0 - 96 + 32 * idx, b * SEQ + t0 - 96 + 32 * idx + 16, kcol, vcol, r, q); else if (idx == 4) attn_load(nxt, P, METAROW, METAROW, kcol, vcol, r, q);
        attn_compute(cur, qf, accO, mrow, lrow, idx < 5 ? 0 : (is_meta ? 2 : 1), 128 - 32 * idx, r, q);
        cur = nxt;
    }
#pragma unroll
    for (int jt = 0; jt < 2; ++jt) {
        if (is_meta && jt > 0) continue;
        const float inv = 1.0f / lrow[jt]; const size_t row = (size_t)(qrow0 + 16 * jt + r);
#pragma unroll
        for (int it = 0; it < 4; ++it) { const f32x4 o = accO[it][jt]; v2u w; w.x = pg8::pk_bf16(o[0] * inv, o[1] * inv); w.y = pg8::pk_bf16(o[2] * inv, o[3] * inv);
            *(v2u*)(Y + row * D + 384 + hq * 64 + 16 * it + 4 * q) = w; }
    }
}

__device__ __forceinline__ void conv_phase(Ctx& F, int l) {
    const bf16* P = (const bf16*)(F.ws + WS_ACT); bf16* Y = (bf16*)F.out;
    LAS float* GL = (LAS float*)F.lds;
    LAS float* OT = GL + 64 * 256;
    const int tid = F.tid, lane = F.lane, wave = F.wave, ch = tid & 255, half = tid >> 8;
    float wt[31];
#pragma unroll
    for (int w = 0; w < 31; ++w) wt[w] = F.in[12][(size_t)(l * 31 + w) * 256 + ch];
    const float bias = F.in[13][l * 256 + ch];
    const f32x4 lg4 = *(const f32x4*)(F.in[14] + l * 256 + 4 * lane), lb4 = *(const f32x4*)(F.in[15] + l * 256 + 4 * lane);
    const int bidc = F.gw / NWAVES;
    for (int uu = bidc; uu < CV_UNITS - 1 + F.G; uu += F.G) {
        int u = uu; if (uu >= CV_UNITS - 1) { if (bidc != F.G - 1) break; u = CV_UNITS - 1; }
        const bool is_meta = (u == CV_UNITS - 1); const int b = is_meta ? 0 : (u >> 7), t0 = is_meta ? 0 : (u & 127) * 32;
        v2u araw[8], graw[8];
#pragma unroll
        for (int ii = 0; ii < 8; ++ii) { const int i = wave + 8 * ii; int row;
            if (is_meta) { const int pos = i - 30; row = (pos >= 0 && pos < NMETA) ? METAROW + pos : -1; }
            else { const int idx = t0 - 30 + i; row = idx >= 0 ? b * SEQ + idx : (idx >= -NMETA ? METAROW + idx + NMETA : -1); }
            const size_t ro = (size_t)(row >= 0 ? row : METAROW) * LDP + P_CU + 4 * lane;
            araw[ii] = *(const v2u*)(P + ro); graw[ii] = *(const v2u*)(P + ro + 256);
            if (row < 0) araw[ii] = (v2u){0u, 0u}; }
#pragma unroll
        for (int ii = 0; ii < 8; ++ii) { const int i = wave + 8 * ii; const v2u a = araw[ii], g = graw[ii]; f32x4 gl;
            gl[0] = bf2f(a.x & 0xffffu) * sigm(bf2f(g.x & 0xffffu)); gl[1] = bf2f(a.x >> 16) * sigm(bf2f(g.x >> 16));
            gl[2] = bf2f(a.y & 0xffffu) * sigm(bf2f(g.y & 0xffffu)); gl[3] = bf2f(a.y >> 16) * sigm(bf2f(g.y >> 16));
            *(LAS f32x4*)(GL + i * 256 + 4 * lane) = gl; }
        __syncthreads();
        float gw_[46], o[16];
#pragma unroll
        for (int i = 0; i < 46; ++i) gw_[i] = GL[(half * 16 + i) * 256 + ch];
#pragma unroll
        for (int jj = 0; jj < 16; ++jj) { float a = bias;
#pragma unroll
            for (int w = 0; w < 31; ++w) a += gw_[jj + w] * wt[w];
            o[jj] = a; }
#pragma unroll
        for (int jj = 0; jj < 16; ++jj) OT[(half * 16 + jj) * 256 + ch] = o[jj];
        __syncthreads();
#pragma unroll
        for (int k = 0; k < 4; ++k) { const int tok = 4 * wave + k; const f32x4 v = *(const LAS f32x4*)(OT + tok * 256 + 4 * lane);
            const float s1 = wave_sum((v[0] + v[1]) + (v[2] + v[3]), lane), s2 = wave_sum((v[0] * v[0] + v[1] * v[1]) + (v[2] * v[2] + v[3] * v[3]), lane);
            const float mean = s1 * (1.0f / 256.0f), var = fmaxf(s2 * (1.0f / 256.0f) - mean * mean, 0.f), rstd = rsqrtf(var + EPS);
            int row; if (is_meta) row = tok < NMETA ? METAROW + tok : -1; else row = b * SEQ + t0 + tok;
            if (row >= 0) { v2u w; w.x = pg8::pk_bf16(pg8::silu_f((v[0] - mean) * rstd * lg4[0] + lb4[0]), pg8::silu_f((v[1] - mean) * rstd * lg4[1] + lb4[1]));
                w.y = pg8::pk_bf16(pg8::silu_f((v[2] - mean) * rstd * lg4[2] + lb4[2]), pg8::silu_f((v[3] - mean) * rstd * lg4[3] + lb4[3]));
                *(v2u*)(Y + (size_t)row * D + 768 + 4 * lane) = w; } }
    }
    __syncthreads();
}

#define XB_TMO      128
#define XB_XCNT(j)  (256  + 64 * (j))
#define XB_XSUB(j)  (1280 + 64 * (j))
#define XB_XGEN(j)  (2304 + 64 * (j))
#define XB_TOP      3328
#define XB_TOPGEN   3392
#define XCD_BAR_WORDS 3456
#define XB_SPIN_CAP (1u << 18)

__device__ __forceinline__ unsigned xb_ld(unsigned* p)              { return __hip_atomic_load(p, __ATOMIC_RELAXED, __HIP_MEMORY_SCOPE_AGENT); }
__device__ __forceinline__ unsigned xb_add(unsigned* p, unsigned v) { return __hip_atomic_fetch_add(p, v, __ATOMIC_RELAXED, __HIP_MEMORY_SCOPE_AGENT); }
__device__ __forceinline__ unsigned xb_xcc_id() { return (unsigned)__builtin_amdgcn_s_getreg((3 << 11) | 20) & 0xFu; }
#define XB_SPIN(cond, bar) do { unsigned _sp = 0; while (cond) { __builtin_amdgcn_s_sleep(1); \
    if ((++_sp & 255u) == 0u) { if (xb_ld(&(bar)[XB_TMO])) break; if (_sp > XB_SPIN_CAP) { atomicAdd(&(bar)[XB_TMO], 1u); break; } } } } while (0)

struct XcdBarrier {
    unsigned* bar; unsigned x;
    volatile LAS unsigned* st;
};

__device__ __forceinline__ XcdBarrier xcd_barrier_post(unsigned* bar, volatile LAS unsigned* st, int tid) {
    XcdBarrier b; b.bar = bar; b.x = xb_xcc_id(); b.st = st;
    if (tid == 0) (void)xb_add(&bar[XB_XCNT(b.x)], 1u);
    return b;
}
__device__ __forceinline__ void xcd_barrier_complete(unsigned* bar, unsigned x, unsigned& nloc, unsigned& nx) {
    const unsigned G = gridDim.x * gridDim.y * gridDim.z;
    unsigned sum, cnt, mine, sp = 0u;
    for (;;) {
        sum = 0u; cnt = 0u; mine = 0u;
#pragma unroll
        for (unsigned j = 0; j < 16; ++j) { const unsigned c = xb_ld(&bar[XB_XCNT(j)]); sum += c; cnt += (c > 0u) ? 1u : 0u; mine = (j == x) ? c : mine; }
        if (sum == G) break;
        __builtin_amdgcn_s_sleep(1);
        if ((++sp & 255u) == 0u) { if (xb_ld(&bar[XB_TMO])) break; if (sp > XB_SPIN_CAP) { atomicAdd(&bar[XB_TMO], 1u); break; } }
    }
    nloc = mine > 0u ? mine : 1u; nx = cnt > 0u ? cnt : 1u;
}

__device__ __forceinline__ void xcd_barrier(const XcdBarrier& b, int tid) {
    asm volatile("s_waitcnt vmcnt(0)" ::: "memory");
    __syncthreads();
    if (tid == 0) {
        unsigned* bar = b.bar;
        __builtin_amdgcn_s_waitcnt(0);
        unsigned nloc = b.st[0], nx = b.st[1];
        if (nloc == 0u) { xcd_barrier_complete(bar, b.x, nloc, nx); b.st[0] = nloc; b.st[1] = nx; }
        const unsigned old = xb_add(&bar[XB_XSUB(b.x)], 1u);
        const unsigned gen = old / nloc;
        if (old + 1u == (gen + 1u) * nloc) {
            __builtin_amdgcn_fence(__ATOMIC_RELEASE, "agent");
            asm volatile("s_waitcnt vmcnt(0)" ::: "memory");
            const unsigned og = xb_add(&bar[XB_TOP], 1u);
            const unsigned tg = og / nx;
            if (og + 1u == (tg + 1u) * nx) xb_add(&bar[XB_TOPGEN], 1u);
            else XB_SPIN(xb_ld(&bar[XB_TOPGEN]) == tg, bar);
            __builtin_amdgcn_fence(__ATOMIC_ACQUIRE, "agent");
            xb_add(&bar[XB_XGEN(b.x)], 1u);
            asm volatile("s_waitcnt vmcnt(0)" ::: "memory");
        } else {
            XB_SPIN(xb_ld(&bar[XB_XGEN(b.x)]) == gen, bar);
            __builtin_amdgcn_fence(__ATOMIC_ACQUIRE, "agent");
            asm volatile("s_waitcnt vmcnt(0)" ::: "memory");
        }
    }
    __syncthreads();
}

constexpr int N_PC = 2 + 9 * DEPTH;
#ifndef PHMASK
#define PHMASK 0xffff
#endif
#define PHON(k) ((PHMASK >> (k)) & 1)
__global__ void __launch_bounds__(NTHREADS, 2) fwd_kernel(Args args) {
    extern __shared__ __attribute__((aligned(16))) unsigned char lds_raw[];
    volatile LAS unsigned* bst = (volatile LAS unsigned*)((LAS unsigned char*)lds_raw + BAR_LDS_OFF);
    if (threadIdx.x == 0) { bst[0] = 0u; bst[1] = 0u; }
    __syncthreads();
    XcdBarrier gbar = xcd_barrier_post((unsigned*)(args.ws + WS_CTL), bst, (int)threadIdx.x);
    const int wave_s = __builtin_amdgcn_readfirstlane((int)threadIdx.x >> 6);
    for (int pc = args.pc_lo; pc < args.pc_hi; ++pc) {
        int lane_; asm volatile("v_mbcnt_lo_u32_b32 %0, -1, 0\n\tv_mbcnt_hi_u32_b32 %0, -1, %0" : "=v"(lane_));
        int tid_ = wave_s * 64 + lane_, pcv = pc, bid_ = blockIdx.x, grd_ = gridDim.x; asm volatile("" : "+v"(tid_)); asm volatile("" : "+s"(pcv), "+s"(bid_), "+s"(grd_));
        Ctx F;
        ArgsP ap = (ArgsP)__builtin_amdgcn_kernarg_segment_ptr(); asm volatile("" : "+s"(ap));
        F.in.ap = ap; F.out = ap->out; F.ws = ap->ws; F.lds = (LAS unsigned char*)lds_raw;
        F.tid = tid_; F.lane = F.tid & 63; F.wave = __builtin_amdgcn_readfirstlane(F.tid >> 6); F.G = grd_;
        F.gw = bid_ * NWAVES + F.wave; F.NGW = F.G * NWAVES;
        bf16* HB = (bf16*)(F.ws + WS_XN); bf16* YB = (bf16*)F.out; bf16* ACT = (bf16*)(F.ws + WS_ACT); float* HM = (float*)(F.ws + WS_HM); float* RSQ = (float*)(F.ws + WS_RSQ);
        const int l = pcv == 0 ? 0 : (pcv - 1) / 9, s = pcv == 0 ? -1 : (pcv == N_PC - 1 ? 9 : (pcv - 1) % 9);
        const unsigned char* wl = F.ws + WS_W + (size_t)l * WL_STRIDE;
        if (s == -1) { if (PHON(0)) prologue(F); }
        else if (s == 0 || s == 7) {
            const bf16* wgu = (const bf16*)(wl + (s == 0 ? WL_GU1 : WL_GU2));
            if (PHON(2)) skinny_gemm<0, 4, true>(F, nullptr, 0, wgu, FF / 16, ACT, FF, HM, 0.f);
            pg8::Gemm g{HB, wgu, MMAIN, 2 * FF, D}; pg8::StaticOrder S; S.init(MMAIN, 2 * FF, F.G, bid_);
            if (PHON(2)) build_rinv_table(F, S, RSQ);
            pg8::EpiSwiGLU E{ACT, FF, (const LAS float*)(F.lds + RTAB_OFF)};
            if (PHON(2)) pg8::gemm_phase<pg8::EpiSwiGLU, pg8::StaticOrder, true, true, true>(F.lds, g, S, E, F.tid);
        } else if (s == 1 || s == 6 || s == 8) {
            const bool isout = (s == 6);
            const bf16* wd = (const bf16*)(wl + (s == 1 ? WL_D1 : (s == 6 ? WL_OUT : WL_D2)));
            if (PHON(3)) { if (isout) skinny_gemm<1, 4, false>(F, YB + (size_t)METAROW * D, D, wd, D / 16, nullptr, 0, HM, 1.0f); else skinny_gemm<1, 11, false>(F, ACT + (size_t)METAROW * FF, FF, wd, D / 16, nullptr, 0, HM, 0.5f); }
            pg8::Gemm g{isout ? YB : ACT, wd, MMAIN, D, isout ? D : FF}; pg8::StaticOrder S; S.init(MMAIN, D, F.G, bid_);
            pg8::EpiResid E{(l == 0 && s == 1) ? F.in[0] : nullptr, HB, RSQ, isout ? 1.0f : 0.5f};
            if (PHON(3)) pg8::gemm_phase<pg8::EpiResid, pg8::StaticOrder, true, true, false>(F.lds, g, S, E, F.tid);
        } else if (s == 2) {
            if (PHON(4)) skinny_gemm<2, 4, true>(F, nullptr, 0, (const bf16*)(wl + WL_IN), INW / 16, ACT, LDP, HM, 0.f);
            pg8::Gemm g{HB, (const bf16*)(wl + WL_IN), MMAIN, LDP, D}; pg8::StaticOrder S; S.init(MMAIN, LDP, F.G, bid_);
            if (PHON(4)) build_rinv_table(F, S, RSQ);
            pg8::EpiStoreBf16 E{ACT, LDP, (const LAS float*)(F.lds + RTAB_OFF)};
            if (PHON(4)) pg8::gemm_phase<pg8::EpiStoreBf16, pg8::StaticOrder, true, true, true>(F.lds, g, S, E, F.tid);
        } else if (s == 3) {
#define M1_ATTN() do { for (int u = F.gw; u < AT_UNITS - 6; u += F.NGW) attn_unit(F, l, u); \
                const int mi = F.NGW - 1 - F.gw; if (mi < 8 && (mi & 7) < 4) attn_unit(F, l, AT_UNITS - 6 + mi); else if (mi >= 8 && mi < 16 && (mi & 7) < 2) attn_unit(F, l, AT_UNITS - 2 + (mi & 7)); } while (0)
            if (PHON(5) && F.wave < 4) M1_ATTN();
            if (PHON(6)) for (int k = F.wave; k * F.G + (F.gw / NWAVES) < HG_UNITS; k += NWAVES) hgrn_p1_unit(F, l, k * F.G + (F.gw / NWAVES));
            if (PHON(5) && F.wave >= 4) M1_ATTN();
#undef M1_ATTN
        } else if (s == 4) { if (PHON(7)) conv_phase(F, l); if (PHON(8)) hgrn_scan(F); }
        else if (s == 5) { if (PHON(9)) for (int k = F.wave; k * F.G + (F.gw / NWAVES) < HG_UNITS; k += NWAVES) hgrn_p3_unit(F, l, k * F.G + (F.gw / NWAVES)); }
        else { if (PHON(10)) final_phase(F); }
        if (pc + 1 < args.pc_hi) { if (args.pc_lo < 0) cg::this_grid().sync(); else xcd_barrier(gbar, F.tid); }
    }
}

#ifndef MK_PER_PHASE
#define MK_PER_PHASE 0
#endif
extern "C" void kernel_launch(void* const* d_in, const int* in_sizes, int n_in, void* d_out, int out_size, void* d_ws, size_t ws_size, hipStream_t stream) {
    static int grid = 0;
    if (grid == 0) {
        if (n_in != 21 || in_sizes[0] != MMAIN * D || out_size != MMAIN * D || ws_size < WS_END) { fprintf(stderr, "kernel_launch: unexpected shapes (n_in %d, in0 %d, out %d, ws %zu); nothing launched\n", n_in, n_in > 0 ? in_sizes[0] : -1, out_size, ws_size); grid = -1; return; }
        int dev = 0, cus = 0, per_cu = 0;
        if (hipGetDevice(&dev) != hipSuccess || hipDeviceGetAttribute(&cus, hipDeviceAttributeMultiprocessorCount, dev) != hipSuccess) { grid = -1; return; }
        if (hipFuncSetAttribute((const void*)fwd_kernel, hipFuncAttributeMaxDynamicSharedMemorySize, LDS_BYTES) != hipSuccess) { fprintf(stderr, "kernel_launch: hipFuncSetAttribute failed\n"); grid = -1; return; }
        if (hipOccupancyMaxActiveBlocksPerMultiprocessor(&per_cu, (const void*)fwd_kernel, NTHREADS, LDS_BYTES) != hipSuccess || per_cu < 1) { fprintf(stderr, "kernel_launch: occupancy query says %d\n", per_cu); per_cu = 1; }
        (void)hipGetLastError();
        grid = cus;
    }
    if (grid < 0) return;
    if (hipMemsetAsync((char*)d_ws + WS_CTL, 0, 16384, stream) != hipSuccess) { fprintf(stderr, "kernel_launch: hipMemsetAsync failed\n"); return; }
    Args a{};
    for (int i = 0; i < 21; ++i) a.in[i] = (const float*)d_in[i];
    a.out = (float*)d_out; a.ws = (unsigned char*)d_ws;
#if MK_PER_PHASE
    for (int pc = 0; pc < N_PC; ++pc) { a.pc_lo = pc; a.pc_hi = pc + 1; hipLaunchKernelGGL(fwd_kernel, dim3(grid), dim3(NTHREADS), LDS_BYTES, stream, a); }
#else
    a.pc_lo = 0; a.pc_hi = N_PC;
    void* kargs[] = {&a};
    hipError_t e = hipLaunchCooperativeKernel((const void*)fwd_kernel, dim3(grid), dim3(NTHREADS), kargs, LDS_BYTES, stream);
    if (e != hipSuccess) fprintf(stderr, "kernel_launch: cooperative launch failed: %s (grid %d)\n", hipGetErrorString(e), grid);
#endif
}
```
